# Optimizing an MI355X kernel written in HIP

```python
import jax, jax.numpy as jnp
from jax import lax
import numpy as np

D_MODEL = 2048
BATCH = 1
SEQ = 16384
DEPTH = 4
DEC_BATCH = 2
DEC_SEQ = 4096
PAST_LEN = 128

N_MIXERS = 2
N_A_LAYERS = (DEPTH + 1) // 2
N_B_LAYERS = DEPTH // 2
MLA_HEADS = 16
Q_LORA = 512
KV_LORA = 512
NOPE_DIM = 128
ROPE_DIM = 64
V_DIM = 128
ROPE_THETA = 10000.0
Q_BLOCK = 128
SWA_Q_HEADS = 16
SWA_KV_HEADS = 4
SWA_GROUP = SWA_Q_HEADS // SWA_KV_HEADS
SWA_HEAD_DIM = 128
WINDOW = 128
BLOCK = 128
N_BUCKETS = 32
MAX_DISTANCE = 128
D_FF = 4 * D_MODEL
PLE_DIM = 256
EPS = 1e-6
NEG_INF = -1e30

kernel_name = 'hybrid_mla_swa_sink_encoder'


def rmsnorm(x, g):
    xf = x.astype(jnp.float32)
    y = xf * lax.rsqrt(jnp.mean(xf * xf, axis=-1, keepdims=True) + EPS)
    return (y * g.astype(jnp.float32)).astype(x.dtype)


def rotary(x, pos):
    half = ROPE_DIM // 2
    inv = 1.0 / (ROPE_THETA ** (jnp.arange(half, dtype=jnp.float32) / half))
    ang = pos.astype(jnp.float32)[:, None] * inv[None, :]
    cos = jnp.cos(ang)[None, :, None, :]
    sin = jnp.sin(ang)[None, :, None, :]
    xf = x.astype(jnp.float32)
    x1, x2 = xf[..., :half], xf[..., half:]
    return jnp.concatenate([x1 * cos - x2 * sin, x2 * cos + x1 * sin], axis=-1).astype(x.dtype)


def t5_bucket(rel):
    nb = N_BUCKETS // 2
    max_exact = nb // 2
    ret = (rel > 0).astype(np.int32) * nb
    n = np.abs(rel)
    large = max_exact + (np.log(np.maximum(n, 1).astype(np.float32) / max_exact)
                         / np.log(MAX_DISTANCE / max_exact) * (nb - max_exact)).astype(np.int32)
    large = np.minimum(large, nb - 1)
    return (ret + np.where(n < max_exact, n, large)).astype(np.int32)


def mla(x, w_down, q_norm, kv_norm, w_uq, w_ukv, w_o):
    B, S, _ = x.shape
    H = MLA_HEADS
    lat = x @ w_down
    c_q = rmsnorm(lat[..., :Q_LORA], q_norm)
    c_kv = rmsnorm(lat[..., Q_LORA:Q_LORA + KV_LORA], kv_norm)
    k_rope = lat[..., Q_LORA + KV_LORA:]
    q = (c_q @ w_uq).reshape(B, S, H, NOPE_DIM + ROPE_DIM)
    kv = (c_kv @ w_ukv).reshape(B, S, H, NOPE_DIM + V_DIM)
    pos = jnp.arange(S)
    q_nope = q[..., :NOPE_DIM]
    q_rope = rotary(q[..., NOPE_DIM:], pos)
    k_nope = kv[..., :NOPE_DIM]
    v = kv[..., NOPE_DIM:]
    k_rope = rotary(k_rope[:, :, None, :], pos)[:, :, 0, :]
    scale = (NOPE_DIM + ROPE_DIM) ** -0.5
    nq = S // Q_BLOCK

    def to_blocks(t):
        return t.reshape(B, nq, Q_BLOCK, *t.shape[2:]).swapaxes(0, 1)

    def attend(blk):
        qn, qr = blk
        s = (jnp.einsum('bqhd,bkhd->bhqk', qn, k_nope).astype(jnp.float32)
             + jnp.einsum('bqhr,bkr->bhqk', qr, k_rope).astype(jnp.float32)) * scale
        p = jax.nn.softmax(s, axis=-1).astype(v.dtype)
        return jnp.einsum('bhqk,bkhd->bqhd', p, v)

    o = lax.map(attend, (to_blocks(q_nope), to_blocks(q_rope)))
    o = o.swapaxes(0, 1).reshape(B, S, H * V_DIM)
    return o @ w_o


def swa(x, w_qkv, sink, rel_bias, w_o):
    B, S, _ = x.shape
    nb = S // BLOCK
    HQ, HKV, G, DH = SWA_Q_HEADS, SWA_KV_HEADS, SWA_GROUP, SWA_HEAD_DIM
    qkv = x @ w_qkv
    q = qkv[..., :HQ * DH].reshape(B, nb, BLOCK, HKV, G, DH)
    k = qkv[..., HQ * DH:(HQ + HKV) * DH].reshape(B, S, HKV, DH)
    v = qkv[..., (HQ + HKV) * DH:].reshape(B, S, HKV, DH)

    def band(t):
        tp = jnp.pad(t, ((0, 0), (BLOCK, BLOCK), (0, 0), (0, 0))).reshape(B, nb + 2, BLOCK, HKV, DH)
        return jnp.concatenate([tp[:, :-2], tp[:, 1:-1], tp[:, 2:]], axis=2)

    kb, vb = band(k), band(v)
    s = jnp.einsum('bnqkgd,bnskd->bnkgqs', q, kb).astype(jnp.float32) * (DH ** -0.5)
    qi = np.arange(BLOCK)[:, None]
    si = np.arange(3 * BLOCK)[None, :]
    rel = si - BLOCK - qi
    bias = rel_bias[t5_bucket(rel)].astype(jnp.float32)
    bias = bias.transpose(2, 0, 1).reshape(HKV, G, BLOCK, 3 * BLOCK)
    kpos = np.arange(nb)[:, None] * BLOCK + np.arange(3 * BLOCK)[None, :] - BLOCK
    mask = (np.abs(rel) <= WINDOW)[None] & ((kpos >= 0) & (kpos < S))[:, None, :]
    s = jnp.where(mask[None, :, None, None], s + bias, NEG_INF)
    sk = sink.astype(jnp.float32).reshape(HKV, G, 1, 1)
    m = jnp.maximum(jnp.max(s, axis=-1, keepdims=True), sk)
    e = jnp.exp(s - m)
    p = e / (jnp.sum(e, axis=-1, keepdims=True) + jnp.exp(sk - m))
    o = jnp.einsum('bnkgqs,bnskd->bnqkgd', p.astype(v.dtype), vb).reshape(B, S, HQ * DH)
    return o @ w_o


def sq_relu_mlp(x, w_up, w_down):
    h = jnp.maximum(x @ w_up, 0)
    return (h * h) @ w_down


def trunk(x, p, norm_gains, mla_w_down, mla_q_norm, mla_kv_norm, mla_w_uq, mla_w_ukv, mla_w_o,
          swa_w_qkv, swa_sink, swa_w_o, rel_bias, mlp_w_up, mlp_w_down, ple_w_up, ple_w_gate, ple_norm):
    for i in range(DEPTH):
        g = norm_gains[i]
        j = i // N_MIXERS
        h = rmsnorm(x, g[0])
        if i % N_MIXERS == 0:
            h = mla(h, mla_w_down[j], mla_q_norm[j], mla_kv_norm[j], mla_w_uq[j], mla_w_ukv[j], mla_w_o[j])
        else:
            h = swa(h, swa_w_qkv[j], swa_sink[j], rel_bias, swa_w_o[j])
        x = x + rmsnorm(h, g[1])
        h = sq_relu_mlp(rmsnorm(x, g[2]), mlp_w_up[i], mlp_w_down[i])
        x = x + rmsnorm(h, g[3])
        e = rmsnorm(p[i] @ ple_w_up[i], ple_norm[i])
        x = x + e * jax.nn.sigmoid(x @ ple_w_gate[i])
    return x


def setup_inputs(seed: int = 0) -> dict:
    key = jax.random.key(seed)
    ks = jax.random.split(key, 24)
    f32 = jnp.float32

    def nrm(k, shape, scale):
        return jax.random.normal(k, shape, f32) * scale

    def gain(k, shape):
        return 1.0 + 0.02 * jax.random.normal(k, shape, f32)

    H = MLA_HEADS
    return {
        'x_prompt': nrm(ks[0], (BATCH, SEQ, D_MODEL), 1.0),
        'x_sample': nrm(ks[1], (DEC_BATCH, DEC_SEQ, D_MODEL), 1.0),
        'p_prompt': nrm(ks[2], (DEPTH, BATCH, SEQ, PLE_DIM), 1.0),
        'p_sample': nrm(ks[3], (DEPTH, DEC_BATCH, DEC_SEQ, PLE_DIM), 1.0),
        'norm_gains': gain(ks[4], (DEPTH, 4, D_MODEL)),
        'mla_w_down': nrm(ks[5], (N_A_LAYERS, D_MODEL, Q_LORA + KV_LORA + ROPE_DIM), D_MODEL ** -0.5),
        'mla_q_norm': gain(ks[6], (N_A_LAYERS, Q_LORA)),
        'mla_kv_norm': gain(ks[7], (N_A_LAYERS, KV_LORA)),
        'mla_w_uq': nrm(ks[8], (N_A_LAYERS, Q_LORA, H * (NOPE_DIM + ROPE_DIM)), Q_LORA ** -0.5),
        'mla_w_ukv': nrm(ks[9], (N_A_LAYERS, KV_LORA, H * (NOPE_DIM + V_DIM)), KV_LORA ** -0.5),
        'mla_w_o': nrm(ks[10], (N_A_LAYERS, H * V_DIM, D_MODEL), (H * V_DIM) ** -0.5),
        'swa_w_qkv': nrm(ks[11], (N_B_LAYERS, D_MODEL, (SWA_Q_HEADS + 2 * SWA_KV_HEADS) * SWA_HEAD_DIM), D_MODEL ** -0.5),
        'swa_sink': nrm(ks[12], (N_B_LAYERS, SWA_Q_HEADS), 0.5),
        'swa_w_o': nrm(ks[13], (N_B_LAYERS, SWA_Q_HEADS * SWA_HEAD_DIM, D_MODEL), (SWA_Q_HEADS * SWA_HEAD_DIM) ** -0.5),
        'rel_bias': nrm(ks[14], (N_BUCKETS, SWA_Q_HEADS), 0.5),
        'mlp_w_up': nrm(ks[15], (DEPTH, D_MODEL, D_FF), D_MODEL ** -0.5),
        'mlp_w_down': nrm(ks[16], (DEPTH, D_FF, D_MODEL), D_FF ** -0.5),
        'ple_w_up': nrm(ks[17], (DEPTH, PLE_DIM, D_MODEL), PLE_DIM ** -0.5),
        'ple_w_gate': nrm(ks[18], (DEPTH, D_MODEL, D_MODEL), D_MODEL ** -0.5),
        'ple_norm': gain(ks[19], (DEPTH, D_MODEL)),
    }


def reference(x_prompt, x_sample, p_prompt, p_sample, norm_gains, mla_w_down, mla_q_norm, mla_kv_norm,
              mla_w_uq, mla_w_ukv, mla_w_o, swa_w_qkv, swa_sink, swa_w_o, rel_bias, mlp_w_up, mlp_w_down,
              ple_w_up, ple_w_gate, ple_norm):
    y_prompt = trunk(x_prompt, p_prompt, norm_gains, mla_w_down, mla_q_norm, mla_kv_norm, mla_w_uq, mla_w_ukv,
                     mla_w_o, swa_w_qkv, swa_sink, swa_w_o, rel_bias, mlp_w_up, mlp_w_down, ple_w_up,
                     ple_w_gate, ple_norm)
    y_sample = trunk(x_sample, p_sample, norm_gains, mla_w_down, mla_q_norm, mla_kv_norm, mla_w_uq, mla_w_ukv,
                     mla_w_o, swa_w_qkv, swa_sink, swa_w_o, rel_bias, mlp_w_up, mlp_w_down, ple_w_up,
                     ple_w_gate, ple_norm)
    return (y_prompt, y_sample)
```

```cpp
#include <hip/hip_runtime.h>
#include <cstdio>
#include <cstdint>
namespace pg8 {
#define PG8_LAS __attribute__((address_space(3)))
typedef unsigned short bf16_t;
typedef short bf16x8 __attribute__((ext_vector_type(8)));
typedef float f32x4 __attribute__((ext_vector_type(4)));
typedef unsigned u32x4 __attribute__((ext_vector_type(4)));
constexpr int BM = 256, BK = 64, HALF = 128, HTB = HALF * BK * 2  , STAGE_BYTES = 8 * HTB, NXCD = 8, WGM = 8;

__host__ __device__ __forceinline__ int lds_byte(int r, int c) { const int st = (r >> 4) * 2 + (c >> 5), rr = r & 15, cc = c & 31, ob = rr * 64 + cc * 2; return st * 1024 + (ob ^ (((ob >> 9) & 1) << 5)); }
__host__ __device__ __forceinline__ void stage_rc(int b, int& R, int& C) { const int st = b / 1024, sb = b % 1024, swz = sb ^ (((sb >> 9) & 1) << 5); R = (st >> 1) * 16 + swz / 64; C = (st & 1) * 32 + (swz % 64) / 2; }
__host__ __device__ __forceinline__ int perm32(int rho) { const int n = rho >> 4, i = rho & 15; return 8 * (i >> 2) + 4 * n + (i & 3); }

struct Unit { int pm, pn; };
struct Gemm { const bf16_t* A; const bf16_t* Bt; int M, N, K; };

struct StaticOrder {
    int nM, nN, nwg, G, c;
    __host__ __device__ void init(int M, int N, int G_, int c_) { nM = M / BM; nN = N / BM; nwg = nM * nN; G = G_; c = c_; }
    __host__ __device__ bool next(int i, Unit& u) const {
        const long L = (long)i * G + c; if (L >= nwg) return false;
        int wgid = (int)L; { const int q = nwg / NXCD, r = nwg % NXCD, xcd = wgid % NXCD, off = wgid / NXCD; wgid = (xcd < r ? xcd * (q + 1) : r * (q + 1) + (xcd - r) * q) + off; }
        const int nig = WGM * nN, gid = wgid / nig, fm = gid * WGM, gsz = (nM - fm) < WGM ? (nM - fm) : WGM;
        u.pm = fm + ((wgid % nig) % gsz); u.pn = (wgid % nig) / gsz; return true;
    }
    __device__ __forceinline__ void a_ready(const Unit&) const {}
    __device__ __forceinline__ void done(const Unit&) const {}
};

__device__ __forceinline__ unsigned cvt_pk_bf16(float lo, float hi) { unsigned r; asm volatile("v_cvt_pk_bf16_f32 %0, %1, %2" : "=v"(r) : "v"(lo), "v"(hi)); return r; }
typedef float f32x2 __attribute__((ext_vector_type(2)));

struct EpiF32 {
    static constexpr bool PERM = false, AFTER_DRAIN = false;
    float* C; int ldc;
    __device__ __forceinline__ void operator()(const f32x4 (&acc)[2][2][4][2], const Unit& u, int wr, int wc, int fr, int fq) const {
        const int row0 = u.pm * BM + wr * 64 + fr, col0 = u.pn * BM + wc * 32 + 4 * fq;
#pragma unroll
        for (int ai = 0; ai < 2; ++ai)
#pragma unroll
            for (int m = 0; m < 4; ++m) { float* rowp = C + (size_t)(row0 + ai * HALF + m * 16) * ldc + col0;
#pragma unroll
                for (int bj = 0; bj < 2; ++bj)
#pragma unroll
                    for (int n = 0; n < 2; ++n) *(f32x4*)(rowp + bj * HALF + n * 16) = acc[ai][bj][m][n]; }
    }
};
template <int ACT  > struct EpiBf16 {
    static constexpr bool PERM = true, AFTER_DRAIN = false;
    bf16_t* O; int ldc;
    __device__ __forceinline__ void operator()(const f32x4 (&acc)[2][2][4][2], const Unit& u, int wr, int wc, int fr, int fq) const {
        const int row0 = u.pm * BM + wr * 64 + fr, col0 = u.pn * BM + wc * 32 + 8 * fq;
#pragma unroll
        for (int ai = 0; ai < 2; ++ai)
#pragma unroll
            for (int m = 0; m < 4; ++m) { bf16_t* rowp = O + (size_t)(row0 + ai * HALF + m * 16) * ldc + col0;
#pragma unroll
                for (int bj = 0; bj < 2; ++bj) { f32x4 v0 = acc[ai][bj][m][0], v1 = acc[ai][bj][m][1];
                    if (ACT == 1) {
#pragma unroll
                        for (int e = 0; e < 4; ++e) { const float a = fmaxf(v0[e], 0.f), b = fmaxf(v1[e], 0.f); v0[e] = a * a; v1[e] = b * b; } }
                    u32x4 w; w.x = cvt_pk_bf16(v0[0], v0[1]); w.y = cvt_pk_bf16(v0[2], v0[3]); w.z = cvt_pk_bf16(v1[0], v1[1]); w.w = cvt_pk_bf16(v1[2], v1[3]);
                    *(u32x4*)(rowp + bj * HALF) = w; } }
    }
};
struct EpiQRope {
    static constexpr bool PERM = true, AFTER_DRAIN = false;
    bf16_t* O; int ldc; const float* rot;
    __device__ __forceinline__ void operator()(const f32x4 (&acc)[2][2][4][2], const Unit& u, int wr, int wc, int fr, int fq) const {
        const int row0 = u.pm * BM + wr * 64 + fr, col0 = u.pn * BM + wc * 32 + 8 * fq;
#pragma unroll
        for (int bj = 0; bj < 2; ++bj) {
            const int sb = u.pn * BM + bj * HALF + wc * 32, hr = sb % 192;
            const bool rope = hr >= 128; const int d0 = ((hr - 128) >> 1) + 4 * fq;
#pragma unroll
            for (int ai = 0; ai < 2; ++ai)
#pragma unroll
                for (int m = 0; m < 4; ++m) { const int row = row0 + ai * HALF + m * 16;
                    f32x4 v0 = acc[ai][bj][m][0], v1 = acc[ai][bj][m][1];
                    if (rope) { const int pos = row < 16384 ? row : ((row - 16384) & 4095);
                        const f32x4 cs0 = *(const f32x4*)(rot + ((size_t)pos * 32 + d0) * 2), cs1 = *(const f32x4*)(rot + ((size_t)pos * 32 + d0 + 2) * 2);
                        f32x4 o0, o1;
                        o0[0] = v0[0] * cs0[0] - v0[1] * cs0[1]; o0[1] = v0[1] * cs0[0] + v0[0] * cs0[1];
                        o0[2] = v0[2] * cs0[2] - v0[3] * cs0[3]; o0[3] = v0[3] * cs0[2] + v0[2] * cs0[3];
                        o1[0] = v1[0] * cs1[0] - v1[1] * cs1[1]; o1[1] = v1[1] * cs1[0] + v1[0] * cs1[1];
                        o1[2] = v1[2] * cs1[2] - v1[3] * cs1[3]; o1[3] = v1[3] * cs1[2] + v1[2] * cs1[3];
                        v0 = o0; v1 = o1; }
                    u32x4 w; w.x = cvt_pk_bf16(v0[0], v0[1]); w.y = cvt_pk_bf16(v0[2], v0[3]); w.z = cvt_pk_bf16(v1[0], v1[1]); w.w = cvt_pk_bf16(v1[2], v1[3]);
                    *(u32x4*)(O + (size_t)row * ldc + col0 + bj * HALF) = w; } }
    }
};
struct EpiGate {
    static constexpr bool PERM = false, AFTER_DRAIN = false;
    float* X; const bf16_t* EN; int ldc;
    __device__ __forceinline__ void operator()(const f32x4 (&acc)[2][2][4][2], const Unit& u, int wr, int wc, int fr, int fq) const {
        typedef unsigned u32x2v __attribute__((ext_vector_type(2)));
        const int row0 = u.pm * BM + wr * 64 + fr, col0 = u.pn * BM + wc * 32 + 4 * fq;
#pragma unroll
        for (int ai = 0; ai < 2; ++ai)
#pragma unroll
            for (int m = 0; m < 4; ++m) { const size_t off = (size_t)(row0 + ai * HALF + m * 16) * ldc + col0;
#pragma unroll
                for (int bj = 0; bj < 2; ++bj)
#pragma unroll
                    for (int n = 0; n < 2; ++n) { const size_t o = off + bj * HALF + n * 16;
                        const f32x4 x = *(const f32x4*)(X + o); const u32x2v ew = *(const u32x2v*)(EN + o); const f32x4 a = acc[ai][bj][m][n];
                        f32x4 e; e[0] = __uint_as_float(ew.x << 16); e[1] = __uint_as_float(ew.x & 0xffff0000u); e[2] = __uint_as_float(ew.y << 16); e[3] = __uint_as_float(ew.y & 0xffff0000u);
                        f32x4 r;
#pragma unroll
                        for (int k = 0; k < 4; ++k) { const float g = __builtin_amdgcn_rcpf(1.0f + __builtin_amdgcn_exp2f(-1.4426950408889634f * a[k])); r[k] = x[k] + e[k] * g; }
                        *(f32x4*)(X + o) = r; }
                if (m & 1) asm volatile("" ::: "memory"); }
    }
};
template <class Epi, class Sched, bool ALIGN_EPI = false, bool SP2 = false>
__device__ __forceinline__ void gemm_phase(PG8_LAS unsigned char* lds, const Gemm g, const Sched& S, const Epi& E) {
    int tid_ = threadIdx.x; asm volatile("" : "+v"(tid_));
    const int tid = tid_, wid = __builtin_amdgcn_readfirstlane(tid >> 6), lane = tid & 63, wr = wid >> 2, wc = wid & 3, fr = lane & 15, fq = lane >> 4;
    const int K = g.K, nt = K / BK;
    unsigned voffA[2], voffB[2];
#pragma unroll
    for (int i = 0; i < 2; ++i) { int R, C; stage_rc(tid * 16 + i * 8192, R, C); const int Rb = Epi::PERM ? ((R & ~31) + perm32(R & 31)) : R;
        voffA[i] = (unsigned)(R * K + C) * 2u; voffB[i] = (unsigned)(Rb * K + C) * 2u; }
    const size_t kstep = (size_t)(BK * 2);
    const size_t hstep = (size_t)HALF * K * 2;
    const size_t tstep = 2 * hstep;
    const unsigned ldsw = (unsigned)wid * 1024u;
    const int aoff = lds_byte(wr * 64 + fr, fq * 8), boff = lds_byte(wc * 32 + fr, fq * 8);
#define PG8_SA(b, h) (((b) * 2 + (h)) * HTB)
#define PG8_SB(b, h) ((4 + (b) * 2 + (h)) * HTB)
#define PG8_STAGE(bufoff, gbase, voff) do { _Pragma("unroll") for (int _i = 0; _i < 2; ++_i) \
        __builtin_amdgcn_global_load_lds((const unsigned*)((const char*)(gbase) + (voff)[_i]), (PG8_LAS unsigned*)(lds + (bufoff) + ldsw + _i * 8192), 16, 0, 0); } while (0)
#define PG8_LDA(dst, b, h) do { _Pragma("unroll") for (int m = 0; m < 4; ++m) _Pragma("unroll") for (int k = 0; k < 2; ++k) dst[m][k] = *(const PG8_LAS bf16x8*)(lds + PG8_SA(b, h) + aoff + m * 2048 + k * 1024); } while (0)
#define PG8_LDB(dst, b, h) do { _Pragma("unroll") for (int n = 0; n < 2; ++n) _Pragma("unroll") for (int k = 0; k < 2; ++k) dst[n][k] = *(const PG8_LAS bf16x8*)(lds + PG8_SB(b, h) + boff + n * 2048 + k * 1024); } while (0)
#define PG8_MMA(ai, bj, At, Bt) do { __builtin_amdgcn_s_setprio(1); _Pragma("unroll") for (int m = 0; m < 4; ++m) _Pragma("unroll") for (int n = 0; n < 2; ++n) _Pragma("unroll") for (int k = 0; k < 2; ++k) \
        acc[ai][bj][m][n] = __builtin_amdgcn_mfma_f32_16x16x32_bf16(Bt[n][k], At[m][k], acc[ai][bj][m][n], 0, 0, 0); __builtin_amdgcn_s_setprio(0); } while (0)
#define PG8_WAIT_V(n) asm volatile("s_waitcnt vmcnt(" #n ")" ::: "memory")
#define PG8_WAIT_L(n) asm volatile("s_waitcnt lgkmcnt(" #n ")" ::: "memory")
#define PG8_BAR __builtin_amdgcn_s_barrier()
#define PG8_SCHED __builtin_amdgcn_sched_barrier(0)
    Unit cur, nxt; int ui = 0;
    if (!S.next(0, cur)) return;
    f32x4 acc[2][2][4][2];
#pragma unroll
    for (int a = 0; a < 2; ++a)
#pragma unroll
        for (int b = 0; b < 2; ++b)
#pragma unroll
            for (int m = 0; m < 4; ++m)
#pragma unroll
                for (int n = 0; n < 2; ++n) acc[a][b][m][n] = (f32x4){0.f, 0.f, 0.f, 0.f};
    bf16x8 At[4][2], B0[2][2], B1[2][2];
    const char* cA = (const char*)g.A + (size_t)cur.pm * tstep; const char* cB = (const char*)g.Bt + (size_t)cur.pn * tstep;
    S.a_ready(cur);
    if constexpr (SP2) {
        PG8_STAGE(PG8_SB(0, 0), cB, voffB); PG8_STAGE(PG8_SB(0, 1), cB + hstep, voffB); PG8_STAGE(PG8_SA(0, 0), cA, voffA); PG8_STAGE(PG8_SA(0, 1), cA + hstep, voffA);
        if (wr == 1) PG8_BAR;
        PG8_WAIT_V(2); PG8_BAR;
        PG8_STAGE(PG8_SB(1, 0), cB + kstep, voffB); PG8_STAGE(PG8_SA(1, 0), cA + kstep, voffA); PG8_STAGE(PG8_SB(1, 1), cB + hstep + kstep, voffB);
        PG8_WAIT_V(6); PG8_BAR;
    } else {
        PG8_STAGE(PG8_SB(0, 0), cB, voffB); PG8_STAGE(PG8_SA(0, 0), cA, voffA); PG8_STAGE(PG8_SB(0, 1), cB + hstep, voffB); PG8_STAGE(PG8_SA(0, 1), cA + hstep, voffA);
        if (wr == 1) PG8_BAR;
        PG8_WAIT_V(4); PG8_BAR;
        PG8_STAGE(PG8_SB(1, 0), cB + kstep, voffB); PG8_STAGE(PG8_SA(1, 0), cA + kstep, voffA); PG8_STAGE(PG8_SB(1, 1), cB + hstep + kstep, voffB);
        PG8_WAIT_V(6); PG8_BAR;
    }
    for (;;) {
        const bool has_next = S.next(ui + 1, nxt);
        const char* nA = has_next ? (const char*)g.A + (size_t)nxt.pm * tstep : cA; const char* nB = has_next ? (const char*)g.Bt + (size_t)nxt.pn * tstep : cB;
        for (int t = 0; t < nt; t += 2) {
            const bool last = (t == nt - 2);
            const char* a1 = cA + (size_t)(t + 1) * kstep;
            const char* a2 = last ? nA : cA + (size_t)(t + 2) * kstep; const char* b2 = last ? nB : cB + (size_t)(t + 2) * kstep;
            const char* a3 = a2 + kstep; const char* b3 = b2 + kstep;
            if (last && has_next) S.a_ready(nxt);
            if constexpr (SP2) {
            PG8_LDB(B0, 0, 0); PG8_LDB(B1, 0, 1); PG8_SCHED; PG8_LDA(At, 0, 0); PG8_STAGE(PG8_SA(1, 1), a1 + hstep, voffA);
            PG8_WAIT_V(8); PG8_WAIT_L(0); PG8_BAR; PG8_MMA(0, 0, At, B0); PG8_MMA(0, 1, At, B1); PG8_BAR; PG8_SCHED;
            PG8_LDA(At, 0, 1); PG8_STAGE(PG8_SB(0, 0), b2, voffB); PG8_STAGE(PG8_SB(0, 1), b2 + hstep, voffB); PG8_STAGE(PG8_SA(0, 0), a2, voffA);
            PG8_WAIT_V(8); PG8_WAIT_L(0); PG8_BAR; PG8_MMA(1, 0, At, B0); PG8_MMA(1, 1, At, B1); PG8_BAR; PG8_SCHED;
            PG8_LDB(B0, 1, 0); PG8_LDB(B1, 1, 1); PG8_SCHED; PG8_LDA(At, 1, 0); PG8_STAGE(PG8_SA(0, 1), a2 + hstep, voffA);
            PG8_WAIT_V(8); PG8_WAIT_L(0); PG8_BAR; PG8_MMA(0, 0, At, B0); PG8_MMA(0, 1, At, B1); PG8_BAR; PG8_SCHED;
            PG8_LDA(At, 1, 1); PG8_STAGE(PG8_SB(1, 0), b3, voffB); PG8_STAGE(PG8_SB(1, 1), b3 + hstep, voffB); PG8_STAGE(PG8_SA(1, 0), a3, voffA);
            PG8_WAIT_V(8); PG8_WAIT_L(0); PG8_BAR; PG8_MMA(1, 0, At, B0); PG8_MMA(1, 1, At, B1); PG8_BAR; PG8_SCHED;
            } else {
            PG8_LDB(B0, 0, 0); PG8_SCHED; PG8_LDA(At, 0, 0); PG8_STAGE(PG8_SA(1, 1), a1 + hstep, voffA);
            PG8_WAIT_L(8); PG8_BAR; PG8_WAIT_L(0); PG8_MMA(0, 0, At, B0); PG8_BAR; PG8_SCHED;
            PG8_LDB(B1, 0, 1); PG8_STAGE(PG8_SB(0, 0), b2, voffB);
            PG8_BAR; PG8_WAIT_L(0); PG8_MMA(0, 1, At, B1); PG8_BAR;
            PG8_LDA(At, 0, 1); PG8_STAGE(PG8_SA(0, 0), a2, voffA);
            PG8_BAR; PG8_WAIT_L(0); PG8_MMA(1, 0, At, B0); PG8_BAR; PG8_SCHED;
            PG8_STAGE(PG8_SB(0, 1), b2 + hstep, voffB);
            PG8_WAIT_V(6); PG8_BAR; PG8_MMA(1, 1, At, B1); PG8_BAR;
            PG8_LDB(B0, 1, 0); PG8_SCHED; PG8_LDA(At, 1, 0); PG8_STAGE(PG8_SA(0, 1), a2 + hstep, voffA);
            PG8_WAIT_L(8); PG8_BAR; PG8_WAIT_L(0); PG8_MMA(0, 0, At, B0); PG8_BAR; PG8_SCHED;
            PG8_LDB(B1, 1, 1); PG8_STAGE(PG8_SB(1, 0), b3, voffB);
            PG8_BAR; PG8_WAIT_L(0); PG8_MMA(0, 1, At, B1); PG8_BAR;
            PG8_LDA(At, 1, 1); PG8_STAGE(PG8_SA(1, 0), a3, voffA);
            PG8_BAR; PG8_WAIT_L(0); PG8_MMA(1, 0, At, B0); PG8_BAR; PG8_SCHED;
            PG8_STAGE(PG8_SB(1, 1), b3 + hstep, voffB);
            PG8_WAIT_V(6); PG8_BAR; PG8_MMA(1, 1, At, B1); PG8_BAR;
            }
        }
        if constexpr (ALIGN_EPI) { if (wr == 0) PG8_BAR; }
        if constexpr (!Epi::AFTER_DRAIN) { E(acc, cur, wr, wc, fr, fq); S.done(cur); }
        if (!has_next) break;
#pragma unroll
        for (int a = 0; a < 2; ++a)
#pragma unroll
            for (int b = 0; b < 2; ++b)
#pragma unroll
                for (int m = 0; m < 4; ++m)
#pragma unroll
                    for (int n = 0; n < 2; ++n) acc[a][b][m][n] = (f32x4){0.f, 0.f, 0.f, 0.f};
        cur = nxt; cA = nA; cB = nB; ++ui;
        if constexpr (ALIGN_EPI) { if (wr == 1) PG8_BAR; }
    }
    PG8_WAIT_V(0);
    if constexpr (!ALIGN_EPI) { if (wr == 0) PG8_BAR; }
    PG8_BAR;
    if constexpr (Epi::AFTER_DRAIN) { E.fused(acc, cur, wr, wc, fr, fq, lds, wid, lane); S.done(cur); }
#undef PG8_SA
#undef PG8_SB
#undef PG8_STAGE
#undef PG8_LDA
#undef PG8_LDB
#undef PG8_MMA
#undef PG8_WAIT_V
#undef PG8_WAIT_L
#undef PG8_BAR
#undef PG8_SCHED
}
}

namespace att {
typedef short bf16x8 __attribute__((ext_vector_type(8)));
typedef short s16x4 __attribute__((ext_vector_type(4)));
typedef float f32x16 __attribute__((ext_vector_type(16)));
typedef unsigned u32x4 __attribute__((ext_vector_type(4)));
typedef unsigned short bf16_t;
#define ATT_LAS __attribute__((address_space(3)))
#define ATT_SBAR() __builtin_amdgcn_sched_barrier(0)
constexpr int KN_OFF = 0, KN_SLOT = 16384, KR_OFF = 49152, KR_SLOT = 8192, V_OFF = 73728, V_SLOT = 16384, WSC_OFF = 122880, BT_OFF = KR_OFF, ATT_LDS_BYTES = WSC_OFF + 8 * 256;
constexpr int BT_STRIDE = 264;
__host__ __device__ __forceinline__ int crow(int r, int hi) { return (r & 3) + 8 * (r >> 2) + 4 * hi; }
__device__ __forceinline__ unsigned cvtpk(float lo, float hi) { unsigned r; asm volatile("v_cvt_pk_bf16_f32 %0, %1, %2" : "=v"(r) : "v"(lo), "v"(hi)); return r; }
__host__ __device__ __forceinline__ int kn_byte(int R, int c) { return R * 256 + ((c ^ (R & 15)) << 4); }
__host__ __device__ __forceinline__ int kr_byte(int R, int c) { return R * 128 + ((c ^ ((R >> 1) & 7)) << 4); }
__host__ __device__ __forceinline__ int v_st(int k, int c) { const int kk = (k & ~0xC) | ((k & 4) << 1) | ((k & 8) >> 1); return ((kk >> 3) * 4 + (c >> 5)) * 512 + ((kk & 7) * 32 + (c & 31)) * 2; }
__host__ __device__ __forceinline__ int v_rd_base(int lane) { return ((lane & 3) << 3) | (((lane >> 2) & 3) << 6) | (((lane >> 4) & 1) << 5) | (((lane >> 5) & 1) << 8); }
__host__ __device__ constexpr int v_rd_off(int d0, int ks, int half) { return d0 * 512 + ks * 4096 + half * 2048; }
__host__ __device__ __forceinline__ void kn_inv(int b, int& R, int& c) { R = b >> 8; c = ((b >> 4) & 15) ^ (R & 15); }
__host__ __device__ __forceinline__ void kr_inv(int b, int& R, int& c) { R = b >> 7; c = ((b >> 4) & 7) ^ ((R >> 1) & 7); }
__host__ __device__ __forceinline__ void v_inv(int b, int& k, int& col) { const int s = b >> 9, w = b & 511, kk = ((s >> 2) << 3) | (w >> 6); k = (kk & ~0xC) | ((kk & 4) << 1) | ((kk & 8) >> 1); col = (s & 3) * 32 + ((w & 63) >> 1); }

__device__ __forceinline__ void glds16(const void* gsrc, unsigned lds_dst) { unsigned keep;
    asm volatile("s_mov_b32 %0, m0\n\ts_mov_b32 m0, %2\n\ts_nop 0\n\tglobal_load_lds_dwordx4 %1, off\n\ts_mov_b32 m0, %0" : "=&s"(keep) : "v"(gsrc), "s"(lds_dst) : "memory"); }
template <int OFF> __device__ __forceinline__ s16x4 tr_read(int vb) { s16x4 r; asm volatile("ds_read_b64_tr_b16 %0, %1 offset:%2" : "=&v"(r) : "v"(vb), "i"(OFF) : "memory"); return r; }
template <int D0> __device__ __forceinline__ void pv_one(f32x16& od, int vb, bf16x8 pa0, bf16x8 pa1, bf16x8 pa2, bf16x8 pa3) {
    const s16x4 l0 = tr_read<v_rd_off(D0, 0, 0)>(vb), h0 = tr_read<v_rd_off(D0, 0, 1)>(vb), l1 = tr_read<v_rd_off(D0, 1, 0)>(vb), h1 = tr_read<v_rd_off(D0, 1, 1)>(vb);
    const s16x4 l2 = tr_read<v_rd_off(D0, 2, 0)>(vb), h2 = tr_read<v_rd_off(D0, 2, 1)>(vb), l3 = tr_read<v_rd_off(D0, 3, 0)>(vb), h3 = tr_read<v_rd_off(D0, 3, 1)>(vb);
    asm volatile("s_waitcnt lgkmcnt(0)" ::: "memory"); ATT_SBAR();
#define ATT_PK(L, H) (bf16x8){L[0], L[1], L[2], L[3], H[0], H[1], H[2], H[3]}
    od = __builtin_amdgcn_mfma_f32_32x32x16_bf16(pa0, ATT_PK(l0, h0), od, 0, 0, 0);
    od = __builtin_amdgcn_mfma_f32_32x32x16_bf16(pa1, ATT_PK(l1, h1), od, 0, 0, 0);
    od = __builtin_amdgcn_mfma_f32_32x32x16_bf16(pa2, ATT_PK(l2, h2), od, 0, 0, 0);
    od = __builtin_amdgcn_mfma_f32_32x32x16_bf16(pa3, ATT_PK(l3, h3), od, 0, 0, 0);
#undef ATT_PK
}
#define ATT_WAIT_BAR(N) asm volatile("s_waitcnt vmcnt(%0) lgkmcnt(0)\n\ts_barrier" :: "n"(N) : "memory")

template <bool SWA>
__device__ __forceinline__ void attn_unit(const bf16_t* __restrict__ Qw, int ldq, const bf16_t* __restrict__ Kn, const bf16_t* __restrict__ Kr, const bf16_t* __restrict__ Vg, int ldk,
                                          bf16_t* __restrict__ Ow, int ldo, int NT, int qk_rel0  , float C, float sinkl,
                                          ATT_LAS unsigned char* shm, const ATT_LAS float* bt) {
    constexpr int NQ = SWA ? 8 : 12;
    constexpr int PIECES = SWA ? 4 : 5;
    int tid_ = threadIdx.x; asm volatile("" : "+v"(tid_));
    const int tid = tid_, lane = tid & 63, r32 = lane & 31, hi = lane >> 5; const int wid = __builtin_amdgcn_readfirstlane(tid >> 6);
    const unsigned lds0 = (unsigned)(size_t)shm;
    ATT_LAS float* wsf = (ATT_LAS float*)(shm + WSC_OFF) + wid * 64;
    const bf16_t* ksrc0; const bf16_t* ksrc1; const bf16_t* rsrc = nullptr; const bf16_t* vsrc0; const bf16_t* vsrc1;
    { int R, c; kn_inv(wid * 1024 + lane * 16, R, c); ksrc0 = Kn + (size_t)R * ldk + c * 8; kn_inv((wid + 8) * 1024 + lane * 16, R, c); ksrc1 = Kn + (size_t)R * ldk + c * 8;
      if (!SWA) { kr_inv(wid * 1024 + lane * 16, R, c); rsrc = Kr + (size_t)R * 64 + c * 8; }
      int k, col; v_inv(wid * 1024 + lane * 16, k, col); vsrc0 = Vg + (size_t)k * ldk + col; v_inv((wid + 8) * 1024 + lane * 16, k, col); vsrc1 = Vg + (size_t)k * ldk + col; }
    const size_t tstep = (size_t)64 * ldk;
    const unsigned dk0 = lds0 + KN_OFF + wid * 1024, dk1 = dk0 + 8192, dr = lds0 + KR_OFF + wid * 1024, dv0 = lds0 + V_OFF + wid * 1024, dv1 = dv0 + 8192;
#define ATT_ISSUE(t, s) do { const size_t to_ = (size_t)(t) * tstep; const unsigned s_ = (unsigned)(s); \
        glds16(ksrc0 + to_, (unsigned)__builtin_amdgcn_readfirstlane(dk0 + s_ * KN_SLOT)); glds16(ksrc1 + to_, (unsigned)__builtin_amdgcn_readfirstlane(dk1 + s_ * KN_SLOT)); \
        if (!SWA) glds16(rsrc + (size_t)(t) * 64 * 64, (unsigned)__builtin_amdgcn_readfirstlane(dr + s_ * KR_SLOT)); \
        glds16(vsrc0 + to_, (unsigned)__builtin_amdgcn_readfirstlane(dv0 + s_ * V_SLOT)); glds16(vsrc1 + to_, (unsigned)__builtin_amdgcn_readfirstlane(dv1 + s_ * V_SLOT)); } while (0)
    ATT_ISSUE(0, 0); if (NT > 1) ATT_ISSUE(1, 1);
    bf16x8 qr[NQ];
#pragma unroll
    for (int d0 = 0; d0 < NQ; ++d0) qr[d0] = *(const bf16x8*)(Qw + (size_t)r32 * ldq + d0 * 16 + hi * 8);
    float m_reg = SWA ? sinkl : -1e30f, l_reg = SWA ? 1.f : 0.f;
    f32x16 o[4];
#pragma unroll
    for (int d = 0; d < 4; ++d)
#pragma unroll
        for (int r = 0; r < 16; ++r) o[d][r] = 0.f;
    const ATT_LAS unsigned char* kn0 = shm + KN_OFF; const ATT_LAS unsigned char* kr0 = shm + KR_OFF;
    const int vb0 = (int)(lds0 + V_OFF) + v_rd_base(lane);
    int s_cur = 0, s_n2 = 2;
    for (int j = 0; j < NT; ++j) {
        if (j + 1 < NT) { ATT_WAIT_BAR(PIECES); } else { ATT_WAIT_BAR(0); }
        if (j + 2 < NT) ATT_ISSUE(j + 2, s_n2);
        f32x16 p0, p1;
#pragma unroll
        for (int r = 0; r < 16; ++r) { p0[r] = 0.f; p1[r] = 0.f; }
        { const ATT_LAS unsigned char* kb = kn0 + s_cur * KN_SLOT;
#pragma unroll
          for (int d0 = 0; d0 < 8; ++d0) {
              const bf16x8 b0 = *(const ATT_LAS bf16x8*)(kb + kn_byte(r32, d0 * 2 + hi)), b1 = *(const ATT_LAS bf16x8*)(kb + kn_byte(32 + r32, d0 * 2 + hi));
              p0 = __builtin_amdgcn_mfma_f32_32x32x16_bf16(b0, qr[d0], p0, 0, 0, 0); p1 = __builtin_amdgcn_mfma_f32_32x32x16_bf16(b1, qr[d0], p1, 0, 0, 0); }
          if (!SWA) { const ATT_LAS unsigned char* rb = kr0 + s_cur * KR_SLOT;
#pragma unroll
              for (int d0 = 0; d0 < 4; ++d0) {
                  const bf16x8 b0 = *(const ATT_LAS bf16x8*)(rb + kr_byte(r32, d0 * 2 + hi)), b1 = *(const ATT_LAS bf16x8*)(rb + kr_byte(32 + r32, d0 * 2 + hi));
                  p0 = __builtin_amdgcn_mfma_f32_32x32x16_bf16(b0, qr[(SWA ? 0 : 8) + d0], p0, 0, 0, 0); p1 = __builtin_amdgcn_mfma_f32_32x32x16_bf16(b1, qr[(SWA ? 0 : 8) + d0], p1, 0, 0, 0); } } }
        if (SWA) { const int base = qk_rel0 + j * 64 - r32 + 128;
#pragma unroll
            for (int r = 0; r < 16; ++r) { const int i0 = base + crow(r, hi), i1 = i0 + 32;
                const float b0 = bt[min(max(i0, 0), 256)], b1 = bt[min(max(i1, 0), 256)];
                p0[r] = (i0 >= 0 && i0 <= 256) ? fmaf(p0[r], C, b0) : -1e30f; p1[r] = (i1 >= 0 && i1 <= 256) ? fmaf(p1[r], C, b1) : -1e30f; }
        } else {
#pragma unroll
            for (int r = 0; r < 16; ++r) { p0[r] *= C; p1[r] *= C; } }
        float pmax = p0[0];
#pragma unroll
        for (int r = 1; r < 16; ++r) pmax = fmaxf(pmax, p0[r]);
#pragma unroll
        for (int r = 0; r < 16; ++r) pmax = fmaxf(pmax, p1[r]);
        { auto rr = __builtin_amdgcn_permlane32_swap(__float_as_uint(pmax), __float_as_uint(pmax), false, false); pmax = fmaxf(__uint_as_float(rr[0]), __uint_as_float(rr[1])); }
        const float mn = fmaxf(m_reg, pmax), alpha = __builtin_amdgcn_exp2f(m_reg - mn); m_reg = mn;
        float ps = 0.f;
#pragma unroll
        for (int r = 0; r < 16; ++r) { p0[r] = __builtin_amdgcn_exp2f(p0[r] - mn); p1[r] = __builtin_amdgcn_exp2f(p1[r] - mn); ps += p0[r] + p1[r]; }
        { auto rr = __builtin_amdgcn_permlane32_swap(__float_as_uint(ps), __float_as_uint(ps), false, false); ps = __uint_as_float(rr[0]) + __uint_as_float(rr[1]); }
        l_reg = l_reg * alpha + ps;
        if (__any(alpha < 1.f)) { if (hi == 0) wsf[r32] = alpha; asm volatile("s_waitcnt lgkmcnt(0)" ::: "memory");
#pragma unroll
            for (int r = 0; r < 16; ++r) { const float a = wsf[crow(r, hi)];
#pragma unroll
                for (int d = 0; d < 4; ++d) o[d][r] *= a; }
            asm volatile("s_waitcnt lgkmcnt(0)" ::: "memory"); }
        bf16x8 pa0, pa1, pa2, pa3;
#define ATT_PK4(P, BASE, OUT) do { unsigned a0 = cvtpk(P[BASE + 0], P[BASE + 1]), a1 = cvtpk(P[BASE + 2], P[BASE + 3]);   \
        unsigned b0_ = cvtpk(P[BASE + 4], P[BASE + 5]), b1_ = cvtpk(P[BASE + 6], P[BASE + 7]);                              \
        auto r0 = __builtin_amdgcn_permlane32_swap(a0, b0_, false, false); auto r1 = __builtin_amdgcn_permlane32_swap(a1, b1_, false, false); \
        u32x4 w = {r0[0], r1[0], r0[1], r1[1]}; OUT = __builtin_bit_cast(bf16x8, w); } while (0)
        ATT_PK4(p0, 0, pa0); ATT_PK4(p0, 8, pa1); ATT_PK4(p1, 0, pa2); ATT_PK4(p1, 8, pa3);
#undef ATT_PK4
        ATT_SBAR();
        { const int vb = vb0 + s_cur * V_SLOT;
          pv_one<0>(o[0], vb, pa0, pa1, pa2, pa3); pv_one<1>(o[1], vb, pa0, pa1, pa2, pa3); pv_one<2>(o[2], vb, pa0, pa1, pa2, pa3); pv_one<3>(o[3], vb, pa0, pa1, pa2, pa3); }
        s_cur = (s_cur == 2) ? 0 : s_cur + 1; s_n2 = (s_n2 == 2) ? 0 : s_n2 + 1;
    }
    if (hi == 0) wsf[32 + r32] = l_reg; asm volatile("s_waitcnt lgkmcnt(0)" ::: "memory");
#pragma unroll
    for (int r = 0; r < 16; ++r) { const int orow = crow(r, hi); const float rl = __builtin_amdgcn_rcpf(wsf[32 + orow]);
#pragma unroll
        for (int d = 0; d < 4; ++d) { const unsigned w = cvtpk(o[d][r] * rl, 0.f); Ow[(size_t)orow * ldo + d * 32 + r32] = (bf16_t)(w & 0xffffu); } }
    asm volatile("s_waitcnt lgkmcnt(0)\n\ts_barrier" ::: "memory");
#undef ATT_ISSUE
}
#undef ATT_WAIT_BAR
#undef ATT_SBAR
}
#define GAS __attribute__((address_space(1)))
#define LAS __attribute__((address_space(3)))
typedef unsigned short bf16;
typedef unsigned v4u __attribute__((ext_vector_type(4)));
typedef float f32x4 __attribute__((ext_vector_type(4)));
typedef short bf16x8 __attribute__((ext_vector_type(8)));
typedef GAS unsigned gu32;
typedef GAS unsigned long long gu64;
#define RLX_AGENT __ATOMIC_RELAXED, __HIP_MEMORY_SCOPE_AGENT
#define LDS_WAIT() asm volatile("s_waitcnt lgkmcnt(0)" ::: "memory")
#define VM_WAIT() asm volatile("s_waitcnt vmcnt(0)" ::: "memory")
__device__ __forceinline__ unsigned long long rt() { return __builtin_amdgcn_s_memrealtime(); }
__device__ __forceinline__ unsigned f2bf(float f) { unsigned u = __builtin_bit_cast(unsigned, f); return (u + 0x7fffu + ((u >> 16) & 1u)) >> 16; }
__device__ __forceinline__ unsigned pk2(float lo, float hi) { return f2bf(lo) | (f2bf(hi) << 16); }

#define XB_TMO      128
#define XB_XCNT(j)  (256  + 64 * (j))
#define XB_XSUB(j)  (1280 + 64 * (j))
#define XB_XGEN(j)  (2304 + 64 * (j))
#define XB_TOP      3328
#define XB_TOPGEN   3392
#define XCD_BAR_WORDS 3456
#define XB_SPIN_CAP (1u << 18)

__device__ __forceinline__ unsigned xb_ld(unsigned* p)              { return __hip_atomic_load(p, __ATOMIC_RELAXED, __HIP_MEMORY_SCOPE_AGENT); }
__device__ __forceinline__ unsigned xb_add(unsigned* p, unsigned v) { return __hip_atomic_fetch_add(p, v, __ATOMIC_RELAXED, __HIP_MEMORY_SCOPE_AGENT); }
__device__ __forceinline__ unsigned xb_xcc_id() { return (unsigned)__builtin_amdgcn_s_getreg((3 << 11) | 20) & 0xFu; }
#define XB_SPIN(cond, bar) do { unsigned _sp = 0; while (cond) { __builtin_amdgcn_s_sleep(1); \
    if ((++_sp & 255u) == 0u) { if (xb_ld(&(bar)[XB_TMO])) break; if (_sp > XB_SPIN_CAP) { atomicAdd(&(bar)[XB_TMO], 1u); break; } } } } while (0)

struct XcdBarrier {
    unsigned* bar; unsigned x;
    volatile LAS unsigned* st;
};

__device__ __forceinline__ XcdBarrier xcd_barrier_post(unsigned* bar, volatile LAS unsigned* st) {
    XcdBarrier b; b.bar = bar; b.x = xb_xcc_id(); b.st = st;
    if (threadIdx.x == 0) (void)xb_add(&bar[XB_XCNT(b.x)], 1u);
    return b;
}
__device__ __forceinline__ void xcd_barrier_complete(unsigned* bar, unsigned x, unsigned& nloc, unsigned& nx) {
    const unsigned G = gridDim.x * gridDim.y * gridDim.z;
    unsigned sum, cnt, mine, sp = 0u;
    for (;;) {
        sum = 0u; cnt = 0u; mine = 0u;
#pragma unroll
        for (unsigned j = 0; j < 16; ++j) { const unsigned c = xb_ld(&bar[XB_XCNT(j)]); sum += c; cnt += (c > 0u) ? 1u : 0u; mine = (j == x) ? c : mine; }
        if (sum == G) break;
        __builtin_amdgcn_s_sleep(1);
        if ((++sp & 255u) == 0u) { if (xb_ld(&bar[XB_TMO])) break; if (sp > XB_SPIN_CAP) { atomicAdd(&bar[XB_TMO], 1u); break; } }
    }
    nloc = mine > 0u ? mine : 1u; nx = cnt > 0u ? cnt : 1u;
}

__device__ __forceinline__ void xcd_barrier(const XcdBarrier& b) {
    asm volatile("s_waitcnt vmcnt(0)" ::: "memory");
    __syncthreads();
    if (threadIdx.x == 0) {
        unsigned* bar = b.bar;
        __builtin_amdgcn_s_waitcnt(0);
        unsigned nloc = b.st[0], nx = b.st[1];
        if (nloc == 0u) { xcd_barrier_complete(bar, b.x, nloc, nx); b.st[0] = nloc; b.st[1] = nx; }
        const unsigned old = xb_add(&bar[XB_XSUB(b.x)], 1u);
        const unsigned gen = old / nloc;
        if (old + 1u == (gen + 1u) * nloc) {
            __builtin_amdgcn_fence(__ATOMIC_RELEASE, "agent");
            asm volatile("s_waitcnt vmcnt(0)" ::: "memory");
            const unsigned og = xb_add(&bar[XB_TOP], 1u);
            const unsigned tg = og / nx;
            if (og + 1u == (tg + 1u) * nx) xb_add(&bar[XB_TOPGEN], 1u);
            else XB_SPIN(xb_ld(&bar[XB_TOPGEN]) == tg, bar);
            __builtin_amdgcn_fence(__ATOMIC_ACQUIRE, "agent");
            xb_add(&bar[XB_XGEN(b.x)], 1u);
            asm volatile("s_waitcnt vmcnt(0)" ::: "memory");
        } else {
            XB_SPIN(xb_ld(&bar[XB_XGEN(b.x)]) == gen, bar);
            __builtin_amdgcn_fence(__ATOMIC_ACQUIRE, "agent");
            asm volatile("s_waitcnt vmcnt(0)" ::: "memory");
        }
    }
    __syncthreads();
}

constexpr int NWAVES = 8;
constexpr int T = 24576, TP = 16384, DM = 2048, DFF = 8192, PLE = 256, DEPTH = 4;
constexpr int LATN = 1280;
constexpr float EPS = 1e-6f;
constexpr int MCH = 8192, NCH = 3;
constexpr size_t MiB = 1u << 20;
constexpr size_t WS_CTL = 0, CTL_ZERO_BYTES = 1 * MiB;
constexpr size_t WS_ROT = 1 * MiB;
constexpr size_t WS_BT = 5 * MiB;
constexpr size_t WS_W = 6 * MiB;
constexpr size_t W_MLA = 20 * MiB, W_SWA = 20 * MiB, W_LAYER = 73 * MiB;
constexpr size_t WO_WD = 0, WO_WUQ = 5 * MiB, WO_WUKV = 8 * MiB, WO_WOM = 12 * MiB;
constexpr size_t WO_WQKV = 0, WO_WOS = 12 * MiB;
constexpr size_t WO_UP = 0, WO_DN = 32 * MiB, WO_PU = 64 * MiB, WO_G = 65 * MiB;
constexpr size_t WS_WMLA = WS_W, WS_WSWA = WS_WMLA + 2 * W_MLA, WS_WLAY = WS_WSWA + 2 * W_SWA, WS_WEND = WS_WLAY + 4 * W_LAYER;
constexpr size_t WS_PB = WS_WEND;
constexpr size_t WS_XN = WS_PB + 12 * MiB;
constexpr size_t WS_H = WS_XN + 96 * MiB;
constexpr size_t WS_LAT = WS_H, WS_CQ = WS_H + 120 * MiB, WS_CKV = WS_CQ + 24 * MiB;
constexpr size_t WS_R = WS_H + 192 * MiB;
constexpr size_t WS_E = WS_R, WS_HID = WS_R + 96 * MiB;
constexpr size_t WS_Q = WS_R, WS_KV = WS_R + 144 * MiB, WS_KR = WS_KV + 192 * MiB;
constexpr size_t WS_QKV = WS_R;
constexpr size_t WS_END = WS_KR + 3 * MiB;
static_assert(WS_CKV + 24 * MiB <= WS_R && WS_HID + 128 * MiB <= WS_END && WS_END <= 1024 * MiB, "d_ws map");
constexpr int CW_BAR = 4096;
constexpr int RING_OFF = 0, RING_BYTES = 131072;
constexpr int LDSCTL_OFF = RING_BYTES, MISC_OFF = LDSCTL_OFF + 320;
constexpr int LDS_BYTES = 147456;
static_assert(MISC_OFF + 128 <= LDS_BYTES && att::ATT_LDS_BYTES <= RING_BYTES, "LDS map");

__device__ __forceinline__ float wave_sum(float v) {
#pragma unroll
    for (int o = 1; o < 64; o <<= 1) v += __shfl_xor(v, o);
    return v;
}
__device__ __forceinline__ float sq4(f32x4 v) { return (v.x * v.x + v.y * v.y) + (v.z * v.z + v.w * v.w); }
typedef unsigned u32x2 __attribute__((ext_vector_type(2)));
__device__ __forceinline__ u32x2 pk4(f32x4 v) { u32x2 r; r.x = pg8::cvt_pk_bf16(v.x, v.y); r.y = pg8::cvt_pk_bf16(v.z, v.w); return r; }
__device__ __forceinline__ f32x4 unpk4(u32x2 w) { f32x4 e; e.x = __uint_as_float(w.x << 16); e.y = __uint_as_float(w.x & 0xffff0000u); e.z = __uint_as_float(w.y << 16); e.w = __uint_as_float(w.y & 0xffff0000u); return e; }

__device__ __forceinline__ int cmap(int mode, int n) {
    if (mode == 1) { if (n < 1024) return n; if (n >= 1088) return -1; const int r = n - 1024; return 1024 + (r >> 1) + 32 * (r & 1); }
    if (mode == 2) { const int h = n / 192, r = n % 192; if (r < 128) return n; const int q = r - 128; return h * 192 + 128 + (q >> 1) + 32 * (q & 1); }
    return n;
}
__device__ __forceinline__ void p0_transpose_item(const float* W, int K, int Nsrc, int Ndst, bf16* WT, int mode, LAS float* scr, int item, int lane) {
    const int nblk = Ndst / 32, kb = item / nblk, nb = item % nblk, k0 = 64 * kb, n0 = 32 * nb;
    const int sc = cmap(mode, n0 + (lane & 31));
#pragma unroll 8
    for (int i = 0; i < 32; ++i) { const int kk = 2 * i + (lane >> 5); scr[kk * 33 + (lane & 31)] = sc >= 0 ? W[(size_t)(k0 + kk) * Nsrc + sc] : 0.f; }
    LDS_WAIT(); asm volatile("" ::: "memory");
    const int c = lane & 7;
#pragma unroll
    for (int j = 0; j < 4; ++j) { const int n = (lane >> 3) + 8 * j; const LAS float* s = scr + (8 * c) * 33 + n;
        v4u o; o.x = pk2(s[0 * 33], s[1 * 33]); o.y = pk2(s[2 * 33], s[3 * 33]); o.z = pk2(s[4 * 33], s[5 * 33]); o.w = pk2(s[6 * 33], s[7 * 33]);
        *(GAS v4u*)(WT + (size_t)(n0 + n) * K + k0 + 8 * c) = o; }
    LDS_WAIT(); asm volatile("" ::: "memory");
}

struct Args { const float* in[20]; float* out; unsigned char* ws; };
#define ZERO() ({ int z__; asm volatile("s_mov_b32 %0, 0" : "=s"(z__)); z__; })
#define WSP(T_, off) ((T_*)(args.ws + (size_t)(off) + (size_t)ZERO()))
#define INP(k) (args.in[(k) + ZERO()])
__global__ void __launch_bounds__(NWAVES * 64, 2) trunk_fwd(Args args) {
    extern __shared__ __attribute__((aligned(16))) unsigned char lds_raw[];
    LAS unsigned char* lds = (LAS unsigned char*)lds_raw;
    volatile LAS unsigned* MISC = (volatile LAS unsigned*)(lds + MISC_OFF);
    const int tid = threadIdx.x, lane0 = tid & 63, wave = __builtin_amdgcn_readfirstlane(tid >> 6);
#define LANE_DECL() int lane = lane0; asm volatile("" : "+v"(lane)); int gwl = gw; asm volatile("" : "+s"(gwl))
    const int G = gridDim.x; const int bx = blockIdx.x; const int vcu = (G % 8 == 0) ? (bx % 8) * (G / 8) + bx / 8 : bx;
    for (int u = tid; u < (LDS_BYTES - LDSCTL_OFF) / 4; u += NWAVES * 64) ((LAS unsigned*)(lds + LDSCTL_OFF))[u] = 0u;
    __syncthreads();
    XcdBarrier bar = xcd_barrier_post((unsigned*)(args.ws + WS_CTL) + CW_BAR, MISC + 8);
#define GRID_BAR() xcd_barrier(bar)
    const int gw = vcu * NWAVES + wave, NGW = G * NWAVES;
#define XROW_IN(m) ((m) < TP ? xin0 + (size_t)(m) * DM : xin1 + (size_t)((m) - TP) * DM)

    {
        LANE_DECL(); LAS float* scr = (LAS float*)(lds + RING_OFF + wave * 16384);
        unsigned char* ws = args.ws;
        int rot_ = 0;
#define CVT(Wsrc, K_, Nsrc_, Ndst_, dst_, mode_) do { const int nit_ = ((K_) / 64) * ((Ndst_) / 32); \
            for (int it_ = (gwl + NGW - rot_) % NGW; it_ < nit_; it_ += NGW) p0_transpose_item((Wsrc), (K_), (Nsrc_), (Ndst_), (dst_), (mode_), scr, it_, lane); rot_ = (rot_ + nit_) % NGW; } while (0)
        for (int j = 0; j < 2; ++j) {
            unsigned char* wm = ws + WS_WMLA + j * W_MLA; unsigned char* wsw = ws + WS_WSWA + j * W_SWA;
            CVT(args.in[5] + (size_t)j * DM * 1088, DM, 1088, LATN, (bf16*)(wm + WO_WD), 1);
            CVT(args.in[8] + (size_t)j * 512 * 3072, 512, 3072, 3072, (bf16*)(wm + WO_WUQ), 2);
            CVT(args.in[9] + (size_t)j * 512 * 4096, 512, 4096, 4096, (bf16*)(wm + WO_WUKV), 0);
            CVT(args.in[10] + (size_t)j * DM * DM, DM, DM, DM, (bf16*)(wm + WO_WOM), 0);
            CVT(args.in[11] + (size_t)j * DM * 3072, DM, 3072, 3072, (bf16*)(wsw + WO_WQKV), 0);
            CVT(args.in[13] + (size_t)j * DM * DM, DM, DM, DM, (bf16*)(wsw + WO_WOS), 0);
        }
        for (int L = 0; L < DEPTH; ++L) {
            unsigned char* wl = ws + WS_WLAY + L * W_LAYER;
            CVT(args.in[15] + (size_t)L * DM * DFF, DM, DFF, DFF, (bf16*)(wl + WO_UP), 0);
            CVT(args.in[16] + (size_t)L * DFF * DM, DFF, DM, DM, (bf16*)(wl + WO_DN), 0);
            CVT(args.in[17] + (size_t)L * PLE * DM, PLE, DM, DM, (bf16*)(wl + WO_PU), 0);
            CVT(args.in[18] + (size_t)L * DM * DM, DM, DM, DM, (bf16*)(wl + WO_G), 0);
        }
#undef CVT
        float* rot = (float*)(ws + WS_ROT);
        for (int i = vcu * (NWAVES * 64) + tid; i < 16384 * 32; i += G * NWAVES * 64) {
            const int pos = i >> 5, d = i & 31; double inv = 1.0; for (int k = 0; k < d; ++k) inv *= 0.74989420933245582730;
            const double turns = (double)pos * inv * 0.15915494309189533577; const float fr = (float)(turns - __builtin_rint(turns));
            rot[2 * i] = __builtin_amdgcn_cosf(fr); rot[2 * i + 1] = __builtin_amdgcn_sinf(fr);
        }
        float* btg = (float*)(ws + WS_BT);
        for (int i = vcu * (NWAVES * 64) + tid; i < 16 * 257; i += G * NWAVES * 64) {
            const int h = i / 257, idx = i % 257, rel = idx - 128, n = rel < 0 ? -rel : rel;
            int b = n < 8 ? n : 8 + (n >= 12) + (n >= 16) + (n >= 23) + (n >= 32) + (n >= 46) + (n >= 64) + (n >= 91); if (b > 15) b = 15; if (rel > 0) b += 16;
            btg[h * att::BT_STRIDE + idx] = args.in[14][b * 16 + h] * 1.4426950408889634f;
        }
    }
    for (int L = 0; L < DEPTH; ++L) {
        const int j = L >> 1; const bool mla = (L & 1) == 0;
        { LANE_DECL(); const float* X = args.out + ZERO(); const float* xin0 = (L == 0) ? INP(0) : X; const float* xin1 = (L == 0) ? INP(1) : X + (size_t)TP * DM; const float* g0 = INP(4) + (size_t)(L * 4 + 0) * DM; bf16* XN = WSP(bf16, WS_XN);
          for (int m = gwl; m < T; m += NGW) {
            const float* xr = XROW_IN(m);
            f32x4 v[8]; float ss = 0.f;
#pragma unroll
            for (int q = 0; q < 8; ++q) { v[q] = *(const f32x4*)(xr + 256 * q + 4 * lane); ss += sq4(v[q]); }
            const float r = 1.0f / sqrtf(wave_sum(ss) * (1.0f / DM) + EPS);
#pragma unroll
            for (int q = 0; q < 8; ++q) { const f32x4 g = *(const f32x4*)(g0 + 256 * q + 4 * lane); *(u32x2*)(XN + (size_t)m * DM + 256 * q + 4 * lane) = pk4(v[q] * r * g); }
          } }
        GRID_BAR();
        if (mla) {
#ifndef DBG_NO_GEMM
            { pg8::Gemm g{WSP(bf16, WS_XN), WSP(bf16, WS_WMLA + j * W_MLA + WO_WD), T, LATN, DM}; pg8::StaticOrder S; S.init(T, LATN, G, bx); pg8::EpiF32 E{WSP(float, WS_LAT), LATN};
#ifndef DBG_NO_S1
              pg8::gemm_phase<pg8::EpiF32, pg8::StaticOrder, true, true>(lds + RING_OFF, g, S, E);
#endif
            }
#endif
            GRID_BAR();
            { LANE_DECL(); const float* qn = INP(6) + j * 512; const float* kn = INP(7) + j * 512; const float* LAT = WSP(float, WS_LAT); bf16* CQ = WSP(bf16, WS_CQ); bf16* CKV = WSP(bf16, WS_CKV); bf16* KRB = WSP(bf16, WS_KR);
              const float* rot = WSP(float, WS_ROT);
              for (int m = gwl; m < T; m += NGW) { const float* lr = LAT + (size_t)m * LATN;
                const f32x4 a0 = *(const f32x4*)(lr + 4 * lane), a1 = *(const f32x4*)(lr + 256 + 4 * lane), b0 = *(const f32x4*)(lr + 512 + 4 * lane), b1 = *(const f32x4*)(lr + 768 + 4 * lane);
                const float rq = 1.0f / sqrtf(wave_sum(sq4(a0) + sq4(a1)) * (1.0f / 512) + EPS), rk = 1.0f / sqrtf(wave_sum(sq4(b0) + sq4(b1)) * (1.0f / 512) + EPS);
                *(u32x2*)(CQ + (size_t)m * 512 + 4 * lane) = pk4(a0 * rq * *(const f32x4*)(qn + 4 * lane)); *(u32x2*)(CQ + (size_t)m * 512 + 256 + 4 * lane) = pk4(a1 * rq * *(const f32x4*)(qn + 256 + 4 * lane));
                *(u32x2*)(CKV + (size_t)m * 512 + 4 * lane) = pk4(b0 * rk * *(const f32x4*)(kn + 4 * lane)); *(u32x2*)(CKV + (size_t)m * 512 + 256 + 4 * lane) = pk4(b1 * rk * *(const f32x4*)(kn + 256 + 4 * lane));
                if (lane < 32) { const int pos = m < TP ? m : ((m - TP) & 4095); const float x1 = lr[1024 + 2 * lane], x2 = lr[1025 + 2 * lane]; const float c = rot[(pos * 32 + lane) * 2], s = rot[(pos * 32 + lane) * 2 + 1];
                    *(unsigned*)(KRB + (size_t)m * 64 + 2 * lane) = pg8::cvt_pk_bf16(x1 * c - x2 * s, x2 * c + x1 * s); } } }
            GRID_BAR();
#ifndef DBG_NO_GEMM
            { pg8::Gemm g{WSP(bf16, WS_CQ), WSP(bf16, WS_WMLA + j * W_MLA + WO_WUQ), T, 3072, 512}; pg8::StaticOrder S; S.init(T, 3072, G, bx); pg8::EpiQRope E{WSP(bf16, WS_Q), 3072, WSP(float, WS_ROT)};
#ifndef DBG_NO_S2
              pg8::gemm_phase<pg8::EpiQRope, pg8::StaticOrder, true, true>(lds + RING_OFF, g, S, E);
#endif
            }
            { pg8::Gemm g{WSP(bf16, WS_CKV), WSP(bf16, WS_WMLA + j * W_MLA + WO_WUKV), T, 4096, 512}; pg8::StaticOrder S; S.init(T, 4096, G, bx); pg8::EpiBf16<0> E{WSP(bf16, WS_KV), 4096};
#ifndef DBG_NO_S3
              pg8::gemm_phase<pg8::EpiBf16<0>, pg8::StaticOrder, true, true>(lds + RING_OFF, g, S, E);
#endif
            }
#endif
            GRID_BAR();
#ifndef DBG_NO_MLA
            { const bf16* QB = WSP(bf16, WS_Q); const bf16* KVB = WSP(bf16, WS_KV); const bf16* KRB = WSP(bf16, WS_KR); bf16* OB = WSP(bf16, WS_XN);
              for (int u = vcu; u < 1536; u += G) {
                int s0, S_, h, qb;
                if (u < 1024) { s0 = 0; S_ = TP; h = u >> 6; qb = u & 63; } else { const int v = u - 1024; s0 = TP + (v >> 8) * 4096; S_ = 4096; h = (v & 255) >> 4; qb = v & 15; }
                const int q0 = s0 + qb * 256 + wave * 32;
                att::attn_unit<false>(QB + (size_t)q0 * 3072 + h * 192, 3072, KVB + (size_t)s0 * 4096 + h * 256, KRB + (size_t)s0 * 64, KVB + (size_t)s0 * 4096 + h * 256 + 128, 4096,
                                      OB + (size_t)q0 * DM + h * 128, DM, S_ / 64, 0, 0.07216878364870322f * 1.4426950408889634f, 0.f, lds + RING_OFF, nullptr);
              } }
#endif
        } else {
#ifndef DBG_NO_GEMM
            { pg8::Gemm g{WSP(bf16, WS_XN), WSP(bf16, WS_WSWA + j * W_SWA + WO_WQKV), T, 3072, DM}; pg8::StaticOrder S; S.init(T, 3072, G, bx); pg8::EpiBf16<0> E{WSP(bf16, WS_QKV), 3072};
#ifndef DBG_NO_S4
              pg8::gemm_phase<pg8::EpiBf16<0>, pg8::StaticOrder, true, true>(lds + RING_OFF, g, S, E);
#endif
            }
#endif
            GRID_BAR();
#ifndef DBG_NO_SWA
            { LAS float* btl = (LAS float*)(lds + RING_OFF + att::BT_OFF); const float* btg = WSP(float, WS_BT);
              int tl = tid; asm volatile("" : "+v"(tl));
              for (int i = tl; i < 16 * att::BT_STRIDE; i += NWAVES * 64) btl[i] = (i % att::BT_STRIDE) < 257 ? btg[i] : 0.f;
              __syncthreads();
              const float* sink = INP(12) + j * 16; const bf16* QKV = WSP(bf16, WS_QKV); bf16* OB = WSP(bf16, WS_XN);
              for (int u = vcu; u < 1536; u += G) {
                  const int kvh = u / 384, rb = u % 384, q0 = rb * 64; int s0, S_;
                  if (q0 < TP) { s0 = 0; S_ = TP; } else { s0 = TP + ((q0 - TP) >> 12) * 4096; S_ = 4096; }
                  const int lo = max(q0 - 128, s0), hi_ = min(q0 + 192, s0 + S_), NT = (hi_ - lo) >> 6;
                  const int hq = kvh * 4 + (wave & 3), qw = q0 + 32 * (wave >> 2);
                  att::attn_unit<true>(QKV + (size_t)qw * 3072 + hq * 128, 3072, QKV + (size_t)lo * 3072 + 2048 + kvh * 128, nullptr, QKV + (size_t)lo * 3072 + 2560 + kvh * 128, 3072,
                                       OB + (size_t)qw * DM + hq * 128, DM, NT, lo - qw, 0.08838834764831845f * 1.4426950408889634f, sink[hq] * 1.4426950408889634f, lds + RING_OFF, btl + hq * att::BT_STRIDE);
              } }
#endif
        }
        GRID_BAR();
#ifndef DBG_NO_GEMM
        { const bf16* wo = mla ? WSP(bf16, WS_WMLA + j * W_MLA + WO_WOM) : WSP(bf16, WS_WSWA + j * W_SWA + WO_WOS);
          pg8::Gemm g{WSP(bf16, WS_XN), wo, T, DM, DM}; pg8::StaticOrder S; S.init(T, DM, G, bx); pg8::EpiF32 E{WSP(float, WS_H), DM};
#ifndef DBG_NO_S5
          pg8::gemm_phase<pg8::EpiF32, pg8::StaticOrder, true, true>(lds + RING_OFF, g, S, E);
#endif
            }
#endif
        GRID_BAR();
        { LANE_DECL(); float* X = args.out + ZERO(); const float* xin0 = (L == 0) ? INP(0) : X; const float* xin1 = (L == 0) ? INP(1) : X + (size_t)TP * DM; const float* g1 = INP(4) + (size_t)(L * 4 + 1) * DM; const float* g2 = g1 + DM; bf16* XN = WSP(bf16, WS_XN); const float* H = WSP(float, WS_H);
          const float* pp = INP(2) + (size_t)L * TP * PLE; const float* psm = INP(3) + (size_t)L * (T - TP) * PLE; bf16* PB = WSP(bf16, WS_PB);
          for (int m = gwl; m < T; m += NGW) {
            const float* xr = XROW_IN(m); const float* hr = H + (size_t)m * DM;
            f32x4 v[8], hv[8]; float ss = 0.f;
#pragma unroll
            for (int q = 0; q < 8; ++q) { hv[q] = *(const f32x4*)(hr + 256 * q + 4 * lane); v[q] = *(const f32x4*)(xr + 256 * q + 4 * lane); ss += sq4(hv[q]); }
            const float rh = 1.0f / sqrtf(wave_sum(ss) * (1.0f / DM) + EPS); float sx = 0.f;
#pragma unroll
            for (int q = 0; q < 8; ++q) { v[q] = v[q] + hv[q] * rh * *(const f32x4*)(g1 + 256 * q + 4 * lane); sx += sq4(v[q]); *(f32x4*)(X + (size_t)m * DM + 256 * q + 4 * lane) = v[q]; }
            const float rx = 1.0f / sqrtf(wave_sum(sx) * (1.0f / DM) + EPS);
#pragma unroll
            for (int q = 0; q < 8; ++q) *(u32x2*)(XN + (size_t)m * DM + 256 * q + 4 * lane) = pk4(v[q] * rx * *(const f32x4*)(g2 + 256 * q + 4 * lane));
            const float* pr = m < TP ? pp + (size_t)m * PLE : psm + (size_t)(m - TP) * PLE;
            *(u32x2*)(PB + (size_t)m * PLE + 4 * lane) = pk4(*(const f32x4*)(pr + 4 * lane));
          } }
        GRID_BAR();
        for (int c = 0; c < NCH; ++c) {
#ifndef DBG_NO_GEMM
            { pg8::Gemm g{WSP(bf16, WS_XN) + (size_t)c * MCH * DM, WSP(bf16, WS_WLAY + L * W_LAYER + WO_UP), MCH, DFF, DM}; pg8::StaticOrder S; S.init(MCH, DFF, G, bx); pg8::EpiBf16<1> E{WSP(bf16, WS_HID), DFF};
#ifndef DBG_NO_S6
              pg8::gemm_phase<pg8::EpiBf16<1>, pg8::StaticOrder, true, true>(lds + RING_OFF, g, S, E);
#endif
            }
#endif
            GRID_BAR();
#ifndef DBG_NO_GEMM
            { pg8::Gemm g{WSP(bf16, WS_HID), WSP(bf16, WS_WLAY + L * W_LAYER + WO_DN), MCH, DM, DFF}; pg8::StaticOrder S; S.init(MCH, DM, G, bx); pg8::EpiF32 E{WSP(float, WS_H) + (size_t)c * MCH * DM, DM};
#ifndef DBG_NO_S7
              pg8::gemm_phase<pg8::EpiF32, pg8::StaticOrder, true, true>(lds + RING_OFF, g, S, E);
#endif
            }
            { pg8::Gemm g{WSP(bf16, WS_PB) + (size_t)c * MCH * PLE, WSP(bf16, WS_WLAY + L * W_LAYER + WO_PU), MCH, DM, PLE + ZERO()}; pg8::StaticOrder S; S.init(MCH, DM, G, bx); pg8::EpiBf16<0> E{WSP(bf16, WS_E) + (size_t)c * MCH * DM, DM};
#ifndef DBG_NO_S8
              pg8::gemm_phase<pg8::EpiBf16<0>, pg8::StaticOrder, true, true>(lds + RING_OFF, g, S, E);
#endif
            }
#endif
            GRID_BAR();
        }
        { LANE_DECL(); const float* pn = INP(19) + (size_t)L * DM; const float* g3 = INP(4) + (size_t)(L * 4 + 3) * DM; float* X = args.out + ZERO(); bf16* XN = WSP(bf16, WS_XN); const float* H = WSP(float, WS_H); bf16* EB = WSP(bf16, WS_E);
          for (int m = gwl; m < T; m += NGW) {
            const float* hr = H + (size_t)m * DM; float* xr = X + (size_t)m * DM; bf16* er = EB + (size_t)m * DM;
            f32x4 v[8], hv[8]; float ss = 0.f;
#pragma unroll
            for (int q = 0; q < 8; ++q) { hv[q] = *(const f32x4*)(hr + 256 * q + 4 * lane); v[q] = *(const f32x4*)(xr + 256 * q + 4 * lane); ss += sq4(hv[q]); }
            const float rh = 1.0f / sqrtf(wave_sum(ss) * (1.0f / DM) + EPS);
#pragma unroll
            for (int q = 0; q < 8; ++q) { v[q] = v[q] + hv[q] * rh * *(const f32x4*)(g3 + 256 * q + 4 * lane); *(f32x4*)(xr + 256 * q + 4 * lane) = v[q]; *(u32x2*)(XN + (size_t)m * DM + 256 * q + 4 * lane) = pk4(v[q]); }
            float se = 0.f;
#pragma unroll
            for (int q = 0; q < 8; ++q) { hv[q] = unpk4(*(const u32x2*)(er + 256 * q + 4 * lane)); se += sq4(hv[q]); }
            const float re = 1.0f / sqrtf(wave_sum(se) * (1.0f / DM) + EPS);
#pragma unroll
            for (int q = 0; q < 8; ++q) *(u32x2*)(er + 256 * q + 4 * lane) = pk4(hv[q] * re * *(const f32x4*)(pn + 256 * q + 4 * lane));
          } }
        GRID_BAR();
#ifndef DBG_NO_GEMM
        { pg8::Gemm g{WSP(bf16, WS_XN), WSP(bf16, WS_WLAY + L * W_LAYER + WO_G), T, DM, DM}; pg8::StaticOrder S; S.init(T, DM, G, bx); pg8::EpiGate E{args.out + ZERO(), WSP(bf16, WS_E), DM};
#ifndef DBG_NO_S9
          pg8::gemm_phase<pg8::EpiGate, pg8::StaticOrder, true, true>(lds + RING_OFF, g, S, E);
#endif
            }
#endif
        if (L + 1 < DEPTH) GRID_BAR();
    }
#undef GRID_BAR
#undef XROW_IN
}

extern "C" void kernel_launch(void* const* d_in, const int* in_sizes, int n_in, void* d_out, int out_size, void* d_ws, size_t ws_size, hipStream_t stream) {
    static int grid = 0;
    if (grid == 0) {
        if (n_in != 20 || out_size != T * DM || ws_size < WS_END) { fprintf(stderr, "kernel_launch: unexpected shapes: n_in %d out %d ws %zu (need %zu)\n", n_in, out_size, ws_size, (size_t)WS_END); grid = -1; return; }
        int dev = 0, cus = 0, per_cu = 0;
        if (hipGetDevice(&dev) != hipSuccess || hipDeviceGetAttribute(&cus, hipDeviceAttributeMultiprocessorCount, dev) != hipSuccess) { grid = -1; return; }
        if (hipFuncSetAttribute((const void*)trunk_fwd, hipFuncAttributeMaxDynamicSharedMemorySize, LDS_BYTES) != hipSuccess) { fprintf(stderr, "kernel_launch: hipFuncSetAttribute failed\n"); grid = -1; return; }
        if (hipOccupancyMaxActiveBlocksPerMultiprocessor(&per_cu, (const void*)trunk_fwd, NWAVES * 64, LDS_BYTES) != hipSuccess || per_cu < 1) fprintf(stderr, "kernel_launch: occupancy query reports %d\n", per_cu);
        (void)hipGetLastError();
        grid = cus;
    }
    if (grid < 0) return;
    if (hipMemsetAsync((char*)d_ws + WS_CTL, 0, CTL_ZERO_BYTES, stream) != hipSuccess) return;
    Args a{};
    for (int i = 0; i < 20; ++i) a.in[i] = (const float*)d_in[i];
    a.out = (float*)d_out; a.ws = (unsigned char*)d_ws;
    hipLaunchKernelGGL(trunk_fwd, dim3(grid), dim3(NWAVES * 64), LDS_BYTES, stream, a);
    const hipError_t le = hipPeekAtLastError();
    if (le != hipSuccess) fprintf(stderr, "kernel_launch: launch failed: %s\n", hipGetErrorName(le));
}
```

```cpp
#include <hip/hip_runtime.h>
#include <cstdio>
#include <cstdint>
namespace pg8 {
#define PG8_LAS __attribute__((address_space(3)))
typedef unsigned short bf16_t;
typedef short bf16x8 __attribute__((ext_vector_type(8)));
typedef float f32x4 __attribute__((ext_vector_type(4)));
typedef unsigned u32x4 __attribute__((ext_vector_type(4)));
constexpr int BM = 256, BK = 64, HALF = 128, HTB = HALF * BK * 2  , STAGE_BYTES = 8 * HTB, NXCD = 8, WGM = 8;

__host__ __device__ __forceinline__ int lds_byte(int r, int c) { const int st = (r >> 4) * 2 + (c >> 5), rr = r & 15, cc = c & 31, ob = rr * 64 + cc * 2; return st * 1024 + (ob ^ (((ob >> 9) & 1) << 5)); }
__host__ __device__ __forceinline__ void stage_rc(int b, int& R, int& C) { const int st = b / 1024, sb = b % 1024, swz = sb ^ (((sb >> 9) & 1) << 5); R = (st >> 1) * 16 + swz / 64; C = (st & 1) * 32 + (swz % 64) / 2; }
__host__ __device__ __forceinline__ int perm32(int rho) { const int n = rho >> 4, i = rho & 15; return 8 * (i >> 2) + 4 * n + (i & 3); }

struct Unit { int pm, pn; };
struct Gemm { const bf16_t* A; const bf16_t* Bt; int M, N, K; };

struct StaticOrder {
    int nM, nN, nwg, G, c;
    __host__ __device__ void init(int M, int N, int G_, int c_) { nM = M / BM; nN = N / BM; nwg = nM * nN; G = G_; c = c_; }
    __host__ __device__ bool next(int i, Unit& u) const {
        const long L = (long)i * G + c; if (L >= nwg) return false;
        int wgid = (int)L; { const int q = nwg / NXCD, r = nwg % NXCD, xcd = wgid % NXCD, off = wgid / NXCD; wgid = (xcd < r ? xcd * (q + 1) : r * (q + 1) + (xcd - r) * q) + off; }
        const int nig = WGM * nN, gid = wgid / nig, fm = gid * WGM, gsz = (nM - fm) < WGM ? (nM - fm) : WGM;
        u.pm = fm + ((wgid % nig) % gsz); u.pn = (wgid % nig) / gsz; return true;
    }
    __device__ __forceinline__ void a_ready(const Unit&) const {}
    __device__ __forceinline__ void done(const Unit&) const {}
};

__device__ __forceinline__ unsigned cvt_pk_bf16(float lo, float hi) { unsigned r; asm volatile("v_cvt_pk_bf16_f32 %0, %1, %2" : "=v"(r) : "v"(lo), "v"(hi)); return r; }
typedef float f32x2 __attribute__((ext_vector_type(2)));

constexpr float RMS_EPS = 1e-6f;
template <int NP> __device__ __forceinline__ float row_rs(const float* ss, int row, float inv_d) {
    float s;
    if (NP == 1) s = ss[row];
    else { const f32x4 a = *(const f32x4*)(ss + (size_t)row * 8), b = *(const f32x4*)(ss + (size_t)row * 8 + 4); s = ((a[0] + a[1]) + (a[2] + a[3])) + ((b[0] + b[1]) + (b[2] + b[3])); }
    return __builtin_amdgcn_rsqf(s * inv_d + RMS_EPS);
}
__device__ __forceinline__ void stat_put(float* ps, int row, int ns, int slot, float part, int fq) {
    part += __shfl_xor(part, 16); part += __shfl_xor(part, 32);
    if (fq == 0) ps[(size_t)row * ns + slot] = part;
}
__device__ __forceinline__ float sq4v(f32x4 v) { return (v[0] * v[0] + v[1] * v[1]) + (v[2] * v[2] + v[3] * v[3]); }

template <int ACT  , int RS  , bool STAT  > struct EpiBf16 {
    static constexpr bool PERM = true, AFTER_DRAIN = false;
    bf16_t* O; int ldc; const float* ss_in; float inv_d; float* ss_out; int row_off;
    __device__ __forceinline__ void operator()(const f32x4 (&acc)[2][2][4][2], const Unit& u, int wr, int wc, int fr, int fq) const {
        const int row0 = u.pm * BM + wr * 64 + fr, col0 = u.pn * BM + wc * 32 + 8 * fq;
#pragma unroll
        for (int ai = 0; ai < 2; ++ai)
#pragma unroll
            for (int m = 0; m < 4; ++m) { const int row = row0 + ai * HALF + m * 16; bf16_t* rowp = O + (size_t)row * ldc + col0;
                float rs = 1.f; if (RS) { rs = row_rs<(RS ? RS : 1)>(ss_in, row_off + row, inv_d); if (ACT == 1) rs = rs * rs; }
                float part = 0.f;
#pragma unroll
                for (int bj = 0; bj < 2; ++bj) { f32x4 v0 = acc[ai][bj][m][0], v1 = acc[ai][bj][m][1];
                    if (ACT == 1) { f32x4 r0, r1;
#pragma unroll
                        for (int e = 0; e < 4; ++e) { float a_, b_; asm("v_max_f32_e32 %0, 0, %1" : "=v"(a_) : "v"(v0[e])); asm("v_max_f32_e32 %0, 0, %1" : "=v"(b_) : "v"(v1[e])); r0[e] = a_; r1[e] = b_; }
                        v0 = v0 * r0; v1 = v1 * r1; }
                    if (RS) { v0 = v0 * rs; v1 = v1 * rs; }
                    if (STAT) part += sq4v(v0) + sq4v(v1);
                    u32x4 w; w.x = cvt_pk_bf16(v0[0], v0[1]); w.y = cvt_pk_bf16(v0[2], v0[3]); w.z = cvt_pk_bf16(v1[0], v1[1]); w.w = cvt_pk_bf16(v1[2], v1[3]);
                    *(u32x4*)(rowp + bj * HALF) = w; }
                if (STAT) stat_put(ss_out, row_off + row, 32, u.pn * 4 + wc, part, fq); }
    }
};
struct EpiLat {
    static constexpr bool PERM = true, AFTER_DRAIN = false;
    bf16_t* CQ; bf16_t* CKV; bf16_t* KR; const float* ss_in; float* ssq; float* sskv; const float* rot;
    __device__ __forceinline__ void operator()(const f32x4 (&acc)[2][2][4][2], const Unit& u, int wr, int wc, int fr, int fq) const {
        const int row0 = u.pm * BM + wr * 64 + fr, col0 = u.pn * BM + wc * 32 + 8 * fq;
        if (u.pn < 4) { float* ssd = u.pn < 2 ? ssq : sskv; bf16_t* C = (u.pn < 2 ? CQ : CKV) + (u.pn & 1) * BM + wc * 32 + 8 * fq;
#pragma unroll
            for (int ai = 0; ai < 2; ++ai)
#pragma unroll
                for (int m = 0; m < 4; ++m) { const int row = row0 + ai * HALF + m * 16; const float rs = row_rs<1>(ss_in, row, 1.0f / 2048.0f); float part = 0.f;
#pragma unroll
                    for (int bj = 0; bj < 2; ++bj) { const f32x4 v0 = acc[ai][bj][m][0] * rs, v1 = acc[ai][bj][m][1] * rs; part += sq4v(v0) + sq4v(v1);
                        u32x4 w; w.x = cvt_pk_bf16(v0[0], v0[1]); w.y = cvt_pk_bf16(v0[2], v0[3]); w.z = cvt_pk_bf16(v1[0], v1[1]); w.w = cvt_pk_bf16(v1[2], v1[3]);
                        *(u32x4*)(C + (size_t)row * 512 + bj * HALF) = w; }
                    stat_put(ssd, row, 8, (u.pn & 1) * 4 + wc, part, fq); }
        } else if (wc < 2) { const int d0 = 16 * wc + 4 * fq;
#pragma unroll
            for (int ai = 0; ai < 2; ++ai)
#pragma unroll
                for (int m = 0; m < 4; ++m) { const int row = row0 + ai * HALF + m * 16; const float rs = row_rs<1>(ss_in, row, 1.0f / 2048.0f); const int pos = row < 16384 ? row : ((row - 16384) & 4095);
                    const f32x4 v0 = acc[ai][0][m][0] * rs, v1 = acc[ai][0][m][1] * rs;
                    const f32x4 cs0 = *(const f32x4*)(rot + ((size_t)pos * 32 + d0) * 2), cs1 = *(const f32x4*)(rot + ((size_t)pos * 32 + d0 + 2) * 2);
                    u32x4 w; w.x = cvt_pk_bf16(v0[0] * cs0[0] - v0[1] * cs0[1], v0[1] * cs0[0] + v0[0] * cs0[1]); w.y = cvt_pk_bf16(v0[2] * cs0[2] - v0[3] * cs0[3], v0[3] * cs0[2] + v0[2] * cs0[3]);
                    w.z = cvt_pk_bf16(v1[0] * cs1[0] - v1[1] * cs1[1], v1[1] * cs1[0] + v1[0] * cs1[1]); w.w = cvt_pk_bf16(v1[2] * cs1[2] - v1[3] * cs1[3], v1[3] * cs1[2] + v1[2] * cs1[3]);
                    *(u32x4*)(KR + (size_t)row * 64 + 32 * wc + 8 * fq) = w; }
        }
    }
};
struct EpiQRope {
    static constexpr bool PERM = true, AFTER_DRAIN = false;
    bf16_t* O; int ldc; const float* rot; float scale; const float* ss_in;
    __device__ __forceinline__ void operator()(const f32x4 (&acc)[2][2][4][2], const Unit& u, int wr, int wc, int fr, int fq) const {
        const int row0 = u.pm * BM + wr * 64 + fr, col0 = u.pn * BM + wc * 32 + 8 * fq;
#pragma unroll
        for (int ai = 0; ai < 2; ++ai)
#pragma unroll
            for (int m = 0; m < 4; ++m) { const int row = row0 + ai * HALF + m * 16; const float rs = row_rs<8>(ss_in, row, 1.0f / 512.0f) * scale; const int pos = row < 16384 ? row : ((row - 16384) & 4095);
#pragma unroll
                for (int bj = 0; bj < 2; ++bj) {
                    const int sb = u.pn * BM + bj * HALF + wc * 32, hr = sb % 192; const bool rope = hr >= 128; const int d0 = ((hr - 128) >> 1) + 4 * fq;
                    f32x4 v0 = acc[ai][bj][m][0] * rs, v1 = acc[ai][bj][m][1] * rs;
                    if (rope) {
                        const f32x4 cs0 = *(const f32x4*)(rot + ((size_t)pos * 32 + d0) * 2), cs1 = *(const f32x4*)(rot + ((size_t)pos * 32 + d0 + 2) * 2);
                        f32x4 o0, o1;
                        o0[0] = v0[0] * cs0[0] - v0[1] * cs0[1]; o0[1] = v0[1] * cs0[0] + v0[0] * cs0[1];
                        o0[2] = v0[2] * cs0[2] - v0[3] * cs0[3]; o0[3] = v0[3] * cs0[2] + v0[2] * cs0[3];
                        o1[0] = v1[0] * cs1[0] - v1[1] * cs1[1]; o1[1] = v1[1] * cs1[0] + v1[0] * cs1[1];
                        o1[2] = v1[2] * cs1[2] - v1[3] * cs1[3]; o1[3] = v1[3] * cs1[2] + v1[2] * cs1[3];
                        v0 = o0; v1 = o1; }
                    u32x4 w; w.x = cvt_pk_bf16(v0[0], v0[1]); w.y = cvt_pk_bf16(v0[2], v0[3]); w.z = cvt_pk_bf16(v1[0], v1[1]); w.w = cvt_pk_bf16(v1[2], v1[3]);
                    *(u32x4*)(O + (size_t)row * ldc + col0 + bj * HALF) = w; } }
    }
};
struct EpiGate {
    static constexpr bool PERM = true, AFTER_DRAIN = false;
    const bf16_t* XBin; const bf16_t* E; bf16_t* XBout; float* OUT; int ldc; const float* sse; const float* pn; float* ss_out;
    __device__ __forceinline__ void operator()(const f32x4 (&acc)[2][2][4][2], const Unit& u, int wr, int wc, int fr, int fq) const {
        const int row0 = u.pm * BM + wr * 64 + fr, col0 = u.pn * BM + wc * 32 + 8 * fq;
        f32x4 g[2][2];
#pragma unroll
        for (int bj = 0; bj < 2; ++bj)
#pragma unroll
            for (int n = 0; n < 2; ++n) g[bj][n] = *(const f32x4*)(pn + col0 + bj * HALF + 4 * n);
#pragma unroll
        for (int am = 0; am < 4; ++am) { const int ai = am >> 1, m0 = (am & 1) * 2;
            u32x4 xw[4][2], ew[4][2]; float re[4];
#pragma unroll
            for (int m = m0; m < m0 + 2; ++m) { const int row = row0 + ai * HALF + m * 16; const size_t off = (size_t)row * ldc + col0; re[m] = sse[row];
#pragma unroll
                for (int bj = 0; bj < 2; ++bj) { xw[m][bj] = *(const u32x4*)(XBin + off + bj * HALF); ew[m][bj] = *(const u32x4*)(E + off + bj * HALF); } }
#pragma unroll
            for (int m = m0; m < m0 + 2; ++m) { const int row = row0 + ai * HALF + m * 16; const size_t off = (size_t)row * ldc + col0; const float rs = __builtin_amdgcn_rsqf(re[m] * (1.0f / 2048.0f) + RMS_EPS); float part = 0.f;
#pragma unroll
                for (int bj = 0; bj < 2; ++bj) { f32x4 r[2];
#pragma unroll
                    for (int n = 0; n < 2; ++n) { const unsigned x0 = n ? xw[m][bj].z : xw[m][bj].x, x1 = n ? xw[m][bj].w : xw[m][bj].y, e0 = n ? ew[m][bj].z : ew[m][bj].x, e1 = n ? ew[m][bj].w : ew[m][bj].y;
                        f32x4 x; x[0] = __uint_as_float(x0 << 16); x[1] = __uint_as_float(x0 & 0xffff0000u); x[2] = __uint_as_float(x1 << 16); x[3] = __uint_as_float(x1 & 0xffff0000u);
                        f32x4 ev; ev[0] = __uint_as_float(e0 << 16); ev[1] = __uint_as_float(e0 & 0xffff0000u); ev[2] = __uint_as_float(e1 << 16); ev[3] = __uint_as_float(e1 & 0xffff0000u);
                        ev = ev * g[bj][n] * rs; const f32x4 a = acc[ai][bj][m][n];
#pragma unroll
                        for (int k = 0; k < 4; ++k) { const float sg = __builtin_amdgcn_rcpf(1.0f + __builtin_amdgcn_exp2f(-1.4426950408889634f * a[k])); r[n][k] = x[k] + ev[k] * sg; } }
                    if (XBout) { part += sq4v(r[0]) + sq4v(r[1]); u32x4 w; w.x = cvt_pk_bf16(r[0][0], r[0][1]); w.y = cvt_pk_bf16(r[0][2], r[0][3]); w.z = cvt_pk_bf16(r[1][0], r[1][1]); w.w = cvt_pk_bf16(r[1][2], r[1][3]);
                        *(u32x4*)(XBout + off + bj * HALF) = w; }
                    else { *(f32x4*)(OUT + off + bj * HALF) = r[0]; *(f32x4*)(OUT + off + bj * HALF + 4) = r[1]; } }
                if (XBout) stat_put(ss_out, row, 32, u.pn * 4 + wc, part, fq); }
            asm volatile("" ::: "memory"); }
    }
};
__device__ __forceinline__ void pg8_dma2(unsigned v0, unsigned v1, const void* base, unsigned dst) { unsigned keep;
    asm volatile("s_mov_b32 %0, m0\n\ts_mov_b32 m0, %4\n\ts_nop 0\n\tglobal_load_lds_dwordx4 %1, %3\n\ts_add_u32 m0, m0, 0x2000\n\ts_nop 0\n\tglobal_load_lds_dwordx4 %2, %3\n\ts_mov_b32 m0, %0"
                 : "=&s"(keep) : "v"(v0), "v"(v1), "s"(base), "s"(dst) : "memory", "scc"); }
__device__ __forceinline__ void pg8_dma6(unsigned v0, unsigned v1, unsigned v2, unsigned v3, unsigned v4, unsigned v5, const void* b0, const void* b1, const void* b2, unsigned d0, unsigned d1, unsigned d2) { unsigned keep;
    asm volatile("s_mov_b32 %0, m0\n\ts_mov_b32 m0, %10\n\ts_nop 0\n\tglobal_load_lds_dwordx4 %1, %7\n\ts_add_u32 m0, m0, 0x2000\n\ts_nop 0\n\tglobal_load_lds_dwordx4 %2, %7\n\t"
                 "s_mov_b32 m0, %11\n\ts_nop 0\n\tglobal_load_lds_dwordx4 %3, %8\n\ts_add_u32 m0, m0, 0x2000\n\ts_nop 0\n\tglobal_load_lds_dwordx4 %4, %8\n\t"
                 "s_mov_b32 m0, %12\n\ts_nop 0\n\tglobal_load_lds_dwordx4 %5, %9\n\ts_add_u32 m0, m0, 0x2000\n\ts_nop 0\n\tglobal_load_lds_dwordx4 %6, %9\n\ts_mov_b32 m0, %0"
                 : "=&s"(keep) : "v"(v0), "v"(v1), "v"(v2), "v"(v3), "v"(v4), "v"(v5), "s"(b0), "s"(b1), "s"(b2), "s"(d0), "s"(d1), "s"(d2) : "memory", "scc"); }
#ifndef PG8_DPOS
#define PG8_DPOS 0
#endif
template <class Epi, class Sched, bool ALIGN_EPI = false, bool SP2 = false>
__device__ __forceinline__ void gemm_phase(PG8_LAS unsigned char* lds, const Gemm g, const Sched& S, const Epi& E) {
    int tid_ = threadIdx.x; asm volatile("" : "+v"(tid_));
    const int tid = tid_, wid = __builtin_amdgcn_readfirstlane(tid >> 6), lane = tid & 63, wr = wid >> 2, wc = wid & 3, fr = lane & 15, fq = lane >> 4;
    const int K = g.K, nt = K / BK;
    unsigned voffA[2], voffB[2];
#pragma unroll
    for (int i = 0; i < 2; ++i) { int R, C; stage_rc(tid * 16 + i * 8192, R, C); const int Rb = Epi::PERM ? ((R & ~31) + perm32(R & 31)) : R;
        voffA[i] = (unsigned)(R * K + C) * 2u; voffB[i] = (unsigned)(Rb * K + C) * 2u; }
    const size_t kstep = (size_t)(BK * 2);
    const size_t hstep = (size_t)HALF * K * 2;
    const size_t tstep = 2 * hstep;
    const unsigned ldsw = (unsigned)wid * 1024u;
    const unsigned ldsb = (unsigned)__builtin_amdgcn_readfirstlane((int)((unsigned)(size_t)lds + ldsw));
    const int aoff = lds_byte(wr * 64 + fr, fq * 8), boff = lds_byte(wc * 32 + fr, fq * 8);
#define PG8_SA(b, h) (((b) * 2 + (h)) * HTB)
#define PG8_SB(b, h) ((4 + (b) * 2 + (h)) * HTB)
#define PG8_STAGE(bufoff, gbase, voff) pg8_dma2((voff)[0], (voff)[1], (gbase), ldsb + (unsigned)(bufoff))
#define PG8_STAGE3(o0, g0, v0, o1, g1, v1, o2, g2, v2) pg8_dma6((v0)[0], (v0)[1], (v1)[0], (v1)[1], (v2)[0], (v2)[1], (g0), (g1), (g2), ldsb + (unsigned)(o0), ldsb + (unsigned)(o1), ldsb + (unsigned)(o2))
#define PG8_LDA(dst, b, h) do { _Pragma("unroll") for (int m = 0; m < 4; ++m) _Pragma("unroll") for (int k = 0; k < 2; ++k) dst[m][k] = *(const PG8_LAS bf16x8*)(lds + PG8_SA(b, h) + aoff + m * 2048 + k * 1024); } while (0)
#define PG8_LDB(dst, b, h) do { _Pragma("unroll") for (int n = 0; n < 2; ++n) _Pragma("unroll") for (int k = 0; k < 2; ++k) dst[n][k] = *(const PG8_LAS bf16x8*)(lds + PG8_SB(b, h) + boff + n * 2048 + k * 1024); } while (0)
#define PG8_MMA(ai, bj, At, Bt) do { __builtin_amdgcn_s_setprio(1); _Pragma("unroll") for (int m = 0; m < 4; ++m) _Pragma("unroll") for (int n = 0; n < 2; ++n) _Pragma("unroll") for (int k = 0; k < 2; ++k) \
        acc[ai][bj][m][n] = __builtin_amdgcn_mfma_f32_16x16x32_bf16(Bt[n][k], At[m][k], acc[ai][bj][m][n], 0, 0, 0); __builtin_amdgcn_s_setprio(0); } while (0)
#define PG8_WAIT_V(n) asm volatile("s_waitcnt vmcnt(" #n ")" ::: "memory")
#define PG8_WAIT_L(n) asm volatile("s_waitcnt lgkmcnt(" #n ")" ::: "memory")
#define PG8_BAR __builtin_amdgcn_s_barrier()
#define PG8_SCHED __builtin_amdgcn_sched_barrier(0)
    Unit cur, nxt; int ui = 0;
    if (!S.next(0, cur)) return;
    typedef double f64x2z __attribute__((ext_vector_type(2)));
    f32x4 acc[2][2][4][2];
#pragma unroll
    for (int a = 0; a < 2; ++a)
#pragma unroll
        for (int b = 0; b < 2; ++b)
#pragma unroll
            for (int m = 0; m < 4; ++m)
#pragma unroll
                for (int n = 0; n < 2; ++n) { double z0_, z1_; asm volatile("v_mov_b64 %0, 0\n\tv_mov_b64 %1, 0" : "=v"(z0_), "=v"(z1_)); const f64x2z zz_ = {z0_, z1_}; acc[a][b][m][n] = __builtin_bit_cast(f32x4, zz_); }
    bf16x8 At[4][2], B0[2][2], B1[2][2];
    const char* cA = (const char*)g.A + (size_t)cur.pm * tstep; const char* cB = (const char*)g.Bt + (size_t)cur.pn * tstep;
    S.a_ready(cur);
    if constexpr (SP2) {
        PG8_STAGE(PG8_SB(0, 0), cB, voffB); PG8_STAGE(PG8_SB(0, 1), cB + hstep, voffB); PG8_STAGE(PG8_SA(0, 0), cA, voffA); PG8_STAGE(PG8_SA(0, 1), cA + hstep, voffA);
        if (wr == 1) PG8_BAR;
        PG8_WAIT_V(2); PG8_BAR;
        PG8_STAGE(PG8_SB(1, 0), cB + kstep, voffB); PG8_STAGE(PG8_SA(1, 0), cA + kstep, voffA); PG8_STAGE(PG8_SB(1, 1), cB + hstep + kstep, voffB);
        PG8_WAIT_V(6); PG8_BAR;
    } else {
        PG8_STAGE(PG8_SB(0, 0), cB, voffB); PG8_STAGE(PG8_SA(0, 0), cA, voffA); PG8_STAGE(PG8_SB(0, 1), cB + hstep, voffB); PG8_STAGE(PG8_SA(0, 1), cA + hstep, voffA);
        if (wr == 1) PG8_BAR;
        PG8_WAIT_V(4); PG8_BAR;
        PG8_STAGE(PG8_SB(1, 0), cB + kstep, voffB); PG8_STAGE(PG8_SA(1, 0), cA + kstep, voffA); PG8_STAGE(PG8_SB(1, 1), cB + hstep + kstep, voffB);
        PG8_WAIT_V(6); PG8_BAR;
    }
    for (;;) {
        const bool has_next = S.next(ui + 1, nxt);
        const char* nA = has_next ? (const char*)g.A + (size_t)nxt.pm * tstep : cA; const char* nB = has_next ? (const char*)g.Bt + (size_t)nxt.pn * tstep : cB;
        for (int t = 0; t < nt; t += 2) {
            const bool last = (t == nt - 2);
            const char* a1 = cA + (size_t)(t + 1) * kstep;
            const char* a2 = last ? nA : cA + (size_t)(t + 2) * kstep; const char* b2 = last ? nB : cB + (size_t)(t + 2) * kstep;
            const char* a3 = a2 + kstep; const char* b3 = b2 + kstep;
            if (last && has_next) S.a_ready(nxt);
            if constexpr (SP2) {
#if PG8_DPOS == 0
            PG8_LDB(B0, 0, 0); PG8_LDB(B1, 0, 1); PG8_SCHED; PG8_LDA(At, 0, 0); PG8_STAGE(PG8_SA(1, 1), a1 + hstep, voffA);
            PG8_WAIT_V(8); PG8_WAIT_L(0); PG8_BAR; PG8_MMA(0, 0, At, B0); PG8_MMA(0, 1, At, B1); PG8_BAR; PG8_SCHED;
#elif PG8_DPOS == 1
            PG8_LDB(B0, 0, 0); PG8_LDB(B1, 0, 1); PG8_SCHED; PG8_LDA(At, 0, 0);
            PG8_WAIT_V(6); PG8_WAIT_L(0); PG8_BAR; PG8_SCHED; PG8_STAGE(PG8_SA(1, 1), a1 + hstep, voffA); PG8_SCHED; PG8_MMA(0, 0, At, B0); PG8_MMA(0, 1, At, B1); PG8_BAR; PG8_SCHED;
#else
            PG8_LDB(B0, 0, 0); PG8_LDB(B1, 0, 1); PG8_SCHED; PG8_LDA(At, 0, 0);
            PG8_WAIT_V(6); PG8_WAIT_L(0); PG8_BAR; PG8_MMA(0, 0, At, B0); PG8_SCHED; PG8_STAGE(PG8_SA(1, 1), a1 + hstep, voffA); PG8_SCHED; PG8_MMA(0, 1, At, B1); PG8_BAR; PG8_SCHED;
#endif
#if PG8_DPOS == 0
            PG8_LDA(At, 0, 1); PG8_STAGE3(PG8_SB(0, 0), b2, voffB, PG8_SB(0, 1), b2 + hstep, voffB, PG8_SA(0, 0), a2, voffA);
            PG8_WAIT_V(8); PG8_WAIT_L(0); PG8_BAR; PG8_MMA(1, 0, At, B0); PG8_MMA(1, 1, At, B1); PG8_BAR; PG8_SCHED;
#elif PG8_DPOS == 1
            PG8_LDA(At, 0, 1);
            PG8_WAIT_V(2); PG8_WAIT_L(0); PG8_BAR; PG8_SCHED; PG8_STAGE3(PG8_SB(0, 0), b2, voffB, PG8_SB(0, 1), b2 + hstep, voffB, PG8_SA(0, 0), a2, voffA); PG8_SCHED; PG8_MMA(1, 0, At, B0); PG8_MMA(1, 1, At, B1); PG8_BAR; PG8_SCHED;
#else
            PG8_LDA(At, 0, 1);
            PG8_WAIT_V(2); PG8_WAIT_L(0); PG8_BAR; PG8_MMA(1, 0, At, B0); PG8_SCHED; PG8_STAGE3(PG8_SB(0, 0), b2, voffB, PG8_SB(0, 1), b2 + hstep, voffB, PG8_SA(0, 0), a2, voffA); PG8_SCHED; PG8_MMA(1, 1, At, B1); PG8_BAR; PG8_SCHED;
#endif
#if PG8_DPOS == 0
            PG8_LDB(B0, 1, 0); PG8_LDB(B1, 1, 1); PG8_SCHED; PG8_LDA(At, 1, 0); PG8_STAGE(PG8_SA(0, 1), a2 + hstep, voffA);
            PG8_WAIT_V(8); PG8_WAIT_L(0); PG8_BAR; PG8_MMA(0, 0, At, B0); PG8_MMA(0, 1, At, B1); PG8_BAR; PG8_SCHED;
#elif PG8_DPOS == 1
            PG8_LDB(B0, 1, 0); PG8_LDB(B1, 1, 1); PG8_SCHED; PG8_LDA(At, 1, 0);
            PG8_WAIT_V(6); PG8_WAIT_L(0); PG8_BAR; PG8_SCHED; PG8_STAGE(PG8_SA(0, 1), a2 + hstep, voffA); PG8_SCHED; PG8_MMA(0, 0, At, B0); PG8_MMA(0, 1, At, B1); PG8_BAR; PG8_SCHED;
#else
            PG8_LDB(B0, 1, 0); PG8_LDB(B1, 1, 1); PG8_SCHED; PG8_LDA(At, 1, 0);
            PG8_WAIT_V(6); PG8_WAIT_L(0); PG8_BAR; PG8_MMA(0, 0, At, B0); PG8_SCHED; PG8_STAGE(PG8_SA(0, 1), a2 + hstep, voffA); PG8_SCHED; PG8_MMA(0, 1, At, B1); PG8_BAR; PG8_SCHED;
#endif
#if PG8_DPOS == 0
            PG8_LDA(At, 1, 1); PG8_STAGE3(PG8_SB(1, 0), b3, voffB, PG8_SB(1, 1), b3 + hstep, voffB, PG8_SA(1, 0), a3, voffA);
            PG8_WAIT_V(8); PG8_WAIT_L(0); PG8_BAR; PG8_MMA(1, 0, At, B0); PG8_MMA(1, 1, At, B1); PG8_BAR; PG8_SCHED;
#elif PG8_DPOS == 1
            PG8_LDA(At, 1, 1);
            PG8_WAIT_V(2); PG8_WAIT_L(0); PG8_BAR; PG8_SCHED; PG8_STAGE3(PG8_SB(1, 0), b3, voffB, PG8_SB(1, 1), b3 + hstep, voffB, PG8_SA(1, 0), a3, voffA); PG8_SCHED; PG8_MMA(1, 0, At, B0); PG8_MMA(1, 1, At, B1); PG8_BAR; PG8_SCHED;
#else
            PG8_LDA(At, 1, 1);
            PG8_WAIT_V(2); PG8_WAIT_L(0); PG8_BAR; PG8_MMA(1, 0, At, B0); PG8_SCHED; PG8_STAGE3(PG8_SB(1, 0), b3, voffB, PG8_SB(1, 1), b3 + hstep, voffB, PG8_SA(1, 0), a3, voffA); PG8_SCHED; PG8_MMA(1, 1, At, B1); PG8_BAR; PG8_SCHED;
#endif
            } else {
            PG8_LDB(B0, 0, 0); PG8_SCHED; PG8_LDA(At, 0, 0); PG8_STAGE(PG8_SA(1, 1), a1 + hstep, voffA);
            PG8_WAIT_L(8); PG8_BAR; PG8_WAIT_L(0); PG8_MMA(0, 0, At, B0); PG8_BAR; PG8_SCHED;
            PG8_LDB(B1, 0, 1); PG8_STAGE(PG8_SB(0, 0), b2, voffB);
            PG8_BAR; PG8_WAIT_L(0); PG8_MMA(0, 1, At, B1); PG8_BAR;
            PG8_LDA(At, 0, 1); PG8_STAGE(PG8_SA(0, 0), a2, voffA);
            PG8_BAR; PG8_WAIT_L(0); PG8_MMA(1, 0, At, B0); PG8_BAR; PG8_SCHED;
            PG8_STAGE(PG8_SB(0, 1), b2 + hstep, voffB);
            PG8_WAIT_V(6); PG8_BAR; PG8_MMA(1, 1, At, B1); PG8_BAR;
            PG8_LDB(B0, 1, 0); PG8_SCHED; PG8_LDA(At, 1, 0); PG8_STAGE(PG8_SA(0, 1), a2 + hstep, voffA);
            PG8_WAIT_L(8); PG8_BAR; PG8_WAIT_L(0); PG8_MMA(0, 0, At, B0); PG8_BAR; PG8_SCHED;
            PG8_LDB(B1, 1, 1); PG8_STAGE(PG8_SB(1, 0), b3, voffB);
            PG8_BAR; PG8_WAIT_L(0); PG8_MMA(0, 1, At, B1); PG8_BAR;
            PG8_LDA(At, 1, 1); PG8_STAGE(PG8_SA(1, 0), a3, voffA);
            PG8_BAR; PG8_WAIT_L(0); PG8_MMA(1, 0, At, B0); PG8_BAR; PG8_SCHED;
            PG8_STAGE(PG8_SB(1, 1), b3 + hstep, voffB);
            PG8_WAIT_V(6); PG8_BAR; PG8_MMA(1, 1, At, B1); PG8_BAR;
            }
        }
        if constexpr (ALIGN_EPI) { if (wr == 0) PG8_BAR; }
        if constexpr (!Epi::AFTER_DRAIN) { E(acc, cur, wr, wc, fr, fq); S.done(cur); }
        if (!has_next) break;
#pragma unroll
        for (int a = 0; a < 2; ++a)
#pragma unroll
            for (int b = 0; b < 2; ++b)
#pragma unroll
                for (int m = 0; m < 4; ++m)
#pragma unroll
                    for (int n = 0; n < 2; ++n) { double z0_, z1_; asm volatile("v_mov_b64 %0, 0\n\tv_mov_b64 %1, 0" : "=v"(z0_), "=v"(z1_)); const f64x2z zz_ = {z0_, z1_}; acc[a][b][m][n] = __builtin_bit_cast(f32x4, zz_); }
        cur = nxt; cA = nA; cB = nB; ++ui;
        if constexpr (ALIGN_EPI) { if (wr == 1) PG8_BAR; }
    }
    PG8_WAIT_V(0);
    if constexpr (!ALIGN_EPI) { if (wr == 0) PG8_BAR; }
    PG8_BAR;
    if constexpr (Epi::AFTER_DRAIN) { E.fused(acc, cur, wr, wc, fr, fq, lds, wid, lane); S.done(cur); }
#undef PG8_SA
#undef PG8_SB
#undef PG8_STAGE
#undef PG8_STAGE3
#undef PG8_LDA
#undef PG8_LDB
#undef PG8_MMA
#undef PG8_WAIT_V
#undef PG8_WAIT_L
#undef PG8_BAR
#undef PG8_SCHED
}
}

#include <type_traits>
namespace att {
typedef short bf16x8 __attribute__((ext_vector_type(8)));
typedef short s16x4 __attribute__((ext_vector_type(4)));
typedef float f32x16 __attribute__((ext_vector_type(16)));
typedef unsigned u32x4 __attribute__((ext_vector_type(4)));
typedef unsigned short bf16_t;
#define ATT_LAS __attribute__((address_space(3)))
#define ATT_SBAR() __builtin_amdgcn_sched_barrier(0)
constexpr int KN_OFF = 0, KN_SLOT = 16384, KR_OFF = 49152, KR_SLOT = 8192, V_OFF = 73728, V_SLOT = 16384, WSC_OFF = V_OFF + 4 * V_SLOT, BT_OFF = KR_OFF, ATT_LDS_BYTES = WSC_OFF + 8 * 256;
constexpr int BT_STRIDE = 384, BT_ZERO = 191;
__host__ __device__ __forceinline__ int crow(int r, int hi) { return (r & 3) + 8 * (r >> 2) + 4 * hi; }
__device__ __forceinline__ unsigned cvtpk(float lo, float hi) { unsigned r; asm volatile("v_cvt_pk_bf16_f32 %0, %1, %2" : "=v"(r) : "v"(lo), "v"(hi)); return r; }
__host__ __device__ __forceinline__ int kn_byte(int R, int c) { return R * 256 + ((c ^ (R & 15)) << 4); }
__host__ __device__ __forceinline__ int kr_byte(int R, int c) { return R * 128 + ((c ^ ((R >> 1) & 7)) << 4); }
__host__ __device__ __forceinline__ int v_st(int k, int c) { const int kk = (k & ~0xC) | ((k & 4) << 1) | ((k & 8) >> 1); return ((kk >> 3) * 4 + (c >> 5)) * 512 + ((kk & 7) * 32 + (c & 31)) * 2; }
__host__ __device__ __forceinline__ int v_rd_base(int lane) { return ((lane & 3) << 3) | (((lane >> 2) & 3) << 6) | (((lane >> 4) & 1) << 5) | (((lane >> 5) & 1) << 8); }
__host__ __device__ constexpr int v_rd_off(int d0, int ks, int half) { return d0 * 512 + ks * 4096 + half * 2048; }
__host__ __device__ __forceinline__ void kn_inv(int b, int& R, int& c) { R = b >> 8; c = ((b >> 4) & 15) ^ (R & 15); }
__host__ __device__ __forceinline__ void kr_inv(int b, int& R, int& c) { R = b >> 7; c = ((b >> 4) & 7) ^ ((R >> 1) & 7); }
__host__ __device__ __forceinline__ void v_inv(int b, int& k, int& col) { const int s = b >> 9, w = b & 511, kk = ((s >> 2) << 3) | (w >> 6); k = (kk & ~0xC) | ((kk & 4) << 1) | ((kk & 8) >> 1); col = (s & 3) * 32 + ((w & 63) >> 1); }

__device__ __forceinline__ void glds16(const void* gsrc, unsigned lds_dst) { unsigned keep;
    asm volatile("s_mov_b32 %0, m0\n\ts_mov_b32 m0, %2\n\ts_nop 0\n\tglobal_load_lds_dwordx4 %1, off\n\ts_mov_b32 m0, %0" : "=&s"(keep) : "v"(gsrc), "s"(lds_dst) : "memory"); }
__device__ __forceinline__ void glds16x5(unsigned ok0, unsigned ok1, unsigned orr, unsigned ov0, unsigned ov1, const void* kb, const void* rb, const void* vb, unsigned dk, unsigned dr, unsigned dv) { unsigned keep;
    asm volatile("s_mov_b32 %0, m0\n\ts_mov_b32 m0, %9\n\ts_nop 0\n\tglobal_load_lds_dwordx4 %1, %6\n\ts_add_u32 m0, m0, 0x2000\n\ts_nop 0\n\tglobal_load_lds_dwordx4 %2, %6\n\t"
                 "s_mov_b32 m0, %10\n\ts_nop 0\n\tglobal_load_lds_dwordx4 %3, %7\n\ts_mov_b32 m0, %11\n\ts_nop 0\n\tglobal_load_lds_dwordx4 %4, %8\n\ts_add_u32 m0, m0, 0x2000\n\ts_nop 0\n\tglobal_load_lds_dwordx4 %5, %8\n\ts_mov_b32 m0, %0"
                 : "=&s"(keep) : "v"(ok0), "v"(ok1), "v"(orr), "v"(ov0), "v"(ov1), "s"(kb), "s"(rb), "s"(vb), "s"(dk), "s"(dr), "s"(dv) : "memory", "scc"); }
template <int OFF> __device__ __forceinline__ s16x4 tr_read(int vb) { s16x4 r; asm volatile("ds_read_b64_tr_b16 %0, %1 offset:%2" : "=&v"(r) : "v"(vb), "i"(OFF) : "memory"); return r; }
struct VFrag { s16x4 l0, h0, l1, h1, l2, h2, l3, h3; };
template <int D0> __device__ __forceinline__ void v_load(VFrag& f, int vb) {
    f.l0 = tr_read<v_rd_off(D0, 0, 0)>(vb); f.h0 = tr_read<v_rd_off(D0, 0, 1)>(vb); f.l1 = tr_read<v_rd_off(D0, 1, 0)>(vb); f.h1 = tr_read<v_rd_off(D0, 1, 1)>(vb);
    f.l2 = tr_read<v_rd_off(D0, 2, 0)>(vb); f.h2 = tr_read<v_rd_off(D0, 2, 1)>(vb); f.l3 = tr_read<v_rd_off(D0, 3, 0)>(vb); f.h3 = tr_read<v_rd_off(D0, 3, 1)>(vb);
}
__device__ __forceinline__ void pv_mma(f32x16& od, const VFrag& f, bf16x8 pa0, bf16x8 pa1, bf16x8 pa2, bf16x8 pa3) {
#define ATT_PK(L, H) (bf16x8){L[0], L[1], L[2], L[3], H[0], H[1], H[2], H[3]}
    od = __builtin_amdgcn_mfma_f32_32x32x16_bf16(pa0, ATT_PK(f.l0, f.h0), od, 0, 0, 0);
    od = __builtin_amdgcn_mfma_f32_32x32x16_bf16(pa1, ATT_PK(f.l1, f.h1), od, 0, 0, 0);
    od = __builtin_amdgcn_mfma_f32_32x32x16_bf16(pa2, ATT_PK(f.l2, f.h2), od, 0, 0, 0);
    od = __builtin_amdgcn_mfma_f32_32x32x16_bf16(pa3, ATT_PK(f.l3, f.h3), od, 0, 0, 0);
#undef ATT_PK
}
__device__ __forceinline__ void pv_all(f32x16* o, int vb, bf16x8 pa0, bf16x8 pa1, bf16x8 pa2, bf16x8 pa3) {
    VFrag fa, fb;
    v_load<0>(fa, vb); v_load<1>(fb, vb);
    asm volatile("s_waitcnt lgkmcnt(8)" ::: "memory"); ATT_SBAR(); pv_mma(o[0], fa, pa0, pa1, pa2, pa3); ATT_SBAR();
    v_load<2>(fa, vb);
    asm volatile("s_waitcnt lgkmcnt(8)" ::: "memory"); ATT_SBAR(); pv_mma(o[1], fb, pa0, pa1, pa2, pa3); ATT_SBAR();
    v_load<3>(fb, vb);
    asm volatile("s_waitcnt lgkmcnt(8)" ::: "memory"); ATT_SBAR(); pv_mma(o[2], fa, pa0, pa1, pa2, pa3); ATT_SBAR();
    asm volatile("s_waitcnt lgkmcnt(0)" ::: "memory"); ATT_SBAR(); pv_mma(o[3], fb, pa0, pa1, pa2, pa3); ATT_SBAR();
}
#define ATT_WAIT_BAR(N) asm volatile("s_waitcnt vmcnt(%0) lgkmcnt(0)\n\ts_barrier" :: "n"(N) : "memory")

template <bool SWA>
__device__ __forceinline__ void attn_unit(const bf16_t* __restrict__ Qw, int ldq, const bf16_t* __restrict__ Kn, const bf16_t* __restrict__ Kr, const bf16_t* __restrict__ Vg, int ldk,
                                          bf16_t* __restrict__ Ow, int ldo, int NT, int qk_rel0  , float C, float sinkl,
                                          ATT_LAS unsigned char* shm, const ATT_LAS float* bt) {
    constexpr int NQ = SWA ? 8 : 12;
    constexpr int PIECES = SWA ? 4 : 5;
    int tid_ = threadIdx.x; asm volatile("" : "+v"(tid_));
    const int tid = tid_, lane = tid & 63, r32 = lane & 31, hi = lane >> 5; const int wid = __builtin_amdgcn_readfirstlane(tid >> 6);
    const unsigned lds0 = (unsigned)(size_t)shm;
    ATT_LAS float* wsf = (ATT_LAS float*)(shm + WSC_OFF) + wid * 64;
    const bf16_t* ksrc0; const bf16_t* ksrc1; const bf16_t* rsrc = nullptr; const bf16_t* vsrc0; const bf16_t* vsrc1;
    { int R, c; kn_inv(wid * 1024 + lane * 16, R, c); ksrc0 = Kn + (size_t)R * ldk + c * 8; kn_inv((wid + 8) * 1024 + lane * 16, R, c); ksrc1 = Kn + (size_t)R * ldk + c * 8;
      if (!SWA) { kr_inv(wid * 1024 + lane * 16, R, c); rsrc = Kr + (size_t)R * 64 + c * 8; }
      int k, col; v_inv(wid * 1024 + lane * 16, k, col); vsrc0 = Vg + (size_t)k * ldk + col; v_inv((wid + 8) * 1024 + lane * 16, k, col); vsrc1 = Vg + (size_t)k * ldk + col; }
    const size_t tstep = (size_t)64 * ldk;
    const unsigned dk0 = lds0 + KN_OFF + wid * 1024, dk1 = dk0 + 8192, dr = lds0 + KR_OFF + wid * 1024, dv0 = lds0 + V_OFF + wid * 1024, dv1 = dv0 + 8192;
#define ATT_ISSUE(t, s, sv) do { const size_t to_ = (size_t)(t) * tstep; const unsigned s_ = (unsigned)(s), sv_ = (unsigned)(sv); \
        glds16(ksrc0 + to_, (unsigned)__builtin_amdgcn_readfirstlane(dk0 + s_ * KN_SLOT)); glds16(ksrc1 + to_, (unsigned)__builtin_amdgcn_readfirstlane(dk1 + s_ * KN_SLOT)); \
        if (!SWA) glds16(rsrc + (size_t)(t) * 64 * 64, (unsigned)__builtin_amdgcn_readfirstlane(dr + s_ * KR_SLOT)); \
        glds16(vsrc0 + to_, (unsigned)__builtin_amdgcn_readfirstlane(dv0 + sv_ * V_SLOT)); glds16(vsrc1 + to_, (unsigned)__builtin_amdgcn_readfirstlane(dv1 + sv_ * V_SLOT)); } while (0)
    ATT_ISSUE(0, 0, 0); if (NT > 1) ATT_ISSUE(1, 1, 1);
    bf16x8 qr[NQ];
#pragma unroll
    for (int d0 = 0; d0 < NQ; ++d0) qr[d0] = *(const bf16x8*)(Qw + (size_t)r32 * ldq + d0 * 16 + hi * 8);
#pragma unroll
    for (int d0 = 0; d0 < NQ; ++d0) asm volatile("" : "+v"(qr[d0]));
    constexpr float THR = 8.f;
    float m_reg = SWA ? sinkl : 0.f, l_reg = SWA ? 1.f : 0.f;
    f32x16 negm;
#pragma unroll
    for (int r = 0; r < 16; ++r) negm[r] = 0.f;
    f32x16 o[4];
#pragma unroll
    for (int d = 0; d < 4; ++d)
#pragma unroll
        for (int r = 0; r < 16; ++r) o[d][r] = 0.f;
    const ATT_LAS unsigned char* kn0 = shm + KN_OFF; const ATT_LAS unsigned char* kr0 = shm + KR_OFF;
    const int vb0 = (int)(lds0 + V_OFF) + v_rd_base(lane);
    int s_cur = 0, s_n2 = 2, v_cur = 0, v_n2 = 2;
    ATT_WAIT_BAR(0);
    if (wid >= 4) asm volatile("s_barrier" ::: "memory");
    for (int j = 0; j < NT; ++j) {
        if (j + 2 < NT) ATT_ISSUE(j + 2, s_n2, v_n2);
        ATT_SBAR();
        f32x16 p0, p1;
        { const ATT_LAS unsigned char* kb = kn0 + s_cur * KN_SLOT; const ATT_LAS unsigned char* rb = kr0 + s_cur * KR_SLOT;
#define ATT_KF(d0_, half_) ((d0_) < 8 ? *(const ATT_LAS bf16x8*)(kb + kn_byte((half_) * 32 + r32, (d0_) * 2 + hi)) : *(const ATT_LAS bf16x8*)(rb + kr_byte((half_) * 32 + r32, ((d0_) - 8) * 2 + hi)))
          bf16x8 fa[NQ + 2], fb[NQ + 2];
          fa[0] = ATT_KF(0, 0); fb[0] = ATT_KF(0, 1); fa[1] = ATT_KF(1, 0); fb[1] = ATT_KF(1, 1);
#pragma unroll
          for (int d0 = 0; d0 < NQ; ++d0) {
              if (d0 + 2 < NQ) { fa[d0 + 2] = ATT_KF(d0 + 2, 0); fb[d0 + 2] = ATT_KF(d0 + 2, 1); }
              ATT_SBAR();
              if (d0 == 0) { p0 = __builtin_amdgcn_mfma_f32_32x32x16_bf16(fa[0], qr[0], negm, 0, 0, 0); p1 = __builtin_amdgcn_mfma_f32_32x32x16_bf16(fb[0], qr[0], negm, 0, 0, 0); }
              else { p0 = __builtin_amdgcn_mfma_f32_32x32x16_bf16(fa[d0], qr[d0], p0, 0, 0, 0); p1 = __builtin_amdgcn_mfma_f32_32x32x16_bf16(fb[d0], qr[d0], p1, 0, 0, 0); }
              ATT_SBAR();
          }
#undef ATT_KF
        }
        ATT_SBAR();
        if (j + 2 < NT) { ATT_WAIT_BAR(PIECES); } else { ATT_WAIT_BAR(0); }
        ATT_SBAR();
        if constexpr (SWA) {
            const ATT_LAS float* btb = bt + (qk_rel0 + j * 64 - r32 + BT_ZERO + 4 * hi);
#pragma unroll
            for (int r = 0; r < 16; ++r) { const int cr = (r & 3) + 8 * (r >> 2);
                p0[r] = fmaf(p0[r], C, btb[cr]); p1[r] = fmaf(p1[r], C, btb[cr + 32]); }
            float pmax = p0[0];
#pragma unroll
            for (int r = 1; r < 16; ++r) pmax = fmaxf(pmax, p0[r]);
#pragma unroll
            for (int r = 0; r < 16; ++r) pmax = fmaxf(pmax, p1[r]);
            { auto rr = __builtin_amdgcn_permlane32_swap(__float_as_uint(pmax), __float_as_uint(pmax), false, false); pmax = fmaxf(__uint_as_float(rr[0]), __uint_as_float(rr[1])); }
            const float mn = fmaxf(m_reg, pmax), alpha = __builtin_amdgcn_exp2f(m_reg - mn); m_reg = mn;
            float ps = 0.f;
#pragma unroll
            for (int r = 0; r < 16; ++r) { p0[r] = __builtin_amdgcn_exp2f(p0[r] - mn); p1[r] = __builtin_amdgcn_exp2f(p1[r] - mn); ps += p0[r] + p1[r]; }
            { auto rr = __builtin_amdgcn_permlane32_swap(__float_as_uint(ps), __float_as_uint(ps), false, false); ps = __uint_as_float(rr[0]) + __uint_as_float(rr[1]); }
            l_reg = l_reg * alpha + ps;
            if (__any(alpha < 1.f)) { if (hi == 0) wsf[r32] = alpha; asm volatile("s_waitcnt lgkmcnt(0)" ::: "memory");
#pragma unroll
                for (int r = 0; r < 16; ++r) { const float a = wsf[crow(r, hi)];
#pragma unroll
                    for (int d = 0; d < 4; ++d) o[d][r] *= a; }
                asm volatile("s_waitcnt lgkmcnt(0)" ::: "memory"); }
        } else {
#define ATT_MX3(a, b, c) __builtin_fmaxf(__builtin_fmaxf((a), (b)), (c))
            float ma = ATT_MX3(p0[0], p0[1], p1[0]), mb = ATT_MX3(p0[2], p0[3], p1[1]); ma = ATT_MX3(ma, p1[2], p1[3]);
#pragma unroll
            for (int r = 4; r < 16; r += 4) { ma = ATT_MX3(ma, p0[r], p0[r + 1]); mb = ATT_MX3(mb, p0[r + 2], p0[r + 3]); ma = ATT_MX3(ma, p1[r], p1[r + 1]); mb = ATT_MX3(mb, p1[r + 2], p1[r + 3]); }
#undef ATT_MX3
            float pmax = __builtin_fmaxf(ma, mb);
            { auto rr = __builtin_amdgcn_permlane32_swap(__float_as_uint(pmax), __float_as_uint(pmax), false, false); pmax = __builtin_fmaxf(__uint_as_float(rr[0]), __uint_as_float(rr[1])); }
            if (j == 0 || __any(pmax > THR)) {
                const float dl = (j == 0) ? pmax : __builtin_fmaxf(pmax, 0.f); m_reg += dl;
#pragma unroll
                for (int r = 0; r < 16; ++r) { p0[r] -= dl; p1[r] -= dl; negm[r] = -m_reg; }
                const float f = __builtin_amdgcn_exp2f(-dl); l_reg *= f;
                if (j != 0) { if (hi == 0) wsf[r32] = f; asm volatile("s_waitcnt lgkmcnt(0)" ::: "memory");
#pragma unroll
                    for (int r = 0; r < 16; ++r) { const float a = wsf[crow(r, hi)];
#pragma unroll
                        for (int d = 0; d < 4; ++d) o[d][r] *= a; }
                    asm volatile("s_waitcnt lgkmcnt(0)" ::: "memory"); }
            }
            float ps0 = 0.f, ps1 = 0.f;
#pragma unroll
            for (int r = 0; r < 16; ++r) { p0[r] = __builtin_amdgcn_exp2f(p0[r]); p1[r] = __builtin_amdgcn_exp2f(p1[r]); ps0 += p0[r]; ps1 += p1[r]; }
            float ps = ps0 + ps1;
            { auto rr = __builtin_amdgcn_permlane32_swap(__float_as_uint(ps), __float_as_uint(ps), false, false); ps = __uint_as_float(rr[0]) + __uint_as_float(rr[1]); }
            l_reg += ps;
        }
        bf16x8 pa0, pa1, pa2, pa3;
#define ATT_PK4(P, BASE, OUT) do { unsigned a0 = cvtpk(P[BASE + 0], P[BASE + 1]), a1 = cvtpk(P[BASE + 2], P[BASE + 3]);   \
        unsigned b0_ = cvtpk(P[BASE + 4], P[BASE + 5]), b1_ = cvtpk(P[BASE + 6], P[BASE + 7]);                              \
        auto r0 = __builtin_amdgcn_permlane32_swap(a0, b0_, false, false); auto r1 = __builtin_amdgcn_permlane32_swap(a1, b1_, false, false); \
        u32x4 w = {r0[0], r1[0], r0[1], r1[1]}; OUT = __builtin_bit_cast(bf16x8, w); } while (0)
        ATT_PK4(p0, 0, pa0); ATT_PK4(p0, 8, pa1); ATT_PK4(p1, 0, pa2); ATT_PK4(p1, 8, pa3);
#undef ATT_PK4
        ATT_SBAR();
        { const int vb = vb0 + v_cur * V_SLOT;
          pv_all(o, vb, pa0, pa1, pa2, pa3); }
        ATT_SBAR();
        asm volatile("s_waitcnt lgkmcnt(0)\n\ts_barrier" ::: "memory");
        ATT_SBAR();
        s_cur = (s_cur == 2) ? 0 : s_cur + 1; s_n2 = (s_n2 == 2) ? 0 : s_n2 + 1; v_cur = (v_cur + 1) & 3; v_n2 = (v_n2 + 1) & 3;
    }
    if (wid < 4) asm volatile("s_barrier" ::: "memory");
    if (hi == 0) wsf[32 + r32] = l_reg; asm volatile("s_waitcnt lgkmcnt(0)" ::: "memory");
#pragma unroll
    for (int r = 0; r < 16; ++r) { const int orow = crow(r, hi); const float rl = __builtin_amdgcn_rcpf(wsf[32 + orow]);
#pragma unroll
        for (int d = 0; d < 4; ++d) { const unsigned w = cvtpk(o[d][r] * rl, 0.f); Ow[(size_t)orow * ldo + d * 32 + r32] = (bf16_t)(w & 0xffffu); } }
    asm volatile("s_waitcnt lgkmcnt(0)" ::: "memory");
#undef ATT_ISSUE
}

__host__ __device__ __forceinline__ int v16_byte(int key, int col) { return (((key >> 3) * 8 + (col >> 4)) << 8) + (key & 7) * 32 + (col & 15) * 2; }
__host__ __device__ __forceinline__ void v16_inv(int b, int& key, int& col) { const int s = b >> 8, w = b & 255; key = (s >> 3) * 8 + (w >> 5); col = (s & 7) * 16 + ((w & 31) >> 1); }
__host__ __device__ __forceinline__ int v16_rd_base(int lane) { const int g = lane >> 4, q = (lane & 15) >> 2, p = lane & 3; return (g >> 1) * 2048 + (4 * (g & 1) + q) * 32 + 8 * p; }
__host__ __device__ constexpr int v16_rd_off(int t, int h, int dg) { return (4 * t + 2 * h) * 2048 + dg * 256; }
typedef float f32x4a __attribute__((ext_vector_type(4)));
__device__ __forceinline__ float xmax16(float v) { auto r = __builtin_amdgcn_permlane16_swap(__float_as_uint(v), __float_as_uint(v), false, false); return __builtin_fmaxf(__uint_as_float(r[0]), __uint_as_float(r[1])); }
__device__ __forceinline__ float xmax32(float v) { auto r = __builtin_amdgcn_permlane32_swap(__float_as_uint(v), __float_as_uint(v), false, false); return __builtin_fmaxf(__uint_as_float(r[0]), __uint_as_float(r[1])); }
__device__ __forceinline__ float xsum16(float v) { auto r = __builtin_amdgcn_permlane16_swap(__float_as_uint(v), __float_as_uint(v), false, false); return __uint_as_float(r[0]) + __uint_as_float(r[1]); }
__device__ __forceinline__ float xsum32(float v) { auto r = __builtin_amdgcn_permlane32_swap(__float_as_uint(v), __float_as_uint(v), false, false); return __uint_as_float(r[0]) + __uint_as_float(r[1]); }
template <int OFF> __device__ __forceinline__ s16x4 tr_read16(int vb) { s16x4 r; asm volatile("ds_read_b64_tr_b16 %0, %1 offset:%2" : "=&v"(r) : "v"(vb), "i"(OFF) : "memory"); return r; }

template <int T> __device__ __forceinline__ void pv_half16(f32x4a (&o)[2][8], f32x4a (&ol)[2], bf16x8 onesb, int vb, bf16x8 p0, bf16x8 p1) {
#define ATT_VRD(dg_, lo_, hi_) do { lo_ = tr_read16<v16_rd_off(T, 0, (dg_))>(vb); hi_ = tr_read16<v16_rd_off(T, 1, (dg_))>(vb); } while (0)
#define ATT_PV(dg_, lo_, hi_) do { const bf16x8 b__ = (bf16x8){lo_[0], lo_[1], lo_[2], lo_[3], hi_[0], hi_[1], hi_[2], hi_[3]}; \
        o[0][dg_] = __builtin_amdgcn_mfma_f32_16x16x32_bf16(p0, b__, o[0][dg_], 0, 0, 0); o[1][dg_] = __builtin_amdgcn_mfma_f32_16x16x32_bf16(p1, b__, o[1][dg_], 0, 0, 0); } while (0)
    s16x4 l0, h0, l1, h1, l2, h2, l3, h3;
    ATT_VRD(0, l0, h0); ATT_VRD(1, l1, h1); ATT_VRD(2, l2, h2); ATT_VRD(3, l3, h3);
    asm volatile("s_waitcnt lgkmcnt(6)" ::: "memory"); ATT_SBAR(); ATT_PV(0, l0, h0); ATT_SBAR(); ATT_VRD(4, l0, h0);
    asm volatile("s_waitcnt lgkmcnt(6)" ::: "memory"); ATT_SBAR(); ATT_PV(1, l1, h1); ATT_SBAR(); ATT_VRD(5, l1, h1);
    asm volatile("s_waitcnt lgkmcnt(6)" ::: "memory"); ATT_SBAR(); ATT_PV(2, l2, h2); ATT_SBAR(); ATT_VRD(6, l2, h2);
    asm volatile("s_waitcnt lgkmcnt(6)" ::: "memory"); ATT_SBAR(); ATT_PV(3, l3, h3); ATT_SBAR(); ATT_VRD(7, l3, h3);
    asm volatile("s_waitcnt lgkmcnt(6)" ::: "memory"); ATT_SBAR(); ATT_PV(4, l0, h0); ATT_SBAR();
    asm volatile("s_waitcnt lgkmcnt(4)" ::: "memory"); ATT_SBAR(); ATT_PV(5, l1, h1); ATT_SBAR();
    asm volatile("s_waitcnt lgkmcnt(2)" ::: "memory"); ATT_SBAR(); ATT_PV(6, l2, h2); ATT_SBAR();
    asm volatile("s_waitcnt lgkmcnt(0)" ::: "memory"); ATT_SBAR(); ATT_PV(7, l3, h3);
    ol[0] = __builtin_amdgcn_mfma_f32_16x16x32_bf16(p0, onesb, ol[0], 0, 0, 0); ol[1] = __builtin_amdgcn_mfma_f32_16x16x32_bf16(p1, onesb, ol[1], 0, 0, 0);
    ATT_SBAR();
#undef ATT_PV
#undef ATT_VRD
}
__device__ __forceinline__ float att_max3(float a, float b, float c) { float r; asm("v_max3_f32 %0, %1, %2, %3" : "=v"(r) : "v"(a), "v"(b), "v"(c)); return r; }
__device__ __forceinline__ float att_max2(float a, float b) { float r; asm("v_max_f32_e32 %0, %1, %2" : "=v"(r) : "v"(a), "v"(b)); return r; }
__device__ __forceinline__ void attn_mla16(const bf16_t* __restrict__ Qw, int ldq, const bf16_t* __restrict__ Kn, const bf16_t* __restrict__ Kr, const bf16_t* __restrict__ Vg, int ldk,
                                           bf16_t* __restrict__ Ow, int ldo, int NT, ATT_LAS unsigned char* shm) {
    constexpr int PIECES = 5;
    int tid_ = threadIdx.x; asm volatile("" : "+v"(tid_));
    const int tid = tid_, lane = tid & 63, qi = lane & 15, g = lane >> 4; const int wid = __builtin_amdgcn_readfirstlane(tid >> 6);
    const unsigned lds0 = (unsigned)(size_t)shm;
    ATT_LAS float* wsf = (ATT_LAS float*)(shm + WSC_OFF) + wid * 64;
    unsigned ok0, ok1, orr, ov0, ov1;
    { int R, c; kn_inv(wid * 1024 + lane * 16, R, c); ok0 = (unsigned)(R * ldk + c * 8) * 2u; kn_inv((wid + 8) * 1024 + lane * 16, R, c); ok1 = (unsigned)(R * ldk + c * 8) * 2u;
      kr_inv(wid * 1024 + lane * 16, R, c); orr = (unsigned)(R * 64 + c * 8) * 2u;
      int k, col; v16_inv(wid * 1024 + lane * 16, k, col); ov0 = (unsigned)(k * ldk + col) * 2u; v16_inv((wid + 8) * 1024 + lane * 16, k, col); ov1 = (unsigned)(k * ldk + col) * 2u; }
    const unsigned tstepB = 128u * (unsigned)ldk;
    const char* kp = (const char*)Kn; const char* rp = (const char*)Kr; const char* vp = (const char*)Vg;
    const unsigned dk0 = lds0 + KN_OFF + wid * 1024, dr = lds0 + KR_OFF + wid * 1024, dv0 = lds0 + V_OFF + wid * 1024;
#define ATT_ISSUE16(s, sv) do { const unsigned s_ = (unsigned)(s), sv_ = (unsigned)(sv); \
        glds16x5(ok0, ok1, orr, ov0, ov1, kp, rp, vp, (unsigned)__builtin_amdgcn_readfirstlane(dk0 + s_ * KN_SLOT), (unsigned)__builtin_amdgcn_readfirstlane(dr + s_ * KR_SLOT), (unsigned)__builtin_amdgcn_readfirstlane(dv0 + sv_ * V_SLOT)); \
        kp += tstepB; rp += 64 * 64 * 2; vp += tstepB; } while (0)
    const bool lead = wid < 4;
    ATT_ISSUE16(0, 0); if (NT > 1) ATT_ISSUE16(1, 1); if (!lead && NT > 2) ATT_ISSUE16(2, 2);
    bf16x8 qf[2][6];
#pragma unroll
    for (int qg = 0; qg < 2; ++qg)
#pragma unroll
        for (int s = 0; s < 6; ++s) qf[qg][s] = *(const bf16x8*)(Qw + (size_t)(16 * qg + qi) * ldq + 32 * s + 8 * g);
#pragma unroll
    for (int qg = 0; qg < 2; ++qg)
#pragma unroll
        for (int s = 0; s < 6; ++s) asm volatile("" : "+v"(qf[qg][s]));
    constexpr float THR = 8.f;
    float m_reg[2] = {0.f, 0.f};
    f32x4a ol[2]; ol[0] = (f32x4a){0.f, 0.f, 0.f, 0.f}; ol[1] = ol[0];
    const short one_ = qi == 0 ? (short)0x3F80 : (short)0; const bf16x8 onesb = (bf16x8){one_, one_, one_, one_, one_, one_, one_, one_};
    f32x4a negm[2]; negm[0] = (f32x4a){0.f, 0.f, 0.f, 0.f}; negm[1] = negm[0]; asm volatile("" : "+v"(negm[0]), "+v"(negm[1]));
    f32x4a o[2][8];
#pragma unroll
    for (int qg = 0; qg < 2; ++qg)
#pragma unroll
        for (int dg = 0; dg < 8; ++dg) o[qg][dg] = (f32x4a){0.f, 0.f, 0.f, 0.f};
    const ATT_LAS unsigned char* kn0 = shm + KN_OFF; const ATT_LAS unsigned char* kr0 = shm + KR_OFF;
    const int vb0 = (int)(lds0 + V_OFF) + v16_rd_base(lane);
    int v_cur = 0, v_n2 = 2;
    bf16x8 pq1[2]; pq1[0] = (bf16x8){0, 0, 0, 0, 0, 0, 0, 0}; pq1[1] = pq1[0];
    ATT_WAIT_BAR(0);
    if (wid >= 4) asm volatile("s_barrier" ::: "memory");
    auto tile = [&](auto ks_, const int j) __attribute__((always_inline)) {
        constexpr int KS = decltype(ks_)::value;
        ATT_SBAR();
        if (j > 0) pv_half16<1>(o, ol, onesb, vb0 + ((v_cur + 3) & 3) * V_SLOT, pq1[0], pq1[1]);
        ATT_SBAR();
        f32x4a c[4][2];
        { const ATT_LAS unsigned char* kb = kn0 + KS * KN_SLOT; const ATT_LAS unsigned char* rb = kr0 + KS * KR_SLOT;
#define ATT_KF16(i_) (((i_) >> 2) < 4 ? *(const ATT_LAS bf16x8*)(kb + kn_byte(16 * ((i_) & 3) + qi, 4 * ((i_) >> 2) + g)) : *(const ATT_LAS bf16x8*)(rb + kr_byte(16 * ((i_) & 3) + qi, 4 * (((i_) >> 2) - 4) + g)))
          bf16x8 kf[24 + 4];
          kf[0] = ATT_KF16(0); kf[1] = ATT_KF16(1); kf[2] = ATT_KF16(2); kf[3] = ATT_KF16(3);
#pragma unroll
          for (int i = 0; i < 24; ++i) { const int s = i >> 2, kg = i & 3;
              if (i + 4 < 24) kf[i + 4] = ATT_KF16(i + 4);
              ATT_SBAR();
              if (s == 0) { c[kg][0] = __builtin_amdgcn_mfma_f32_16x16x32_bf16(kf[i], qf[0][0], negm[0], 0, 0, 0); c[kg][1] = __builtin_amdgcn_mfma_f32_16x16x32_bf16(kf[i], qf[1][0], negm[1], 0, 0, 0); }
              else { c[kg][0] = __builtin_amdgcn_mfma_f32_16x16x32_bf16(kf[i], qf[0][s], c[kg][0], 0, 0, 0); c[kg][1] = __builtin_amdgcn_mfma_f32_16x16x32_bf16(kf[i], qf[1][s], c[kg][1], 0, 0, 0); }
              ATT_SBAR();
          }
#undef ATT_KF16
        }
        ATT_SBAR();
        if (lead) asm volatile("s_waitcnt lgkmcnt(0)\n\ts_barrier" ::: "memory"); else if (j + 2 < NT) { ATT_WAIT_BAR(PIECES); } else { ATT_WAIT_BAR(0); }
        ATT_SBAR();
        if (lead) { if (j + 2 < NT) ATT_ISSUE16((KS + 2) % 3, v_n2); } else { if (j + 3 < NT) ATT_ISSUE16(KS, (v_cur + 3) & 3); }
        ATT_SBAR();
        asm volatile("s_nop 7\n\ts_nop 7" ::: "memory");
        float mx[2], mxx;
        { float a_, b_;
          asm volatile("v_max3_f32 %0, %2, %3, %4\n\tv_max3_f32 %1, %5, %6, %7\n\tv_max3_f32 %0, %0, %8, %9\n\tv_max3_f32 %1, %1, %10, %11\n\tv_max3_f32 %0, %0, %12, %13\n\tv_max3_f32 %1, %1, %14, %15\n\t"
                       "v_max3_f32 %0, %0, %16, %17\n\tv_max_f32_e32 %0, %0, %1"
                       : "=&v"(a_), "=&v"(b_)
                       : "v"(c[0][0][0]), "v"(c[0][0][1]), "v"(c[0][0][2]), "v"(c[0][0][3]), "v"(c[1][0][0]), "v"(c[1][0][1]), "v"(c[1][0][2]), "v"(c[1][0][3]),
                         "v"(c[2][0][0]), "v"(c[2][0][1]), "v"(c[2][0][2]), "v"(c[2][0][3]), "v"(c[3][0][0]), "v"(c[3][0][1]), "v"(c[3][0][2]), "v"(c[3][0][3]));
          mx[0] = a_; }
        { float a_, b_, m_;
          asm volatile("v_max3_f32 %0, %3, %4, %5\n\tv_max3_f32 %1, %6, %7, %8\n\tv_max3_f32 %0, %0, %9, %10\n\tv_max3_f32 %1, %1, %11, %12\n\tv_max3_f32 %0, %0, %13, %14\n\tv_max3_f32 %1, %1, %15, %16\n\t"
                       "v_max3_f32 %0, %0, %17, %18\n\tv_max_f32_e32 %0, %0, %1\n\tv_max_f32_e32 %2, %0, %19"
                       : "=&v"(a_), "=&v"(b_), "=&v"(m_)
                       : "v"(c[0][1][0]), "v"(c[0][1][1]), "v"(c[0][1][2]), "v"(c[0][1][3]), "v"(c[1][1][0]), "v"(c[1][1][1]), "v"(c[1][1][2]), "v"(c[1][1][3]),
                         "v"(c[2][1][0]), "v"(c[2][1][1]), "v"(c[2][1][2]), "v"(c[2][1][3]), "v"(c[3][1][0]), "v"(c[3][1][1]), "v"(c[3][1][2]), "v"(c[3][1][3]), "v"(mx[0]));
          mx[1] = a_; mxx = m_; }
        if (j == 0 || __any(mxx > THR)) {
#pragma unroll
            for (int qg = 0; qg < 2; ++qg) {
                const float rmx = xmax32(xmax16(mx[qg]));
                const float dl = (j == 0) ? rmx : __builtin_fmaxf(rmx, 0.f); m_reg[qg] += dl;
#pragma unroll
                for (int kg = 0; kg < 4; ++kg) c[kg][qg] = c[kg][qg] - dl;
                negm[qg] = (f32x4a){-m_reg[qg], -m_reg[qg], -m_reg[qg], -m_reg[qg]}; asm volatile("" : "+v"(negm[qg]));
                const float f = __builtin_amdgcn_exp2f(-dl);
                if (j != 0 && g == 0) wsf[16 * qg + qi] = f; }
            if (j != 0) { asm volatile("s_waitcnt lgkmcnt(0)" ::: "memory");
#pragma unroll
                for (int qg = 0; qg < 2; ++qg) { const f32x4a a = *(const ATT_LAS f32x4a*)(wsf + 16 * qg + 4 * g);
#pragma unroll
                    for (int dg = 0; dg < 8; ++dg) o[qg][dg] = o[qg][dg] * a;
                    ol[qg] = ol[qg] * a; }
                asm volatile("s_waitcnt lgkmcnt(0)" ::: "memory"); }
        }
        bf16x8 pa[2][2];
        { unsigned wq[16];
#define ATT_CREF(f_) c[((f_) >> 2) & 3][(f_) >> 4][(f_) & 3]
#define ATT_EX(f_) asm volatile("v_exp_f32_e32 %0, %0" : "+v"(ATT_CREF(f_)))
#define ATT_CV(k_) asm volatile("v_cvt_pk_bf16_f32 %0, %1, %2" : "=v"(wq[k_]) : "v"(ATT_CREF(2 * (k_))), "v"(ATT_CREF(2 * (k_) + 1)))
#define ATT_E8(b_) ATT_EX((b_)); ATT_EX((b_) + 1); ATT_EX((b_) + 2); ATT_EX((b_) + 3); ATT_EX((b_) + 4); ATT_EX((b_) + 5); ATT_EX((b_) + 6); ATT_EX((b_) + 7)
#define ATT_C8(b_) ATT_CV((b_)); ATT_CV((b_) + 1); ATT_CV((b_) + 2); ATT_CV((b_) + 3); ATT_CV((b_) + 4); ATT_CV((b_) + 5); ATT_CV((b_) + 6); ATT_CV((b_) + 7)
          ATT_E8(0); ATT_E8(8); ATT_C8(0); ATT_E8(16); ATT_E8(24); ATT_C8(8);
#undef ATT_C8
#undef ATT_E8
#define ATT_STEP(k_) (void)0
#undef ATT_STEP
#undef ATT_CV
#undef ATT_EX
#undef ATT_CREF
#pragma unroll
          for (int qg = 0; qg < 2; ++qg)
#pragma unroll
              for (int t = 0; t < 2; ++t) { u32x4 w = {wq[8 * qg + 4 * t], wq[8 * qg + 4 * t + 1], wq[8 * qg + 4 * t + 2], wq[8 * qg + 4 * t + 3]}; pa[qg][t] = __builtin_bit_cast(bf16x8, w); } }
        ATT_SBAR();
        pv_half16<0>(o, ol, onesb, vb0 + v_cur * V_SLOT, pa[0][0], pa[1][0]);
        pq1[0] = pa[0][1]; pq1[1] = pa[1][1];
        ATT_SBAR();
        if (!lead) asm volatile("s_waitcnt lgkmcnt(0)\n\ts_barrier" ::: "memory"); else if (j + 2 < NT) { ATT_WAIT_BAR(PIECES); } else { ATT_WAIT_BAR(0); }
        ATT_SBAR();
        v_cur = (v_cur + 1) & 3; v_n2 = (v_n2 + 1) & 3;
    };
    { int j = 0;
      for (; j + 3 <= NT; j += 3) { tile(std::integral_constant<int, 0>{}, j); tile(std::integral_constant<int, 1>{}, j + 1); tile(std::integral_constant<int, 2>{}, j + 2); }
      if (j < NT) { tile(std::integral_constant<int, 0>{}, j); ++j; if (j < NT) tile(std::integral_constant<int, 1>{}, j); } }
    if (wid < 4) asm volatile("s_barrier" ::: "memory");
    pv_half16<1>(o, ol, onesb, vb0 + ((v_cur + 3) & 3) * V_SLOT, pq1[0], pq1[1]);
    asm volatile("s_waitcnt lgkmcnt(0)\n\ts_barrier" ::: "memory");
    if (qi == 0) { *(ATT_LAS f32x4a*)(wsf + 32 + 4 * g) = ol[0]; *(ATT_LAS f32x4a*)(wsf + 48 + 4 * g) = ol[1]; }
    asm volatile("s_waitcnt lgkmcnt(0)" ::: "memory");
#pragma unroll
    for (int qg = 0; qg < 2; ++qg) { const f32x4a lv = *(const ATT_LAS f32x4a*)(wsf + 32 + 16 * qg + 4 * g);
#pragma unroll
        for (int r = 0; r < 4; ++r) { const float rl = __builtin_amdgcn_rcpf(lv[r]);
#pragma unroll
            for (int dg = 0; dg < 8; ++dg) { const unsigned w = cvtpk(o[qg][dg][r] * rl, 0.f); Ow[(size_t)(16 * qg + 4 * g + r) * ldo + 16 * dg + qi] = (bf16_t)(w & 0xffffu); } } }
    asm volatile("s_waitcnt lgkmcnt(0)" ::: "memory");
#undef ATT_ISSUE16
}
#undef ATT_WAIT_BAR
#undef ATT_SBAR
}
#define GAS __attribute__((address_space(1)))
#define LAS __attribute__((address_space(3)))
typedef unsigned short bf16;
typedef unsigned v4u __attribute__((ext_vector_type(4)));
typedef float f32x4 __attribute__((ext_vector_type(4)));
typedef short bf16x8 __attribute__((ext_vector_type(8)));
typedef GAS unsigned gu32;
typedef GAS unsigned long long gu64;
#define RLX_AGENT __ATOMIC_RELAXED, __HIP_MEMORY_SCOPE_AGENT
#define LDS_WAIT() asm volatile("s_waitcnt lgkmcnt(0)" ::: "memory")
#define VM_WAIT() asm volatile("s_waitcnt vmcnt(0)" ::: "memory")
__device__ __forceinline__ unsigned long long rt() { return __builtin_amdgcn_s_memrealtime(); }
__device__ __forceinline__ unsigned f2bf(float f) { unsigned u = __builtin_bit_cast(unsigned, f); return (u + 0x7fffu + ((u >> 16) & 1u)) >> 16; }
__device__ __forceinline__ unsigned pk2(float lo, float hi) { return f2bf(lo) | (f2bf(hi) << 16); }

#define XB_TMO      128
#define XB_XCNT(j)  (256  + 64 * (j))
#define XB_XSUB(j)  (1280 + 64 * (j))
#define XB_XGEN(j)  (2304 + 64 * (j))
#define XB_TOP      3328
#define XB_TOPGEN   3392
#define XCD_BAR_WORDS 3456
#define XB_SPIN_CAP (1u << 18)

__device__ __forceinline__ unsigned xb_ld(unsigned* p)              { return __hip_atomic_load(p, __ATOMIC_RELAXED, __HIP_MEMORY_SCOPE_AGENT); }
__device__ __forceinline__ unsigned xb_add(unsigned* p, unsigned v) { return __hip_atomic_fetch_add(p, v, __ATOMIC_RELAXED, __HIP_MEMORY_SCOPE_AGENT); }
__device__ __forceinline__ unsigned xb_xcc_id() { return (unsigned)__builtin_amdgcn_s_getreg((3 << 11) | 20) & 0xFu; }
#define XB_SPIN(cond, bar) do { unsigned _sp = 0; while (cond) { __builtin_amdgcn_s_sleep(1); \
    if ((++_sp & 255u) == 0u) { if (xb_ld(&(bar)[XB_TMO])) break; if (_sp > XB_SPIN_CAP) { atomicAdd(&(bar)[XB_TMO], 1u); break; } } } } while (0)

struct XcdBarrier {
    unsigned* bar; unsigned x;
    volatile LAS unsigned* st;
};

__device__ __forceinline__ XcdBarrier xcd_barrier_post(unsigned* bar, volatile LAS unsigned* st) {
    XcdBarrier b; b.bar = bar; b.x = xb_xcc_id(); b.st = st;
    if (threadIdx.x == 0) (void)xb_add(&bar[XB_XCNT(b.x)], 1u);
    return b;
}
__device__ __forceinline__ void xcd_barrier_complete(unsigned* bar, unsigned x, unsigned& nloc, unsigned& nx) {
    const unsigned G = gridDim.x * gridDim.y * gridDim.z;
    unsigned sum, cnt, mine, sp = 0u;
    for (;;) {
        sum = 0u; cnt = 0u; mine = 0u;
#pragma unroll
        for (unsigned j = 0; j < 16; ++j) { const unsigned c = xb_ld(&bar[XB_XCNT(j)]); sum += c; cnt += (c > 0u) ? 1u : 0u; mine = (j == x) ? c : mine; }
        if (sum == G) break;
        __builtin_amdgcn_s_sleep(1);
        if ((++sp & 255u) == 0u) { if (xb_ld(&bar[XB_TMO])) break; if (sp > XB_SPIN_CAP) { atomicAdd(&bar[XB_TMO], 1u); break; } }
    }
    nloc = mine > 0u ? mine : 1u; nx = cnt > 0u ? cnt : 1u;
}

__device__ __forceinline__ void xcd_barrier(const XcdBarrier& b) {
    asm volatile("s_waitcnt vmcnt(0)" ::: "memory");
    __syncthreads();
    if (threadIdx.x == 0) {
        unsigned* bar = b.bar;
        __builtin_amdgcn_s_waitcnt(0);
        unsigned nloc = b.st[0], nx = b.st[1];
        if (nloc == 0u) { xcd_barrier_complete(bar, b.x, nloc, nx); b.st[0] = nloc; b.st[1] = nx; }
        const unsigned old = xb_add(&bar[XB_XSUB(b.x)], 1u);
        const unsigned gen = old / nloc;
        if (old + 1u == (gen + 1u) * nloc) {
            __builtin_amdgcn_fence(__ATOMIC_RELEASE, "agent");
            asm volatile("s_waitcnt vmcnt(0)" ::: "memory");
            const unsigned og = xb_add(&bar[XB_TOP], 1u);
            const unsigned tg = og / nx;
            if (og + 1u == (tg + 1u) * nx) xb_add(&bar[XB_TOPGEN], 1u);
            else XB_SPIN(xb_ld(&bar[XB_TOPGEN]) == tg, bar);
            __builtin_amdgcn_fence(__ATOMIC_ACQUIRE, "agent");
            xb_add(&bar[XB_XGEN(b.x)], 1u);
            asm volatile("s_waitcnt vmcnt(0)" ::: "memory");
        } else {
            XB_SPIN(xb_ld(&bar[XB_XGEN(b.x)]) == gen, bar);
            __builtin_amdgcn_fence(__ATOMIC_ACQUIRE, "agent");
            asm volatile("s_waitcnt vmcnt(0)" ::: "memory");
        }
    }
    __syncthreads();
}

constexpr int NWAVES = 8;
constexpr int T = 24576, TP = 16384, DM = 2048, DFF = 8192, PLE = 256, DEPTH = 4;
constexpr int LATN = 1280;
constexpr float EPS = 1e-6f;
constexpr int MCH = 8192, NCH = 3;
constexpr size_t MiB = 1u << 20;
constexpr size_t WS_CTL = 0, CTL_ZERO_BYTES = 1 * MiB;
constexpr size_t WS_ROT = 1 * MiB;
constexpr size_t WS_BT = 5 * MiB;
constexpr size_t WS_STAT = 6 * MiB;
constexpr size_t SS_XIN = WS_STAT, SS_X2 = WS_STAT + 128 * 1024, SS_E = WS_STAT + 256 * 1024, PS_Q = WS_STAT + 1 * MiB, PS_KV = WS_STAT + 2 * MiB, PS_H = WS_STAT + 3 * MiB, PS_E = WS_STAT + 6 * MiB, PS_X = WS_STAT + 9 * MiB;
constexpr size_t WS_W = 18 * MiB;
constexpr size_t W_MLA = 20 * MiB, W_SWA = 20 * MiB, W_LAYER = 73 * MiB;
constexpr size_t WO_WD = 0, WO_WUQ = 5 * MiB, WO_WUKV = 8 * MiB, WO_WOM = 12 * MiB;
constexpr size_t WO_WQKV = 0, WO_WOS = 12 * MiB;
constexpr size_t WO_UP = 0, WO_DN = 32 * MiB, WO_PU = 64 * MiB, WO_G = 65 * MiB;
constexpr size_t WS_WMLA = WS_W, WS_WSWA = WS_WMLA + 2 * W_MLA, WS_WLAY = WS_WSWA + 2 * W_SWA, WS_WEND = WS_WLAY + 4 * W_LAYER;
constexpr size_t WS_PB = WS_WEND;
constexpr size_t WS_XB = WS_PB + 12 * MiB;
constexpr size_t WS_H = WS_XB + 96 * MiB;
constexpr size_t WS_CQ = WS_H, WS_CKV = WS_H + 24 * MiB;
constexpr size_t WS_R = WS_H + 96 * MiB;
constexpr size_t WS_E = WS_R, WS_HID = WS_R + 96 * MiB;
constexpr size_t WS_Q = WS_R, WS_KV = WS_R + 144 * MiB, WS_KR = WS_KV + 192 * MiB;
constexpr size_t WS_QKV = WS_R;
constexpr size_t WS_XB1_UNUSED = WS_R + 144 * MiB;
constexpr size_t WS_END = WS_KR + 3 * MiB;
static_assert(PS_X + (size_t)T * 32 * 4 <= WS_W && WS_HID + 128 * MiB <= WS_END && WS_END <= 1000 * MiB, "d_ws map");
constexpr int CW_BAR = 4096;
constexpr int RING_OFF = 0, RING_BYTES = 131072;
constexpr int LDSCTL_OFF = 143360, MISC_OFF = LDSCTL_OFF + 320;
constexpr int LDS_BYTES = 147456;
static_assert(MISC_OFF + 128 <= LDS_BYTES && att::ATT_LDS_BYTES <= LDSCTL_OFF && RING_BYTES <= LDSCTL_OFF, "LDS map");

__device__ __forceinline__ float wave_sum(float v) {
#pragma unroll
    for (int o = 1; o < 64; o <<= 1) v += __shfl_xor(v, o);
    return v;
}
__device__ __forceinline__ float sq4(f32x4 v) { return (v.x * v.x + v.y * v.y) + (v.z * v.z + v.w * v.w); }
typedef unsigned u32x2 __attribute__((ext_vector_type(2)));
typedef unsigned u32x4 __attribute__((ext_vector_type(4)));
__device__ __forceinline__ u32x2 pk4(f32x4 v) { u32x2 r; r.x = pg8::cvt_pk_bf16(v.x, v.y); r.y = pg8::cvt_pk_bf16(v.z, v.w); return r; }
__device__ __forceinline__ f32x4 unpk4(u32x2 w) { f32x4 e; e.x = __uint_as_float(w.x << 16); e.y = __uint_as_float(w.x & 0xffff0000u); e.z = __uint_as_float(w.y << 16); e.w = __uint_as_float(w.y & 0xffff0000u); return e; }

__device__ __forceinline__ int cmap(int mode, int n) {
    if (mode == 1) { if (n < 1024) return n; if (n >= 1088) return -1; const int r = n - 1024; return 1024 + (r >> 1) + 32 * (r & 1); }
    if (mode == 2) { const int h = n / 192, r = n % 192; if (r < 128) return n; const int q = r - 128; return h * 192 + 128 + (q >> 1) + 32 * (q & 1); }
    return n;
}
__device__ __forceinline__ void p0_transpose_item(const float* W, int K, int Nsrc, int Ndst, bf16* WT, int mode, const float* gain, LAS float* scr, int item, int lane) {
    const int nblk = Ndst / 32, kb = item / nblk, nb = item % nblk, k0 = 64 * kb, n0 = 32 * nb;
    const int sc = cmap(mode, n0 + (lane & 31));
#pragma unroll 8
    for (int i = 0; i < 32; ++i) { const int kk = 2 * i + (lane >> 5); scr[kk * 33 + (lane & 31)] = sc >= 0 ? W[(size_t)(k0 + kk) * Nsrc + sc] * (gain ? gain[k0 + kk] : 1.f) : 0.f; }
    LDS_WAIT(); asm volatile("" ::: "memory");
    const int c = lane & 7;
#pragma unroll
    for (int j = 0; j < 4; ++j) { const int n = (lane >> 3) + 8 * j; const LAS float* s = scr + (8 * c) * 33 + n;
        v4u o; o.x = pk2(s[0 * 33], s[1 * 33]); o.y = pk2(s[2 * 33], s[3 * 33]); o.z = pk2(s[4 * 33], s[5 * 33]); o.w = pk2(s[6 * 33], s[7 * 33]);
        *(GAS v4u*)(WT + (size_t)(n0 + n) * K + k0 + 8 * c) = o; }
    LDS_WAIT(); asm volatile("" ::: "memory");
}
__device__ __forceinline__ void p0_fast_item(const float* W, int K, int N, bf16* WT, const float* gain, LAS unsigned char* scr, int item, int lane) {
    const int nblk = N / 64, kb = item / nblk, nb = item % nblk, k0 = 64 * kb, n0 = 64 * nb, q = lane & 15, g = lane >> 4;
    f32x4 a[8], b[8];
    const float* src = W + (size_t)(k0 + 2 * g) * N + n0 + 4 * q;
#pragma unroll
    for (int i = 0; i < 8; ++i) { a[i] = *(const f32x4*)(src + (size_t)(8 * i) * N); b[i] = *(const f32x4*)(src + (size_t)(8 * i + 1) * N); }
    if (gain) {
#pragma unroll
        for (int i = 0; i < 8; ++i) { const float ga = gain[k0 + 8 * i + 2 * g], gb = gain[k0 + 8 * i + 2 * g + 1]; a[i] = a[i] * ga; b[i] = b[i] * gb; } }
#pragma unroll
    for (int i = 0; i < 8; ++i)
#pragma unroll
        for (int e = 0; e < 4; ++e) *(LAS unsigned*)(scr + (4 * q + e) * 128 + ((i ^ (q & 7)) << 4) + 4 * g) = pg8::cvt_pk_bf16(a[i][e], b[i][e]);
    LDS_WAIT(); asm volatile("" ::: "memory");
    const int c = lane & 7;
#pragma unroll
    for (int j = 0; j < 8; ++j) { const int n = (lane >> 3) + 8 * j; const v4u v = *(const LAS v4u*)(scr + n * 128 + ((c ^ ((n >> 2) & 7)) << 4));
        *(GAS v4u*)(WT + (size_t)(n0 + n) * K + k0 + 8 * c) = v; }
    LDS_WAIT(); asm volatile("" ::: "memory");
}

template <int R> __device__ __forceinline__ void thin_c_rows(int m0, int stride, int lane, const bf16* XB1, const float* g1, bf16* XB, const bf16* H,
                                                             const float* psh, float* ssx2, const float* pp, const float* psm, bf16* PB) {
    u32x4 hw[R][4], xw[R][4]; float ph[R]; f32x4 pv_[R];
#pragma unroll
    for (int rr = 0; rr < R; ++rr) { const int m = m0 + rr * stride; const bf16* hr = H + (size_t)m * DM; const bf16* xr = XB1 + (size_t)m * DM;
#pragma unroll
        for (int q = 0; q < 4; ++q) { hw[rr][q] = *(const u32x4*)(hr + 512 * q + 8 * lane); xw[rr][q] = *(const u32x4*)(xr + 512 * q + 8 * lane); }
        ph[rr] = lane < 32 ? psh[(size_t)m * 32 + lane] : 0.f;
        const float* pr = m < TP ? pp + (size_t)m * PLE : psm + (size_t)(m - TP) * PLE; pv_[rr] = *(const f32x4*)(pr + 4 * lane); }
#pragma unroll
    for (int rr = 0; rr < R; ++rr) { const int m = m0 + rr * stride;
        const float rh = __builtin_amdgcn_rsqf(wave_sum(ph[rr]) * (1.0f / DM) + EPS); float sx = 0.f;
        f32x4 v[4][2];
#pragma unroll
        for (int q = 0; q < 4; ++q) {
            v[q][0] = unpk4((u32x2){xw[rr][q].x, xw[rr][q].y}) + unpk4((u32x2){hw[rr][q].x, hw[rr][q].y}) * rh * *(const f32x4*)(g1 + 512 * q + 8 * lane);
            v[q][1] = unpk4((u32x2){xw[rr][q].z, xw[rr][q].w}) + unpk4((u32x2){hw[rr][q].z, hw[rr][q].w}) * rh * *(const f32x4*)(g1 + 512 * q + 8 * lane + 4);
            sx += sq4(v[q][0]) + sq4(v[q][1]); }
        sx = wave_sum(sx); if (lane == 0) ssx2[m] = sx;
        { const float rx = __builtin_amdgcn_rsqf(sx * (1.0f / DM) + EPS);
#pragma unroll
          for (int q = 0; q < 4; ++q) { const u32x2 lo = pk4(v[q][0] * rx), hi = pk4(v[q][1] * rx); *(u32x4*)(XB + (size_t)m * DM + 512 * q + 8 * lane) = (u32x4){lo.x, lo.y, hi.x, hi.y}; } }
        *(u32x2*)(PB + (size_t)m * PLE + 4 * lane) = pk4(pv_[rr]); }
}
template <int R> __device__ __forceinline__ void thin_d_rows(int m0, int stride, int lane, const float* g3, bf16* XB, const bf16* H, const float* psh, const float* pse, float* sse, const float* ssx2) {
    u32x4 xw[R][4], hw[R][4]; float ph[R], pe[R], sx2[R];
#pragma unroll
    for (int rr = 0; rr < R; ++rr) { const int m = m0 + rr * stride; const bf16* hr = H + (size_t)m * DM; const bf16* xr = XB + (size_t)m * DM;
#pragma unroll
        for (int q = 0; q < 4; ++q) { hw[rr][q] = *(const u32x4*)(hr + 512 * q + 8 * lane); xw[rr][q] = *(const u32x4*)(xr + 512 * q + 8 * lane); }
        ph[rr] = lane < 32 ? psh[(size_t)m * 32 + lane] : 0.f; pe[rr] = lane < 32 ? pse[(size_t)m * 32 + lane] : 0.f; sx2[rr] = ssx2[m]; }
#pragma unroll
    for (int rr = 0; rr < R; ++rr) { const int m = m0 + rr * stride; bf16* xr = XB + (size_t)m * DM;
        const float rh = __builtin_amdgcn_rsqf(wave_sum(ph[rr]) * (1.0f / DM) + EPS);
        { const float se = wave_sum(pe[rr]); if (lane == 0) sse[m] = se; }
        const float ux = __builtin_sqrtf(sx2[rr] * (1.0f / DM) + EPS);
#pragma unroll
        for (int q = 0; q < 4; ++q) {
            const u32x2 lo = pk4(unpk4((u32x2){xw[rr][q].x, xw[rr][q].y}) * ux + unpk4((u32x2){hw[rr][q].x, hw[rr][q].y}) * rh * *(const f32x4*)(g3 + 512 * q + 8 * lane));
            const u32x2 hi = pk4(unpk4((u32x2){xw[rr][q].z, xw[rr][q].w}) * ux + unpk4((u32x2){hw[rr][q].z, hw[rr][q].w}) * rh * *(const f32x4*)(g3 + 512 * q + 8 * lane + 4));
            *(u32x4*)(xr + 512 * q + 8 * lane) = (u32x4){lo.x, lo.y, hi.x, hi.y}; } }
}

struct Args { const float* in[20]; float* out; unsigned char* ws; };
#define ZERO() ({ int z__; asm volatile("s_mov_b32 %0, 0" : "=s"(z__)); z__; })
#define WSP(T_, off) ((T_*)(args.ws + (size_t)(off) + (size_t)ZERO()))
#define INP(k) (args.in[(k) + ZERO()])
__global__ void __launch_bounds__(NWAVES * 64, 2) trunk_fwd(Args args) {
    extern __shared__ __attribute__((aligned(16))) unsigned char lds_raw[];
    LAS unsigned char* lds = (LAS unsigned char*)lds_raw;
    volatile LAS unsigned* MISC = (volatile LAS unsigned*)(lds + MISC_OFF);
    const int tid = threadIdx.x, lane0 = tid & 63, wave = __builtin_amdgcn_readfirstlane(tid >> 6);
#define LANE_DECL() int lane = lane0; asm volatile("" : "+v"(lane)); int gwl = gw; asm volatile("" : "+s"(gwl))
    const int G = gridDim.x; const int bx = blockIdx.x; const int vcu = (G % 8 == 0) ? (bx % 8) * (G / 8) + bx / 8 : bx;
    for (int u = tid; u < (LDS_BYTES - LDSCTL_OFF) / 4; u += NWAVES * 64) ((LAS unsigned*)(lds + LDSCTL_OFF))[u] = 0u;
    __syncthreads();
    XcdBarrier bar = xcd_barrier_post((unsigned*)(args.ws + WS_CTL) + CW_BAR, MISC + 8);
#define GRID_BAR() xcd_barrier(bar)
    const int gw = vcu * NWAVES + wave, NGW = G * NWAVES;
    constexpr float QSCALE = 0.07216878364870322f * 1.4426950408889634f;

    {
        LANE_DECL(); LAS unsigned char* scr8 = lds + RING_OFF + wave * 16384; LAS float* scr = (LAS float*)scr8;
        unsigned char* ws = args.ws;
        int rot_ = 0;
#define CVT(Wsrc, K_, Nsrc_, Ndst_, dst_, mode_, gain_) do { const int nit_ = ((K_) / 64) * ((Ndst_) / 32); \
            for (int it_ = (gwl + NGW - rot_) % NGW; it_ < nit_; it_ += NGW) p0_transpose_item((Wsrc), (K_), (Nsrc_), (Ndst_), (dst_), (mode_), (gain_), scr, it_, lane); rot_ = (rot_ + nit_) % NGW; } while (0)
#define CVTF(Wsrc, K_, N_, dst_, gain_) do { const int nit_ = ((K_) / 64) * ((N_) / 64); \
            for (int it_ = (gwl + NGW - rot_) % NGW; it_ < nit_; it_ += NGW) p0_fast_item((Wsrc), (K_), (N_), (dst_), (gain_), scr8, it_, lane); rot_ = (rot_ + nit_) % NGW; } while (0)
        const float* gains = args.in[4];
        for (int j = 0; j < 2; ++j) {
            unsigned char* wm = ws + WS_WMLA + j * W_MLA; unsigned char* wsw = ws + WS_WSWA + j * W_SWA;
            CVT(args.in[5] + (size_t)j * DM * 1088, DM, 1088, LATN, (bf16*)(wm + WO_WD), 1, gains + (size_t)(2 * j * 4 + 0) * DM);
            CVT(args.in[8] + (size_t)j * 512 * 3072, 512, 3072, 3072, (bf16*)(wm + WO_WUQ), 2, args.in[6] + j * 512);
            CVTF(args.in[9] + (size_t)j * 512 * 4096, 512, 4096, (bf16*)(wm + WO_WUKV), args.in[7] + j * 512);
            CVTF(args.in[10] + (size_t)j * DM * DM, DM, DM, (bf16*)(wm + WO_WOM), (const float*)nullptr);
            CVTF(args.in[11] + (size_t)j * DM * 3072, DM, 3072, (bf16*)(wsw + WO_WQKV), gains + (size_t)((2 * j + 1) * 4 + 0) * DM);
            CVTF(args.in[13] + (size_t)j * DM * DM, DM, DM, (bf16*)(wsw + WO_WOS), (const float*)nullptr);
        }
        for (int L = 0; L < DEPTH; ++L) {
            unsigned char* wl = ws + WS_WLAY + L * W_LAYER;
            CVTF(args.in[15] + (size_t)L * DM * DFF, DM, DFF, (bf16*)(wl + WO_UP), gains + (size_t)(L * 4 + 2) * DM);
            CVTF(args.in[16] + (size_t)L * DFF * DM, DFF, DM, (bf16*)(wl + WO_DN), (const float*)nullptr);
            CVTF(args.in[17] + (size_t)L * PLE * DM, PLE, DM, (bf16*)(wl + WO_PU), (const float*)nullptr);
            CVTF(args.in[18] + (size_t)L * DM * DM, DM, DM, (bf16*)(wl + WO_G), (const float*)nullptr);
        }
#undef CVT
#undef CVTF
        float* rot = (float*)(ws + WS_ROT);
        for (int i = vcu * (NWAVES * 64) + tid; i < 16384 * 32; i += G * NWAVES * 64) {
            const int pos = i >> 5, d = i & 31; double inv = 1.0; for (int k = 0; k < d; ++k) inv *= 0.74989420933245582730;
            const double turns = (double)pos * inv * 0.15915494309189533577; const float fr = (float)(turns - __builtin_rint(turns));
            rot[2 * i] = __builtin_amdgcn_cosf(fr); rot[2 * i + 1] = __builtin_amdgcn_sinf(fr);
        }
        float* btg = (float*)(ws + WS_BT);
        for (int i = vcu * (NWAVES * 64) + tid; i < 16 * att::BT_STRIDE; i += G * NWAVES * 64) {
            const int h = i / att::BT_STRIDE, idx = i % att::BT_STRIDE, rel = idx - att::BT_ZERO, n = rel < 0 ? -rel : rel;
            int b = n < 8 ? n : 8 + (n >= 12) + (n >= 16) + (n >= 23) + (n >= 32) + (n >= 46) + (n >= 64) + (n >= 91); if (b > 15) b = 15; if (rel > 0) b += 16;
            btg[i] = n <= 128 ? args.in[14][b * 16 + h] * 1.4426950408889634f : -1e30f;
        }
    }
    { LANE_DECL(); const float* xin0 = INP(0); const float* xin1 = INP(1); bf16* XB = (bf16*)(args.out + ZERO()); float* ssx = WSP(float, SS_XIN);
      for (int m = gwl; m < T; m += NGW) {
        const float* xr = m < TP ? xin0 + (size_t)m * DM : xin1 + (size_t)(m - TP) * DM;
        f32x4 v[8]; float ss = 0.f;
#pragma unroll
        for (int q = 0; q < 8; ++q) { v[q] = *(const f32x4*)(xr + 256 * q + 4 * lane); ss += sq4(v[q]); }
        ss = wave_sum(ss);
#pragma unroll
        for (int q = 0; q < 8; ++q) *(u32x2*)(XB + (size_t)m * DM + 256 * q + 4 * lane) = pk4(v[q]);
        if (lane == 0) ssx[m] = ss;
      } }
    GRID_BAR();
    for (int L = 0; L < DEPTH; ++L) {
        const int j = L >> 1; const bool mla = (L & 1) == 0;
        if (mla) {
#ifndef DBG_NO_GEMM
            { pg8::Gemm g{(const bf16*)(args.out + ZERO()), WSP(bf16, WS_WMLA + j * W_MLA + WO_WD), T, LATN, DM}; pg8::StaticOrder S; S.init(T, LATN, G, bx + ZERO());
              pg8::EpiLat E{WSP(bf16, WS_CQ), WSP(bf16, WS_CKV), WSP(bf16, WS_KR), WSP(float, SS_XIN), WSP(float, PS_Q), WSP(float, PS_KV), WSP(float, WS_ROT)};
              pg8::gemm_phase<pg8::EpiLat, pg8::StaticOrder, true, true>(lds + RING_OFF, g, S, E);
            }
#endif
            GRID_BAR();
#ifndef DBG_NO_GEMM
            { pg8::Gemm g{WSP(bf16, WS_CQ), WSP(bf16, WS_WMLA + j * W_MLA + WO_WUQ), T, 3072, 512}; pg8::StaticOrder S; S.init(T, 3072, G, bx + ZERO()); pg8::EpiQRope E{WSP(bf16, WS_Q), 3072, WSP(float, WS_ROT), QSCALE, WSP(float, PS_Q)};
              pg8::gemm_phase<pg8::EpiQRope, pg8::StaticOrder, true, true>(lds + RING_OFF, g, S, E);
            }
            { pg8::Gemm g{WSP(bf16, WS_CKV), WSP(bf16, WS_WMLA + j * W_MLA + WO_WUKV), T, 4096, 512}; pg8::StaticOrder S; S.init(T, 4096, G, bx + ZERO());
              pg8::EpiBf16<0, 8, false> E{WSP(bf16, WS_KV), 4096, WSP(float, PS_KV), 1.0f / 512.0f, nullptr, 0};
              pg8::gemm_phase<pg8::EpiBf16<0, 8, false>, pg8::StaticOrder, true, true>(lds + RING_OFF, g, S, E);
            }
#endif
            GRID_BAR();
#ifndef DBG_NO_MLA
            { const bf16* QB = WSP(bf16, WS_Q); const bf16* KVB = WSP(bf16, WS_KV); const bf16* KRB = WSP(bf16, WS_KR); bf16* OB = WSP(bf16, WS_XB);
              for (int u = vcu; u < 1536; u += G) {
                int s0, S_, h, qb;
                if (u < 1024) { s0 = 0; S_ = TP; h = u >> 6; qb = u & 63; } else { const int v = u - 1024; s0 = TP + (v >> 8) * 4096; S_ = 4096; h = (v & 255) >> 4; qb = v & 15; }
                const int q0 = s0 + qb * 256 + wave * 32;
                att::attn_mla16(QB + (size_t)q0 * 3072 + h * 192, 3072, KVB + (size_t)s0 * 4096 + h * 256, KRB + (size_t)s0 * 64, KVB + (size_t)s0 * 4096 + h * 256 + 128, 4096,
                                OB + (size_t)q0 * DM + h * 128, DM, S_ / 64, lds + RING_OFF);
              } }
#endif
        } else {
#ifndef DBG_NO_GEMM
            { pg8::Gemm g{(const bf16*)(args.out + ZERO()), WSP(bf16, WS_WSWA + j * W_SWA + WO_WQKV), T, 3072, DM}; pg8::StaticOrder S; S.init(T, 3072, G, bx + ZERO());
              pg8::EpiBf16<0, 1, false> E{WSP(bf16, WS_QKV), 3072, WSP(float, SS_XIN), 1.0f / 2048.0f, nullptr, 0};
              pg8::gemm_phase<pg8::EpiBf16<0, 1, false>, pg8::StaticOrder, true, true>(lds + RING_OFF, g, S, E);
            }
#endif
            GRID_BAR();
#ifndef DBG_NO_SWA
            { LAS float* btl = (LAS float*)(lds + RING_OFF + att::BT_OFF); const float* btg = WSP(float, WS_BT);
              int tl = tid; asm volatile("" : "+v"(tl));
              for (int i = tl; i < 16 * att::BT_STRIDE; i += NWAVES * 64) btl[i] = btg[i];
              __syncthreads();
              const float* sink = INP(12) + j * 16; const bf16* QKV = WSP(bf16, WS_QKV); bf16* OB = WSP(bf16, WS_XB);
              for (int u = vcu; u < 1536; u += G) {
                  const int kvh = u / 384, rb = u % 384, q0 = rb * 64; int s0, S_;
                  if (q0 < TP) { s0 = 0; S_ = TP; } else { s0 = TP + ((q0 - TP) >> 12) * 4096; S_ = 4096; }
                  const int lo = max(q0 - 128, s0), hi_ = min(q0 + 192, s0 + S_), NT = (hi_ - lo) >> 6;
                  const int hq = kvh * 4 + (wave & 3), qw = q0 + 32 * (wave >> 2);
                  att::attn_unit<true>(QKV + (size_t)qw * 3072 + hq * 128, 3072, QKV + (size_t)lo * 3072 + 2048 + kvh * 128, nullptr, QKV + (size_t)lo * 3072 + 2560 + kvh * 128, 3072,
                                       OB + (size_t)qw * DM + hq * 128, DM, NT, lo - qw, 0.08838834764831845f * 1.4426950408889634f, sink[hq] * 1.4426950408889634f, lds + RING_OFF, btl + hq * att::BT_STRIDE);
              } }
#endif
        }
        GRID_BAR();
#ifndef DBG_NO_GEMM
        { const bf16* wo = mla ? WSP(bf16, WS_WMLA + j * W_MLA + WO_WOM) : WSP(bf16, WS_WSWA + j * W_SWA + WO_WOS);
          pg8::Gemm g{WSP(bf16, WS_XB), wo, T, DM, DM}; pg8::StaticOrder S; S.init(T, DM, G, bx + ZERO()); pg8::EpiBf16<0, 0, true> E{WSP(bf16, WS_H), DM, nullptr, 0.f, WSP(float, PS_H), 0};
          pg8::gemm_phase<pg8::EpiBf16<0, 0, true>, pg8::StaticOrder, true, true>(lds + RING_OFF, g, S, E);
        }
#endif
        GRID_BAR();
        { LANE_DECL(); const float* xin0 = INP(0); const float* xin1 = INP(1); const bf16* XB1 = (const bf16*)(args.out + ZERO()); const float* g1 = INP(4) + (size_t)(L * 4 + 1) * DM;
          bf16* XB = WSP(bf16, WS_XB); const bf16* H = WSP(bf16, WS_H); const float* psh = WSP(float, PS_H); float* ssx2 = WSP(float, SS_X2);
          const float* pp = INP(2) + (size_t)L * TP * PLE; const float* psm = INP(3) + (size_t)L * (T - TP) * PLE; bf16* PB = WSP(bf16, WS_PB);
          constexpr int RC = 2; int m0 = gwl;
          for (; m0 + (RC - 1) * NGW < T; m0 += RC * NGW) thin_c_rows<RC>(m0, NGW, lane, XB1, g1, XB, H, psh, ssx2, pp, psm, PB);
          for (; m0 < T; m0 += NGW) thin_c_rows<1>(m0, NGW, lane, XB1, g1, XB, H, psh, ssx2, pp, psm, PB);
        }
        GRID_BAR();
        for (int c = 0; c < NCH; ++c) {
#ifndef DBG_NO_GEMM
            { pg8::Gemm g{WSP(bf16, WS_XB) + (size_t)c * MCH * DM, WSP(bf16, WS_WLAY + L * W_LAYER + WO_UP), MCH, DFF, DM}; pg8::StaticOrder S; S.init(MCH, DFF, G, bx + ZERO());
              pg8::EpiBf16<1, 0, false> E{WSP(bf16, WS_HID), DFF, nullptr, 0.f, nullptr, c * MCH};
              pg8::gemm_phase<pg8::EpiBf16<1, 0, false>, pg8::StaticOrder, true, true>(lds + RING_OFF, g, S, E);
            }
#endif
            GRID_BAR();
#ifndef DBG_NO_GEMM
            { pg8::Gemm g{WSP(bf16, WS_HID), WSP(bf16, WS_WLAY + L * W_LAYER + WO_DN), MCH, DM, DFF}; pg8::StaticOrder S; S.init(MCH, DM, G, bx + ZERO());
              pg8::EpiBf16<0, 0, true> E{WSP(bf16, WS_H) + (size_t)c * MCH * DM, DM, nullptr, 0.f, WSP(float, PS_H), c * MCH};
              pg8::gemm_phase<pg8::EpiBf16<0, 0, true>, pg8::StaticOrder, true, true>(lds + RING_OFF, g, S, E);
            }
            if (c == 0) {
              pg8::Gemm g{WSP(bf16, WS_PB), WSP(bf16, WS_WLAY + L * W_LAYER + WO_PU), T, DM, PLE + ZERO()}; pg8::StaticOrder S; S.init(T, DM, G, bx + ZERO());
              pg8::EpiBf16<0, 0, true> E{WSP(bf16, WS_E), DM, nullptr, 0.f, WSP(float, PS_E), 0};
              pg8::gemm_phase<pg8::EpiBf16<0, 0, true>, pg8::StaticOrder, true, true>(lds + RING_OFF, g, S, E);
            }
#endif
            GRID_BAR();
        }
        { LANE_DECL(); const float* g3 = INP(4) + (size_t)(L * 4 + 3) * DM; bf16* XB = WSP(bf16, WS_XB); const bf16* H = WSP(bf16, WS_H); const float* psh = WSP(float, PS_H); const float* pse = WSP(float, PS_E); float* sse = WSP(float, SS_E); const float* ssx2 = WSP(float, SS_X2);
          constexpr int RD = 4; int m0 = gwl;
          for (; m0 + (RD - 1) * NGW < T; m0 += RD * NGW) thin_d_rows<RD>(m0, NGW, lane, g3, XB, H, psh, pse, sse, ssx2);
          for (; m0 < T; m0 += NGW) thin_d_rows<1>(m0, NGW, lane, g3, XB, H, psh, pse, sse, ssx2);
        }
        GRID_BAR();
#ifndef DBG_NO_GEMM
        { pg8::Gemm g{WSP(bf16, WS_XB), WSP(bf16, WS_WLAY + L * W_LAYER + WO_G), T, DM, DM}; pg8::StaticOrder S; S.init(T, DM, G, bx + ZERO());
          pg8::EpiGate E{WSP(bf16, WS_XB), WSP(bf16, WS_E), (L + 1 < DEPTH) ? (bf16*)(args.out + ZERO()) : (bf16*)nullptr, args.out + ZERO(), DM, WSP(float, SS_E), INP(19) + (size_t)L * DM, WSP(float, PS_X)};
          pg8::gemm_phase<pg8::EpiGate, pg8::StaticOrder, true, true>(lds + RING_OFF, g, S, E);
        }
#endif
        if (L + 1 < DEPTH) {
            GRID_BAR();
            { LANE_DECL(); const float* psx = WSP(float, PS_X); float* ssx = WSP(float, SS_XIN);
              for (int m = gwl; m < T; m += NGW) { const float s = wave_sum(lane < 32 ? psx[(size_t)m * 32 + lane] : 0.f); if (lane == 0) ssx[m] = s; } }
            GRID_BAR();
        }
    }
#undef GRID_BAR
}

extern "C" void kernel_launch(void* const* d_in, const int* in_sizes, int n_in, void* d_out, int out_size, void* d_ws, size_t ws_size, hipStream_t stream) {
    static int grid = 0;
    if (grid == 0) {
        if (n_in != 20 || out_size != T * DM || ws_size < WS_END) { fprintf(stderr, "kernel_launch: unexpected shapes: n_in %d out %d ws %zu (need %zu)\n", n_in, out_size, ws_size, (size_t)WS_END); grid = -1; return; }
        int dev = 0, cus = 0, per_cu = 0;
        if (hipGetDevice(&dev) != hipSuccess || hipDeviceGetAttribute(&cus, hipDeviceAttributeMultiprocessorCount, dev) != hipSuccess) { grid = -1; return; }
        if (hipFuncSetAttribute((const void*)trunk_fwd, hipFuncAttributeMaxDynamicSharedMemorySize, LDS_BYTES) != hipSuccess) { fprintf(stderr, "kernel_launch: hipFuncSetAttribute failed\n"); grid = -1; return; }
        if (hipOccupancyMaxActiveBlocksPerMultiprocessor(&per_cu, (const void*)trunk_fwd, NWAVES * 64, LDS_BYTES) != hipSuccess || per_cu < 1) fprintf(stderr, "kernel_launch: occupancy query reports %d\n", per_cu);
        (void)hipGetLastError();
        grid = cus;
    }
    if (grid < 0) return;
    if (hipMemsetAsync((char*)d_ws + WS_CTL, 0, CTL_ZERO_BYTES, stream) != hipSuccess) return;
    Args a{};
    for (int i = 0; i < 20; ++i) a.in[i] = (const float*)d_in[i];
    a.out = (float*)d_out; a.ws = (unsigned char*)d_ws;
    hipLaunchKernelGGL(trunk_fwd, dim3(grid), dim3(NWAVES * 64), LDS_BYTES, stream, a);
    const hipError_t le = hipPeekAtLastError();
    if (le != hipSuccess) fprintf(stderr, "kernel_launch: launch failed: %s\n", hipGetErrorName(le));
}
```

```cpp
#include <hip/hip_runtime.h>
#include <cstdio>
#include <cstdint>
namespace pg8 {
#define PG8_LAS __attribute__((address_space(3)))
typedef unsigned short bf16_t;
typedef short bf16x8 __attribute__((ext_vector_type(8)));
typedef float f32x4 __attribute__((ext_vector_type(4)));
typedef unsigned u32x4 __attribute__((ext_vector_type(4)));
constexpr int BM = 256, BK = 64, HALF = 128, HTB = HALF * BK * 2  , STAGE_BYTES = 8 * HTB, NXCD = 8, WGM = 8;

__host__ __device__ __forceinline__ int lds_byte(int r, int c) { const int st = (r >> 4) * 2 + (c >> 5), rr = r & 15, cc = c & 31, ob = rr * 64 + cc * 2; return st * 1024 + (ob ^ (((ob >> 9) & 1) << 5)); }
__host__ __device__ __forceinline__ void stage_rc(int b, int& R, int& C) { const int st = b / 1024, sb = b % 1024, swz = sb ^ (((sb >> 9) & 1) << 5); R = (st >> 1) * 16 + swz / 64; C = (st & 1) * 32 + (swz % 64) / 2; }
__host__ __device__ __forceinline__ int perm32(int rho) { const int n = rho >> 4, i = rho & 15; return 8 * (i >> 2) + 4 * n + (i & 3); }

struct Unit { int pm, pn; };
struct Gemm { const bf16_t* A; const bf16_t* Bt; int M, N, K; };

struct StaticOrder {
    int nM, nN, nwg, G, c;
    __host__ __device__ void init(int M, int N, int G_, int c_) { nM = M / BM; nN = N / BM; nwg = nM * nN; G = G_; c = c_; }
    __host__ __device__ bool next(int i, Unit& u) const {
        const long L = (long)i * G + c; if (L >= nwg) return false;
        int wgid = (int)L; { const int q = nwg / NXCD, r = nwg % NXCD, xcd = wgid % NXCD, off = wgid / NXCD; wgid = (xcd < r ? xcd * (q + 1) : r * (q + 1) + (xcd - r) * q) + off; }
        const int nig = WGM * nN, gid = wgid / nig, fm = gid * WGM, gsz = (nM - fm) < WGM ? (nM - fm) : WGM;
        u.pm = fm + ((wgid % nig) % gsz); u.pn = (wgid % nig) / gsz; return true;
    }
    __device__ __forceinline__ void a_ready(const Unit&) const {}
    __device__ __forceinline__ void done(const Unit&) const {}
};

__device__ __forceinline__ unsigned cvt_pk_bf16(float lo, float hi) { unsigned r; asm volatile("v_cvt_pk_bf16_f32 %0, %1, %2" : "=v"(r) : "v"(lo), "v"(hi)); return r; }
typedef float f32x2 __attribute__((ext_vector_type(2)));

constexpr float RMS_EPS = 1e-6f;
template <int NP> __device__ __forceinline__ float row_rs(const float* ss, int row, float inv_d) {
    float s;
    if (NP == 1) s = ss[row];
    else { const f32x4 a = *(const f32x4*)(ss + (size_t)row * 8), b = *(const f32x4*)(ss + (size_t)row * 8 + 4); s = ((a[0] + a[1]) + (a[2] + a[3])) + ((b[0] + b[1]) + (b[2] + b[3])); }
    return __builtin_amdgcn_rsqf(s * inv_d + RMS_EPS);
}
__device__ __forceinline__ void stat_put(float* ps, int row, int ns, int slot, float part, int fq) {
    part += __shfl_xor(part, 16); part += __shfl_xor(part, 32);
    if (fq == 0) ps[(size_t)row * ns + slot] = part;
}
__device__ __forceinline__ float sq4v(f32x4 v) { return (v[0] * v[0] + v[1] * v[1]) + (v[2] * v[2] + v[3] * v[3]); }

template <int ACT  , int RS  , bool STAT  > struct EpiBf16 {
    static constexpr bool PERM = true, AFTER_DRAIN = false; static constexpr int EPI_STORES_MIN = 16;
    bf16_t* O; int ldc; const float* ss_in; float inv_d; float* ss_out; int row_off;
    __device__ __forceinline__ void operator()(const f32x4 (&acc)[2][2][4][2], const Unit& u, int wr, int wc, int fr, int fq) const {
        const int row0 = u.pm * BM + wr * 64 + fr, col0 = u.pn * BM + wc * 32 + 8 * fq;
#pragma unroll
        for (int ai = 0; ai < 2; ++ai)
#pragma unroll
            for (int m = 0; m < 4; ++m) { const int row = row0 + ai * HALF + m * 16; bf16_t* rowp = O + (size_t)row * ldc + col0;
                float rs = 1.f; if (RS) { rs = row_rs<(RS ? RS : 1)>(ss_in, row_off + row, inv_d); if (ACT == 1) rs = rs * rs; }
                float part = 0.f;
#pragma unroll
                for (int bj = 0; bj < 2; ++bj) { f32x4 v0 = acc[ai][bj][m][0], v1 = acc[ai][bj][m][1];
                    if (ACT == 1) {
#pragma unroll
                        for (int e = 0; e < 4; ++e) { const float a = fmaxf(v0[e], 0.f), b = fmaxf(v1[e], 0.f); v0[e] = a * a; v1[e] = b * b; } }
                    if (RS) { v0 = v0 * rs; v1 = v1 * rs; }
                    if (STAT) part += sq4v(v0) + sq4v(v1);
                    u32x4 w; w.x = cvt_pk_bf16(v0[0], v0[1]); w.y = cvt_pk_bf16(v0[2], v0[3]); w.z = cvt_pk_bf16(v1[0], v1[1]); w.w = cvt_pk_bf16(v1[2], v1[3]);
                    *(u32x4*)(rowp + bj * HALF) = w; }
                if (STAT) stat_put(ss_out, row_off + row, 32, u.pn * 4 + wc, part, fq); }
    }
};
struct EpiLat {
    static constexpr bool PERM = true, AFTER_DRAIN = false; static constexpr int EPI_STORES_MIN = 0;
    bf16_t* CQ; bf16_t* CKV; bf16_t* KR; const float* ss_in; float* ssq; float* sskv; const float* rot;
    __device__ __forceinline__ void operator()(const f32x4 (&acc)[2][2][4][2], const Unit& u, int wr, int wc, int fr, int fq) const {
        const int row0 = u.pm * BM + wr * 64 + fr, col0 = u.pn * BM + wc * 32 + 8 * fq;
        if (u.pn < 4) { float* ssd = u.pn < 2 ? ssq : sskv; bf16_t* C = (u.pn < 2 ? CQ : CKV) + (u.pn & 1) * BM + wc * 32 + 8 * fq;
#pragma unroll
            for (int ai = 0; ai < 2; ++ai)
#pragma unroll
                for (int m = 0; m < 4; ++m) { const int row = row0 + ai * HALF + m * 16; const float rs = row_rs<1>(ss_in, row, 1.0f / 2048.0f); float part = 0.f;
#pragma unroll
                    for (int bj = 0; bj < 2; ++bj) { const f32x4 v0 = acc[ai][bj][m][0] * rs, v1 = acc[ai][bj][m][1] * rs; part += sq4v(v0) + sq4v(v1);
                        u32x4 w; w.x = cvt_pk_bf16(v0[0], v0[1]); w.y = cvt_pk_bf16(v0[2], v0[3]); w.z = cvt_pk_bf16(v1[0], v1[1]); w.w = cvt_pk_bf16(v1[2], v1[3]);
                        *(u32x4*)(C + (size_t)row * 512 + bj * HALF) = w; }
                    stat_put(ssd, row, 8, (u.pn & 1) * 4 + wc, part, fq); }
        } else if (wc < 2) { const int d0 = 16 * wc + 4 * fq;
#pragma unroll
            for (int ai = 0; ai < 2; ++ai)
#pragma unroll
                for (int m = 0; m < 4; ++m) { const int row = row0 + ai * HALF + m * 16; const float rs = row_rs<1>(ss_in, row, 1.0f / 2048.0f); const int pos = row < 16384 ? row : ((row - 16384) & 4095);
                    const f32x4 v0 = acc[ai][0][m][0] * rs, v1 = acc[ai][0][m][1] * rs;
                    const f32x4 cs0 = *(const f32x4*)(rot + ((size_t)pos * 32 + d0) * 2), cs1 = *(const f32x4*)(rot + ((size_t)pos * 32 + d0 + 2) * 2);
                    u32x4 w; w.x = cvt_pk_bf16(v0[0] * cs0[0] - v0[1] * cs0[1], v0[1] * cs0[0] + v0[0] * cs0[1]); w.y = cvt_pk_bf16(v0[2] * cs0[2] - v0[3] * cs0[3], v0[3] * cs0[2] + v0[2] * cs0[3]);
                    w.z = cvt_pk_bf16(v1[0] * cs1[0] - v1[1] * cs1[1], v1[1] * cs1[0] + v1[0] * cs1[1]); w.w = cvt_pk_bf16(v1[2] * cs1[2] - v1[3] * cs1[3], v1[3] * cs1[2] + v1[2] * cs1[3]);
                    *(u32x4*)(KR + (size_t)row * 64 + 32 * wc + 8 * fq) = w; }
        }
    }
};
struct EpiQRope {
    static constexpr bool PERM = true, AFTER_DRAIN = false; static constexpr int EPI_STORES_MIN = 0;
    bf16_t* O; int ldc; const float* rot; float scale; const float* ss_in;
    __device__ __forceinline__ void operator()(const f32x4 (&acc)[2][2][4][2], const Unit& u, int wr, int wc, int fr, int fq) const {
        const int row0 = u.pm * BM + wr * 64 + fr, col0 = u.pn * BM + wc * 32 + 8 * fq;
#pragma unroll
        for (int ai = 0; ai < 2; ++ai)
#pragma unroll
            for (int m = 0; m < 4; ++m) { const int row = row0 + ai * HALF + m * 16; const float rs = row_rs<8>(ss_in, row, 1.0f / 512.0f) * scale; const int pos = row < 16384 ? row : ((row - 16384) & 4095);
#pragma unroll
                for (int bj = 0; bj < 2; ++bj) {
                    const int sb = u.pn * BM + bj * HALF + wc * 32, hr = sb % 192; const bool rope = hr >= 128; const int d0 = ((hr - 128) >> 1) + 4 * fq;
                    f32x4 v0 = acc[ai][bj][m][0] * rs, v1 = acc[ai][bj][m][1] * rs;
                    if (rope) {
                        const f32x4 cs0 = *(const f32x4*)(rot + ((size_t)pos * 32 + d0) * 2), cs1 = *(const f32x4*)(rot + ((size_t)pos * 32 + d0 + 2) * 2);
                        f32x4 o0, o1;
                        o0[0] = v0[0] * cs0[0] - v0[1] * cs0[1]; o0[1] = v0[1] * cs0[0] + v0[0] * cs0[1];
                        o0[2] = v0[2] * cs0[2] - v0[3] * cs0[3]; o0[3] = v0[3] * cs0[2] + v0[2] * cs0[3];
                        o1[0] = v1[0] * cs1[0] - v1[1] * cs1[1]; o1[1] = v1[1] * cs1[0] + v1[0] * cs1[1];
                        o1[2] = v1[2] * cs1[2] - v1[3] * cs1[3]; o1[3] = v1[3] * cs1[2] + v1[2] * cs1[3];
                        v0 = o0; v1 = o1; }
                    u32x4 w; w.x = cvt_pk_bf16(v0[0], v0[1]); w.y = cvt_pk_bf16(v0[2], v0[3]); w.z = cvt_pk_bf16(v1[0], v1[1]); w.w = cvt_pk_bf16(v1[2], v1[3]);
                    *(u32x4*)(O + (size_t)row * ldc + col0 + bj * HALF) = w; } }
    }
};
struct EpiGate {
    static constexpr bool PERM = true, AFTER_DRAIN = false; static constexpr int EPI_STORES_MIN = 0;
    const bf16_t* XBin; const bf16_t* E; bf16_t* XBout; float* OUT; int ldc; const float* sse; const float* pn; float* ss_out;
    __device__ __forceinline__ void operator()(const f32x4 (&acc)[2][2][4][2], const Unit& u, int wr, int wc, int fr, int fq) const {
        const int row0 = u.pm * BM + wr * 64 + fr, col0 = u.pn * BM + wc * 32 + 8 * fq;
        f32x4 g[2][2];
#pragma unroll
        for (int bj = 0; bj < 2; ++bj)
#pragma unroll
            for (int n = 0; n < 2; ++n) g[bj][n] = *(const f32x4*)(pn + col0 + bj * HALF + 4 * n);
#pragma unroll
        for (int am = 0; am < 4; ++am) { const int ai = am >> 1, m0 = (am & 1) * 2;
            u32x4 xw[4][2], ew[4][2]; float re[4];
#pragma unroll
            for (int m = m0; m < m0 + 2; ++m) { const int row = row0 + ai * HALF + m * 16; const size_t off = (size_t)row * ldc + col0; re[m] = sse[row];
#pragma unroll
                for (int bj = 0; bj < 2; ++bj) { xw[m][bj] = *(const u32x4*)(XBin + off + bj * HALF); ew[m][bj] = *(const u32x4*)(E + off + bj * HALF); } }
#pragma unroll
            for (int m = m0; m < m0 + 2; ++m) { const int row = row0 + ai * HALF + m * 16; const size_t off = (size_t)row * ldc + col0; const float rs = __builtin_amdgcn_rsqf(re[m] * (1.0f / 2048.0f) + RMS_EPS); float part = 0.f;
#pragma unroll
                for (int bj = 0; bj < 2; ++bj) { f32x4 r[2];
#pragma unroll
                    for (int n = 0; n < 2; ++n) { const unsigned x0 = n ? xw[m][bj].z : xw[m][bj].x, x1 = n ? xw[m][bj].w : xw[m][bj].y, e0 = n ? ew[m][bj].z : ew[m][bj].x, e1 = n ? ew[m][bj].w : ew[m][bj].y;
                        f32x4 x; x[0] = __uint_as_float(x0 << 16); x[1] = __uint_as_float(x0 & 0xffff0000u); x[2] = __uint_as_float(x1 << 16); x[3] = __uint_as_float(x1 & 0xffff0000u);
                        f32x4 ev; ev[0] = __uint_as_float(e0 << 16); ev[1] = __uint_as_float(e0 & 0xffff0000u); ev[2] = __uint_as_float(e1 << 16); ev[3] = __uint_as_float(e1 & 0xffff0000u);
                        ev = ev * g[bj][n] * rs; const f32x4 a = acc[ai][bj][m][n];
#pragma unroll
                        for (int k = 0; k < 4; ++k) { const float sg = __builtin_amdgcn_rcpf(1.0f + __builtin_amdgcn_exp2f(-1.4426950408889634f * a[k])); r[n][k] = x[k] + ev[k] * sg; } }
                    if (XBout) { part += sq4v(r[0]) + sq4v(r[1]); u32x4 w; w.x = cvt_pk_bf16(r[0][0], r[0][1]); w.y = cvt_pk_bf16(r[0][2], r[0][3]); w.z = cvt_pk_bf16(r[1][0], r[1][1]); w.w = cvt_pk_bf16(r[1][2], r[1][3]);
                        *(u32x4*)(XBout + off + bj * HALF) = w; }
                    else { *(f32x4*)(OUT + off + bj * HALF) = r[0]; *(f32x4*)(OUT + off + bj * HALF + 4) = r[1]; } }
                if (XBout) stat_put(ss_out, row, 32, u.pn * 4 + wc, part, fq); }
            asm volatile("" ::: "memory"); }
    }
};
__device__ __forceinline__ void pg8_dma2(unsigned v0, unsigned v1, const void* base, unsigned dst) { unsigned keep;
    asm volatile("s_mov_b32 %0, m0\n\ts_mov_b32 m0, %4\n\ts_nop 0\n\tglobal_load_lds_dwordx4 %1, %3\n\ts_add_u32 m0, m0, 0x2000\n\ts_nop 0\n\tglobal_load_lds_dwordx4 %2, %3\n\ts_mov_b32 m0, %0"
                 : "=&s"(keep) : "v"(v0), "v"(v1), "s"(base), "s"(dst) : "memory", "scc"); }
__device__ __forceinline__ void pg8_dma6(unsigned v0, unsigned v1, unsigned v2, unsigned v3, unsigned v4, unsigned v5, const void* b0, const void* b1, const void* b2, unsigned d0, unsigned d1, unsigned d2) { unsigned keep;
    asm volatile("s_mov_b32 %0, m0\n\ts_mov_b32 m0, %10\n\ts_nop 0\n\tglobal_load_lds_dwordx4 %1, %7\n\ts_add_u32 m0, m0, 0x2000\n\ts_nop 0\n\tglobal_load_lds_dwordx4 %2, %7\n\t"
                 "s_mov_b32 m0, %11\n\ts_nop 0\n\tglobal_load_lds_dwordx4 %3, %8\n\ts_add_u32 m0, m0, 0x2000\n\ts_nop 0\n\tglobal_load_lds_dwordx4 %4, %8\n\t"
                 "s_mov_b32 m0, %12\n\ts_nop 0\n\tglobal_load_lds_dwordx4 %5, %9\n\ts_add_u32 m0, m0, 0x2000\n\ts_nop 0\n\tglobal_load_lds_dwordx4 %6, %9\n\ts_mov_b32 m0, %0"
                 : "=&s"(keep) : "v"(v0), "v"(v1), "v"(v2), "v"(v3), "v"(v4), "v"(v5), "s"(b0), "s"(b1), "s"(b2), "s"(d0), "s"(d1), "s"(d2) : "memory", "scc"); }
#ifndef PG8_DPOS
#define PG8_DPOS 0
#endif
template <class Epi, class Sched, bool ALIGN_EPI = false, bool SP2 = false>
__device__ __forceinline__ void gemm_phase(PG8_LAS unsigned char* lds, const Gemm g, const Sched& S, const Epi& E) {
    int tid_ = threadIdx.x; asm volatile("" : "+v"(tid_));
    const int tid = tid_, wid = __builtin_amdgcn_readfirstlane(tid >> 6), lane = tid & 63, wr = wid >> 2, wc = wid & 3, fr = lane & 15, fq = lane >> 4;
    const int K = g.K, nt = K / BK;
    unsigned voffA[2], voffB[2];
#pragma unroll
    for (int i = 0; i < 2; ++i) { int R, C; stage_rc(tid * 16 + i * 8192, R, C); const int Rb = Epi::PERM ? ((R & ~31) + perm32(R & 31)) : R;
        voffA[i] = (unsigned)(R * K + C) * 2u; voffB[i] = (unsigned)(Rb * K + C) * 2u; }
    const size_t kstep = (size_t)(BK * 2);
    const size_t hstep = (size_t)HALF * K * 2;
    const size_t tstep = 2 * hstep;
    const unsigned ldsw = (unsigned)wid * 1024u;
    const unsigned ldsb = (unsigned)__builtin_amdgcn_readfirstlane((int)((unsigned)(size_t)lds + ldsw));
    const int aoff = lds_byte(wr * 64 + fr, fq * 8), boff = lds_byte(wc * 32 + fr, fq * 8);
#define PG8_SA(b, h) (((b) * 2 + (h)) * HTB)
#define PG8_SB(b, h) ((4 + (b) * 2 + (h)) * HTB)
#define PG8_STAGE(bufoff, gbase, voff) pg8_dma2((voff)[0], (voff)[1], (gbase), ldsb + (unsigned)(bufoff))
#define PG8_STAGE3(o0, g0, v0, o1, g1, v1, o2, g2, v2) pg8_dma6((v0)[0], (v0)[1], (v1)[0], (v1)[1], (v2)[0], (v2)[1], (g0), (g1), (g2), ldsb + (unsigned)(o0), ldsb + (unsigned)(o1), ldsb + (unsigned)(o2))
#define PG8_LDA(dst, b, h) do { _Pragma("unroll") for (int m = 0; m < 4; ++m) _Pragma("unroll") for (int k = 0; k < 2; ++k) dst[m][k] = *(const PG8_LAS bf16x8*)(lds + PG8_SA(b, h) + aoff + m * 2048 + k * 1024); } while (0)
#define PG8_LDB(dst, b, h) do { _Pragma("unroll") for (int n = 0; n < 2; ++n) _Pragma("unroll") for (int k = 0; k < 2; ++k) dst[n][k] = *(const PG8_LAS bf16x8*)(lds + PG8_SB(b, h) + boff + n * 2048 + k * 1024); } while (0)
#define PG8_MMA(ai, bj, At, Bt) do { __builtin_amdgcn_s_setprio(1); _Pragma("unroll") for (int m = 0; m < 4; ++m) _Pragma("unroll") for (int n = 0; n < 2; ++n) _Pragma("unroll") for (int k = 0; k < 2; ++k) \
        acc[ai][bj][m][n] = __builtin_amdgcn_mfma_f32_16x16x32_bf16(Bt[n][k], At[m][k], acc[ai][bj][m][n], 0, 0, 0); __builtin_amdgcn_s_setprio(0); } while (0)
#define PG8_WAIT_VN(n) asm volatile("s_waitcnt vmcnt(%0)" :: "n"(n) : "memory")
#define PG8_WAIT_V(n) asm volatile("s_waitcnt vmcnt(" #n ")" ::: "memory")
#define PG8_WAIT_L(n) asm volatile("s_waitcnt lgkmcnt(" #n ")" ::: "memory")
#define PG8_BAR __builtin_amdgcn_s_barrier()
#define PG8_SCHED __builtin_amdgcn_sched_barrier(0)
    constexpr int ESN = (SP2 && !Epi::AFTER_DRAIN) ? Epi::EPI_STORES_MIN : 0;
    Unit cur, nxt; int ui = 0;
    if (!S.next(0, cur)) return;
    typedef double f64x2z __attribute__((ext_vector_type(2)));
    f32x4 acc[2][2][4][2];
#pragma unroll
    for (int a = 0; a < 2; ++a)
#pragma unroll
        for (int b = 0; b < 2; ++b)
#pragma unroll
            for (int m = 0; m < 4; ++m)
#pragma unroll
                for (int n = 0; n < 2; ++n) { double z0_, z1_; asm volatile("v_mov_b64 %0, 0\n\tv_mov_b64 %1, 0" : "=v"(z0_), "=v"(z1_)); const f64x2z zz_ = {z0_, z1_}; acc[a][b][m][n] = __builtin_bit_cast(f32x4, zz_); }
    bf16x8 At[4][2], B0[2][2], B1[2][2];
    const char* cA = (const char*)g.A + (size_t)cur.pm * tstep; const char* cB = (const char*)g.Bt + (size_t)cur.pn * tstep;
    S.a_ready(cur);
    if constexpr (SP2) {
        PG8_STAGE(PG8_SB(0, 0), cB, voffB); PG8_STAGE(PG8_SB(0, 1), cB + hstep, voffB); PG8_STAGE(PG8_SA(0, 0), cA, voffA); PG8_STAGE(PG8_SA(0, 1), cA + hstep, voffA);
        if (wr == 1) PG8_BAR;
        PG8_WAIT_V(2); PG8_BAR;
        PG8_STAGE(PG8_SB(1, 0), cB + kstep, voffB); PG8_STAGE(PG8_SA(1, 0), cA + kstep, voffA); PG8_STAGE(PG8_SB(1, 1), cB + hstep + kstep, voffB);
        PG8_WAIT_V(6); PG8_BAR;
    } else {
        PG8_STAGE(PG8_SB(0, 0), cB, voffB); PG8_STAGE(PG8_SA(0, 0), cA, voffA); PG8_STAGE(PG8_SB(0, 1), cB + hstep, voffB); PG8_STAGE(PG8_SA(0, 1), cA + hstep, voffA);
        if (wr == 1) PG8_BAR;
        PG8_WAIT_V(4); PG8_BAR;
        PG8_STAGE(PG8_SB(1, 0), cB + kstep, voffB); PG8_STAGE(PG8_SA(1, 0), cA + kstep, voffA); PG8_STAGE(PG8_SB(1, 1), cB + hstep + kstep, voffB);
        PG8_WAIT_V(6); PG8_BAR;
    }
    for (;;) {
        const bool has_next = S.next(ui + 1, nxt);
        const char* nA = has_next ? (const char*)g.A + (size_t)nxt.pm * tstep : cA; const char* nB = has_next ? (const char*)g.Bt + (size_t)nxt.pn * tstep : cB;
        const int tfirst = __builtin_amdgcn_readfirstlane(ui > 0 ? 0 : -1);
        for (int t = 0; t < nt; t += 2) {
            const bool last = (t == nt - 2);
            const char* a1 = cA + (size_t)(t + 1) * kstep;
            const char* a2 = last ? nA : cA + (size_t)(t + 2) * kstep; const char* b2 = last ? nB : cB + (size_t)(t + 2) * kstep;
            const char* a3 = a2 + kstep; const char* b3 = b2 + kstep;
            if (last && has_next) S.a_ready(nxt);
            if constexpr (SP2) {
#if PG8_DPOS == 0
            PG8_LDB(B0, 0, 0); PG8_LDB(B1, 0, 1); PG8_SCHED; PG8_LDA(At, 0, 0); PG8_STAGE(PG8_SA(1, 1), a1 + hstep, voffA);
            if (ESN > 0 && t == tfirst) { PG8_WAIT_VN(8 + ESN); } else { PG8_WAIT_V(8); }
            PG8_WAIT_L(0); PG8_BAR; PG8_MMA(0, 0, At, B0); PG8_MMA(0, 1, At, B1); PG8_BAR; PG8_SCHED;
#elif PG8_DPOS == 1
            PG8_LDB(B0, 0, 0); PG8_LDB(B1, 0, 1); PG8_SCHED; PG8_LDA(At, 0, 0);
            PG8_WAIT_V(6); PG8_WAIT_L(0); PG8_BAR; PG8_SCHED; PG8_STAGE(PG8_SA(1, 1), a1 + hstep, voffA); PG8_SCHED; PG8_MMA(0, 0, At, B0); PG8_MMA(0, 1, At, B1); PG8_BAR; PG8_SCHED;
#else
            PG8_LDB(B0, 0, 0); PG8_LDB(B1, 0, 1); PG8_SCHED; PG8_LDA(At, 0, 0);
            PG8_WAIT_V(6); PG8_WAIT_L(0); PG8_BAR; PG8_MMA(0, 0, At, B0); PG8_SCHED; PG8_STAGE(PG8_SA(1, 1), a1 + hstep, voffA); PG8_SCHED; PG8_MMA(0, 1, At, B1); PG8_BAR; PG8_SCHED;
#endif
#if PG8_DPOS == 0
            PG8_LDA(At, 0, 1); PG8_STAGE3(PG8_SB(0, 0), b2, voffB, PG8_SB(0, 1), b2 + hstep, voffB, PG8_SA(0, 0), a2, voffA);
            if (ESN > 0 && t == tfirst) { PG8_WAIT_VN(8 + ESN); } else { PG8_WAIT_V(8); }
            PG8_WAIT_L(0); PG8_BAR; PG8_MMA(1, 0, At, B0); PG8_MMA(1, 1, At, B1); PG8_BAR; PG8_SCHED;
#elif PG8_DPOS == 1
            PG8_LDA(At, 0, 1);
            PG8_WAIT_V(2); PG8_WAIT_L(0); PG8_BAR; PG8_SCHED; PG8_STAGE3(PG8_SB(0, 0), b2, voffB, PG8_SB(0, 1), b2 + hstep, voffB, PG8_SA(0, 0), a2, voffA); PG8_SCHED; PG8_MMA(1, 0, At, B0); PG8_MMA(1, 1, At, B1); PG8_BAR; PG8_SCHED;
#else
            PG8_LDA(At, 0, 1);
            PG8_WAIT_V(2); PG8_WAIT_L(0); PG8_BAR; PG8_MMA(1, 0, At, B0); PG8_SCHED; PG8_STAGE3(PG8_SB(0, 0), b2, voffB, PG8_SB(0, 1), b2 + hstep, voffB, PG8_SA(0, 0), a2, voffA); PG8_SCHED; PG8_MMA(1, 1, At, B1); PG8_BAR; PG8_SCHED;
#endif
#if PG8_DPOS == 0
            PG8_LDB(B0, 1, 0); PG8_LDB(B1, 1, 1); PG8_SCHED; PG8_LDA(At, 1, 0); PG8_STAGE(PG8_SA(0, 1), a2 + hstep, voffA);
            PG8_WAIT_V(8); PG8_WAIT_L(0); PG8_BAR; PG8_MMA(0, 0, At, B0); PG8_MMA(0, 1, At, B1); PG8_BAR; PG8_SCHED;
#elif PG8_DPOS == 1
            PG8_LDB(B0, 1, 0); PG8_LDB(B1, 1, 1); PG8_SCHED; PG8_LDA(At, 1, 0);
            PG8_WAIT_V(6); PG8_WAIT_L(0); PG8_BAR; PG8_SCHED; PG8_STAGE(PG8_SA(0, 1), a2 + hstep, voffA); PG8_SCHED; PG8_MMA(0, 0, At, B0); PG8_MMA(0, 1, At, B1); PG8_BAR; PG8_SCHED;
#else
            PG8_LDB(B0, 1, 0); PG8_LDB(B1, 1, 1); PG8_SCHED; PG8_LDA(At, 1, 0);
            PG8_WAIT_V(6); PG8_WAIT_L(0); PG8_BAR; PG8_MMA(0, 0, At, B0); PG8_SCHED; PG8_STAGE(PG8_SA(0, 1), a2 + hstep, voffA); PG8_SCHED; PG8_MMA(0, 1, At, B1); PG8_BAR; PG8_SCHED;
#endif
#if PG8_DPOS == 0
            PG8_LDA(At, 1, 1); PG8_STAGE3(PG8_SB(1, 0), b3, voffB, PG8_SB(1, 1), b3 + hstep, voffB, PG8_SA(1, 0), a3, voffA);
            PG8_WAIT_V(8); PG8_WAIT_L(0); PG8_BAR; PG8_MMA(1, 0, At, B0); PG8_MMA(1, 1, At, B1); PG8_BAR; PG8_SCHED;
#elif PG8_DPOS == 1
            PG8_LDA(At, 1, 1);
            PG8_WAIT_V(2); PG8_WAIT_L(0); PG8_BAR; PG8_SCHED; PG8_STAGE3(PG8_SB(1, 0), b3, voffB, PG8_SB(1, 1), b3 + hstep, voffB, PG8_SA(1, 0), a3, voffA); PG8_SCHED; PG8_MMA(1, 0, At, B0); PG8_MMA(1, 1, At, B1); PG8_BAR; PG8_SCHED;
#else
            PG8_LDA(At, 1, 1);
            PG8_WAIT_V(2); PG8_WAIT_L(0); PG8_BAR; PG8_MMA(1, 0, At, B0); PG8_SCHED; PG8_STAGE3(PG8_SB(1, 0), b3, voffB, PG8_SB(1, 1), b3 + hstep, voffB, PG8_SA(1, 0), a3, voffA); PG8_SCHED; PG8_MMA(1, 1, At, B1); PG8_BAR; PG8_SCHED;
#endif
            } else {
            PG8_LDB(B0, 0, 0); PG8_SCHED; PG8_LDA(At, 0, 0); PG8_STAGE(PG8_SA(1, 1), a1 + hstep, voffA);
            PG8_WAIT_L(8); PG8_BAR; PG8_WAIT_L(0); PG8_MMA(0, 0, At, B0); PG8_BAR; PG8_SCHED;
            PG8_LDB(B1, 0, 1); PG8_STAGE(PG8_SB(0, 0), b2, voffB);
            PG8_BAR; PG8_WAIT_L(0); PG8_MMA(0, 1, At, B1); PG8_BAR;
            PG8_LDA(At, 0, 1); PG8_STAGE(PG8_SA(0, 0), a2, voffA);
            PG8_BAR; PG8_WAIT_L(0); PG8_MMA(1, 0, At, B0); PG8_BAR; PG8_SCHED;
            PG8_STAGE(PG8_SB(0, 1), b2 + hstep, voffB);
            PG8_WAIT_V(6); PG8_BAR; PG8_MMA(1, 1, At, B1); PG8_BAR;
            PG8_LDB(B0, 1, 0); PG8_SCHED; PG8_LDA(At, 1, 0); PG8_STAGE(PG8_SA(0, 1), a2 + hstep, voffA);
            PG8_WAIT_L(8); PG8_BAR; PG8_WAIT_L(0); PG8_MMA(0, 0, At, B0); PG8_BAR; PG8_SCHED;
            PG8_LDB(B1, 1, 1); PG8_STAGE(PG8_SB(1, 0), b3, voffB);
            PG8_BAR; PG8_WAIT_L(0); PG8_MMA(0, 1, At, B1); PG8_BAR;
            PG8_LDA(At, 1, 1); PG8_STAGE(PG8_SA(1, 0), a3, voffA);
            PG8_BAR; PG8_WAIT_L(0); PG8_MMA(1, 0, At, B0); PG8_BAR; PG8_SCHED;
            PG8_STAGE(PG8_SB(1, 1), b3 + hstep, voffB);
            PG8_WAIT_V(6); PG8_BAR; PG8_MMA(1, 1, At, B1); PG8_BAR;
            }
        }
        if constexpr (ALIGN_EPI) { if (wr == 0) PG8_BAR; }
        if constexpr (!Epi::AFTER_DRAIN) { E(acc, cur, wr, wc, fr, fq); S.done(cur); }
        if (!has_next) break;
#pragma unroll
        for (int a = 0; a < 2; ++a)
#pragma unroll
            for (int b = 0; b < 2; ++b)
#pragma unroll
                for (int m = 0; m < 4; ++m)
#pragma unroll
                    for (int n = 0; n < 2; ++n) { double z0_, z1_; asm volatile("v_mov_b64 %0, 0\n\tv_mov_b64 %1, 0" : "=v"(z0_), "=v"(z1_)); const f64x2z zz_ = {z0_, z1_}; acc[a][b][m][n] = __builtin_bit_cast(f32x4, zz_); }
        cur = nxt; cA = nA; cB = nB; ++ui;
        if constexpr (ALIGN_EPI) { if (wr == 1) PG8_BAR; }
    }
    PG8_WAIT_V(0);
    if constexpr (!ALIGN_EPI) { if (wr == 0) PG8_BAR; }
    PG8_BAR;
    if constexpr (Epi::AFTER_DRAIN) { E.fused(acc, cur, wr, wc, fr, fq, lds, wid, lane); S.done(cur); }
#undef PG8_SA
#undef PG8_SB
#undef PG8_STAGE
#undef PG8_STAGE3
#undef PG8_LDA
#undef PG8_LDB
#undef PG8_MMA
#undef PG8_WAIT_V
#undef PG8_WAIT_L
#undef PG8_BAR
#undef PG8_SCHED
}
}

#include <type_traits>
namespace att {
typedef short bf16x8 __attribute__((ext_vector_type(8)));
typedef short s16x4 __attribute__((ext_vector_type(4)));
typedef float f32x16 __attribute__((ext_vector_type(16)));
typedef unsigned u32x4 __attribute__((ext_vector_type(4)));
typedef unsigned short bf16_t;
#define ATT_LAS __attribute__((address_space(3)))
#define ATT_SBAR() __builtin_amdgcn_sched_barrier(0)
constexpr int KN_OFF = 0, KN_SLOT = 16384, KR_OFF = 49152, KR_SLOT = 8192, V_OFF = 73728, V_SLOT = 16384, WSC_OFF = V_OFF + 4 * V_SLOT, BT_OFF = KR_OFF, ATT_LDS_BYTES = WSC_OFF + 8 * 256;
constexpr int BT_STRIDE = 384, BT_ZERO = 191;
__host__ __device__ __forceinline__ int crow(int r, int hi) { return (r & 3) + 8 * (r >> 2) + 4 * hi; }
__device__ __forceinline__ unsigned cvtpk(float lo, float hi) { unsigned r; asm volatile("v_cvt_pk_bf16_f32 %0, %1, %2" : "=v"(r) : "v"(lo), "v"(hi)); return r; }
__host__ __device__ __forceinline__ int kn_byte(int R, int c) { return R * 256 + ((c ^ (R & 15)) << 4); }
__host__ __device__ __forceinline__ int kr_byte(int R, int c) { return R * 128 + ((c ^ ((R >> 1) & 7)) << 4); }
__host__ __device__ __forceinline__ int v_st(int k, int c) { const int kk = (k & ~0xC) | ((k & 4) << 1) | ((k & 8) >> 1); return ((kk >> 3) * 4 + (c >> 5)) * 512 + ((kk & 7) * 32 + (c & 31)) * 2; }
__host__ __device__ __forceinline__ int v_rd_base(int lane) { return ((lane & 3) << 3) | (((lane >> 2) & 3) << 6) | (((lane >> 4) & 1) << 5) | (((lane >> 5) & 1) << 8); }
__host__ __device__ constexpr int v_rd_off(int d0, int ks, int half) { return d0 * 512 + ks * 4096 + half * 2048; }
__host__ __device__ __forceinline__ void kn_inv(int b, int& R, int& c) { R = b >> 8; c = ((b >> 4) & 15) ^ (R & 15); }
__host__ __device__ __forceinline__ void kr_inv(int b, int& R, int& c) { R = b >> 7; c = ((b >> 4) & 7) ^ ((R >> 1) & 7); }
__host__ __device__ __forceinline__ void v_inv(int b, int& k, int& col) { const int s = b >> 9, w = b & 511, kk = ((s >> 2) << 3) | (w >> 6); k = (kk & ~0xC) | ((kk & 4) << 1) | ((kk & 8) >> 1); col = (s & 3) * 32 + ((w & 63) >> 1); }

__device__ __forceinline__ void glds16(const void* gsrc, unsigned lds_dst) { unsigned keep;
    asm volatile("s_mov_b32 %0, m0\n\ts_mov_b32 m0, %2\n\ts_nop 0\n\tglobal_load_lds_dwordx4 %1, off\n\ts_mov_b32 m0, %0" : "=&s"(keep) : "v"(gsrc), "s"(lds_dst) : "memory"); }
__device__ __forceinline__ void glds16x5(unsigned ok0, unsigned ok1, unsigned orr, unsigned ov0, unsigned ov1, const void* kb, const void* rb, const void* vb, unsigned dk, unsigned dr, unsigned dv) { unsigned keep;
    asm volatile("s_mov_b32 %0, m0\n\ts_mov_b32 m0, %9\n\ts_nop 0\n\tglobal_load_lds_dwordx4 %1, %6\n\ts_add_u32 m0, m0, 0x2000\n\ts_nop 0\n\tglobal_load_lds_dwordx4 %2, %6\n\t"
                 "s_mov_b32 m0, %10\n\ts_nop 0\n\tglobal_load_lds_dwordx4 %3, %7\n\ts_mov_b32 m0, %11\n\ts_nop 0\n\tglobal_load_lds_dwordx4 %4, %8\n\ts_add_u32 m0, m0, 0x2000\n\ts_nop 0\n\tglobal_load_lds_dwordx4 %5, %8\n\ts_mov_b32 m0, %0"
                 : "=&s"(keep) : "v"(ok0), "v"(ok1), "v"(orr), "v"(ov0), "v"(ov1), "s"(kb), "s"(rb), "s"(vb), "s"(dk), "s"(dr), "s"(dv) : "memory", "scc"); }
template <int OFF> __device__ __forceinline__ s16x4 tr_read(int vb) { s16x4 r; asm volatile("ds_read_b64_tr_b16 %0, %1 offset:%2" : "=&v"(r) : "v"(vb), "i"(OFF) : "memory"); return r; }
struct VFrag { s16x4 l0, h0, l1, h1, l2, h2, l3, h3; };
template <int D0> __device__ __forceinline__ void v_load(VFrag& f, int vb) {
    f.l0 = tr_read<v_rd_off(D0, 0, 0)>(vb); f.h0 = tr_read<v_rd_off(D0, 0, 1)>(vb); f.l1 = tr_read<v_rd_off(D0, 1, 0)>(vb); f.h1 = tr_read<v_rd_off(D0, 1, 1)>(vb);
    f.l2 = tr_read<v_rd_off(D0, 2, 0)>(vb); f.h2 = tr_read<v_rd_off(D0, 2, 1)>(vb); f.l3 = tr_read<v_rd_off(D0, 3, 0)>(vb); f.h3 = tr_read<v_rd_off(D0, 3, 1)>(vb);
}
__device__ __forceinline__ void pv_mma(f32x16& od, const VFrag& f, bf16x8 pa0, bf16x8 pa1, bf16x8 pa2, bf16x8 pa3) {
#define ATT_PK(L, H) (bf16x8){L[0], L[1], L[2], L[3], H[0], H[1], H[2], H[3]}
    od = __builtin_amdgcn_mfma_f32_32x32x16_bf16(pa0, ATT_PK(f.l0, f.h0), od, 0, 0, 0);
    od = __builtin_amdgcn_mfma_f32_32x32x16_bf16(pa1, ATT_PK(f.l1, f.h1), od, 0, 0, 0);
    od = __builtin_amdgcn_mfma_f32_32x32x16_bf16(pa2, ATT_PK(f.l2, f.h2), od, 0, 0, 0);
    od = __builtin_amdgcn_mfma_f32_32x32x16_bf16(pa3, ATT_PK(f.l3, f.h3), od, 0, 0, 0);
#undef ATT_PK
}
__device__ __forceinline__ void pv_all(f32x16* o, int vb, bf16x8 pa0, bf16x8 pa1, bf16x8 pa2, bf16x8 pa3) {
    VFrag fa, fb;
    v_load<0>(fa, vb); v_load<1>(fb, vb);
    asm volatile("s_waitcnt lgkmcnt(8)" ::: "memory"); ATT_SBAR(); pv_mma(o[0], fa, pa0, pa1, pa2, pa3); ATT_SBAR();
    v_load<2>(fa, vb);
    asm volatile("s_waitcnt lgkmcnt(8)" ::: "memory"); ATT_SBAR(); pv_mma(o[1], fb, pa0, pa1, pa2, pa3); ATT_SBAR();
    v_load<3>(fb, vb);
    asm volatile("s_waitcnt lgkmcnt(8)" ::: "memory"); ATT_SBAR(); pv_mma(o[2], fa, pa0, pa1, pa2, pa3); ATT_SBAR();
    asm volatile("s_waitcnt lgkmcnt(0)" ::: "memory"); ATT_SBAR(); pv_mma(o[3], fb, pa0, pa1, pa2, pa3); ATT_SBAR();
}
#define ATT_WAIT_BAR(N) asm volatile("s_waitcnt vmcnt(%0) lgkmcnt(0)\n\ts_barrier" :: "n"(N) : "memory")

template <bool SWA>
__device__ __forceinline__ void attn_unit(const bf16_t* __restrict__ Qw, int ldq, const bf16_t* __restrict__ Kn, const bf16_t* __restrict__ Kr, const bf16_t* __restrict__ Vg, int ldk,
                                          bf16_t* __restrict__ Ow, int ldo, int NT, int qk_rel0  , float C, float sinkl,
                                          ATT_LAS unsigned char* shm, const ATT_LAS float* bt) {
    constexpr int NQ = SWA ? 8 : 12;
    constexpr int PIECES = SWA ? 4 : 5;
    int tid_ = threadIdx.x; asm volatile("" : "+v"(tid_));
    const int tid = tid_, lane = tid & 63, r32 = lane & 31, hi = lane >> 5; const int wid = __builtin_amdgcn_readfirstlane(tid >> 6);
    const unsigned lds0 = (unsigned)(size_t)shm;
    ATT_LAS float* wsf = (ATT_LAS float*)(shm + WSC_OFF) + wid * 64;
    const bf16_t* ksrc0; const bf16_t* ksrc1; const bf16_t* rsrc = nullptr; const bf16_t* vsrc0; const bf16_t* vsrc1;
    { int R, c; kn_inv(wid * 1024 + lane * 16, R, c); ksrc0 = Kn + (size_t)R * ldk + c * 8; kn_inv((wid + 8) * 1024 + lane * 16, R, c); ksrc1 = Kn + (size_t)R * ldk + c * 8;
      if (!SWA) { kr_inv(wid * 1024 + lane * 16, R, c); rsrc = Kr + (size_t)R * 64 + c * 8; }
      int k, col; v_inv(wid * 1024 + lane * 16, k, col); vsrc0 = Vg + (size_t)k * ldk + col; v_inv((wid + 8) * 1024 + lane * 16, k, col); vsrc1 = Vg + (size_t)k * ldk + col; }
    const size_t tstep = (size_t)64 * ldk;
    const unsigned dk0 = lds0 + KN_OFF + wid * 1024, dk1 = dk0 + 8192, dr = lds0 + KR_OFF + wid * 1024, dv0 = lds0 + V_OFF + wid * 1024, dv1 = dv0 + 8192;
#define ATT_ISSUE(t, s, sv) do { const size_t to_ = (size_t)(t) * tstep; const unsigned s_ = (unsigned)(s), sv_ = (unsigned)(sv); \
        glds16(ksrc0 + to_, (unsigned)__builtin_amdgcn_readfirstlane(dk0 + s_ * KN_SLOT)); glds16(ksrc1 + to_, (unsigned)__builtin_amdgcn_readfirstlane(dk1 + s_ * KN_SLOT)); \
        if (!SWA) glds16(rsrc + (size_t)(t) * 64 * 64, (unsigned)__builtin_amdgcn_readfirstlane(dr + s_ * KR_SLOT)); \
        glds16(vsrc0 + to_, (unsigned)__builtin_amdgcn_readfirstlane(dv0 + sv_ * V_SLOT)); glds16(vsrc1 + to_, (unsigned)__builtin_amdgcn_readfirstlane(dv1 + sv_ * V_SLOT)); } while (0)
    ATT_ISSUE(0, 0, 0); if (NT > 1) ATT_ISSUE(1, 1, 1);
    bf16x8 qr[NQ];
#pragma unroll
    for (int d0 = 0; d0 < NQ; ++d0) qr[d0] = *(const bf16x8*)(Qw + (size_t)r32 * ldq + d0 * 16 + hi * 8);
#pragma unroll
    for (int d0 = 0; d0 < NQ; ++d0) asm volatile("" : "+v"(qr[d0]));
    constexpr float THR = 8.f;
    float m_reg = SWA ? sinkl : 0.f, l_reg = SWA ? 1.f : 0.f;
    f32x16 negm;
#pragma unroll
    for (int r = 0; r < 16; ++r) negm[r] = 0.f;
    f32x16 o[4];
#pragma unroll
    for (int d = 0; d < 4; ++d)
#pragma unroll
        for (int r = 0; r < 16; ++r) o[d][r] = 0.f;
    const ATT_LAS unsigned char* kn0 = shm + KN_OFF; const ATT_LAS unsigned char* kr0 = shm + KR_OFF;
    const int vb0 = (int)(lds0 + V_OFF) + v_rd_base(lane);
    int s_cur = 0, s_n2 = 2, v_cur = 0, v_n2 = 2;
    ATT_WAIT_BAR(0);
    if (wid >= 4) asm volatile("s_barrier" ::: "memory");
    for (int j = 0; j < NT; ++j) {
        if (j + 2 < NT) ATT_ISSUE(j + 2, s_n2, v_n2);
        ATT_SBAR();
        f32x16 p0, p1;
        { const ATT_LAS unsigned char* kb = kn0 + s_cur * KN_SLOT; const ATT_LAS unsigned char* rb = kr0 + s_cur * KR_SLOT;
#define ATT_KF(d0_, half_) ((d0_) < 8 ? *(const ATT_LAS bf16x8*)(kb + kn_byte((half_) * 32 + r32, (d0_) * 2 + hi)) : *(const ATT_LAS bf16x8*)(rb + kr_byte((half_) * 32 + r32, ((d0_) - 8) * 2 + hi)))
          bf16x8 fa[NQ + 2], fb[NQ + 2];
          fa[0] = ATT_KF(0, 0); fb[0] = ATT_KF(0, 1); fa[1] = ATT_KF(1, 0); fb[1] = ATT_KF(1, 1);
#pragma unroll
          for (int d0 = 0; d0 < NQ; ++d0) {
              if (d0 + 2 < NQ) { fa[d0 + 2] = ATT_KF(d0 + 2, 0); fb[d0 + 2] = ATT_KF(d0 + 2, 1); }
              ATT_SBAR();
              if (d0 == 0) { p0 = __builtin_amdgcn_mfma_f32_32x32x16_bf16(fa[0], qr[0], negm, 0, 0, 0); p1 = __builtin_amdgcn_mfma_f32_32x32x16_bf16(fb[0], qr[0], negm, 0, 0, 0); }
              else { p0 = __builtin_amdgcn_mfma_f32_32x32x16_bf16(fa[d0], qr[d0], p0, 0, 0, 0); p1 = __builtin_amdgcn_mfma_f32_32x32x16_bf16(fb[d0], qr[d0], p1, 0, 0, 0); }
              ATT_SBAR();
          }
#undef ATT_KF
        }
        ATT_SBAR();
        if (j + 2 < NT) { ATT_WAIT_BAR(PIECES); } else { ATT_WAIT_BAR(0); }
        ATT_SBAR();
        if constexpr (SWA) {
            const ATT_LAS float* btb = bt + (qk_rel0 + j * 64 - r32 + BT_ZERO + 4 * hi);
#pragma unroll
            for (int r = 0; r < 16; ++r) { const int cr = (r & 3) + 8 * (r >> 2);
                p0[r] = fmaf(p0[r], C, btb[cr]); p1[r] = fmaf(p1[r], C, btb[cr + 32]); }
            float pmax = p0[0];
#pragma unroll
            for (int r = 1; r < 16; ++r) pmax = fmaxf(pmax, p0[r]);
#pragma unroll
            for (int r = 0; r < 16; ++r) pmax = fmaxf(pmax, p1[r]);
            { auto rr = __builtin_amdgcn_permlane32_swap(__float_as_uint(pmax), __float_as_uint(pmax), false, false); pmax = fmaxf(__uint_as_float(rr[0]), __uint_as_float(rr[1])); }
            const float mn = fmaxf(m_reg, pmax), alpha = __builtin_amdgcn_exp2f(m_reg - mn); m_reg = mn;
            float ps = 0.f;
#pragma unroll
            for (int r = 0; r < 16; ++r) { p0[r] = __builtin_amdgcn_exp2f(p0[r] - mn); p1[r] = __builtin_amdgcn_exp2f(p1[r] - mn); ps += p0[r] + p1[r]; }
            { auto rr = __builtin_amdgcn_permlane32_swap(__float_as_uint(ps), __float_as_uint(ps), false, false); ps = __uint_as_float(rr[0]) + __uint_as_float(rr[1]); }
            l_reg = l_reg * alpha + ps;
            if (__any(alpha < 1.f)) { if (hi == 0) wsf[r32] = alpha; asm volatile("s_waitcnt lgkmcnt(0)" ::: "memory");
#pragma unroll
                for (int r = 0; r < 16; ++r) { const float a = wsf[crow(r, hi)];
#pragma unroll
                    for (int d = 0; d < 4; ++d) o[d][r] *= a; }
                asm volatile("s_waitcnt lgkmcnt(0)" ::: "memory"); }
        } else {
#define ATT_MX3(a, b, c) __builtin_fmaxf(__builtin_fmaxf((a), (b)), (c))
            float ma = ATT_MX3(p0[0], p0[1], p1[0]), mb = ATT_MX3(p0[2], p0[3], p1[1]); ma = ATT_MX3(ma, p1[2], p1[3]);
#pragma unroll
            for (int r = 4; r < 16; r += 4) { ma = ATT_MX3(ma, p0[r], p0[r + 1]); mb = ATT_MX3(mb, p0[r + 2], p0[r + 3]); ma = ATT_MX3(ma, p1[r], p1[r + 1]); mb = ATT_MX3(mb, p1[r + 2], p1[r + 3]); }
#undef ATT_MX3
            float pmax = __builtin_fmaxf(ma, mb);
            { auto rr = __builtin_amdgcn_permlane32_swap(__float_as_uint(pmax), __float_as_uint(pmax), false, false); pmax = __builtin_fmaxf(__uint_as_float(rr[0]), __uint_as_float(rr[1])); }
            if (j == 0 || __any(pmax > THR)) {
                const float dl = (j == 0) ? pmax : __builtin_fmaxf(pmax, 0.f); m_reg += dl;
#pragma unroll
                for (int r = 0; r < 16; ++r) { p0[r] -= dl; p1[r] -= dl; negm[r] = -m_reg; }
                const float f = __builtin_amdgcn_exp2f(-dl); l_reg *= f;
                if (j != 0) { if (hi == 0) wsf[r32] = f; asm volatile("s_waitcnt lgkmcnt(0)" ::: "memory");
#pragma unroll
                    for (int r = 0; r < 16; ++r) { const float a = wsf[crow(r, hi)];
#pragma unroll
                        for (int d = 0; d < 4; ++d) o[d][r] *= a; }
                    asm volatile("s_waitcnt lgkmcnt(0)" ::: "memory"); }
            }
            float ps0 = 0.f, ps1 = 0.f;
#pragma unroll
            for (int r = 0; r < 16; ++r) { p0[r] = __builtin_amdgcn_exp2f(p0[r]); p1[r] = __builtin_amdgcn_exp2f(p1[r]); ps0 += p0[r]; ps1 += p1[r]; }
            float ps = ps0 + ps1;
            { auto rr = __builtin_amdgcn_permlane32_swap(__float_as_uint(ps), __float_as_uint(ps), false, false); ps = __uint_as_float(rr[0]) + __uint_as_float(rr[1]); }
            l_reg += ps;
        }
        bf16x8 pa0, pa1, pa2, pa3;
#define ATT_PK4(P, BASE, OUT) do { unsigned a0 = cvtpk(P[BASE + 0], P[BASE + 1]), a1 = cvtpk(P[BASE + 2], P[BASE + 3]);   \
        unsigned b0_ = cvtpk(P[BASE + 4], P[BASE + 5]), b1_ = cvtpk(P[BASE + 6], P[BASE + 7]);                              \
        auto r0 = __builtin_amdgcn_permlane32_swap(a0, b0_, false, false); auto r1 = __builtin_amdgcn_permlane32_swap(a1, b1_, false, false); \
        u32x4 w = {r0[0], r1[0], r0[1], r1[1]}; OUT = __builtin_bit_cast(bf16x8, w); } while (0)
        ATT_PK4(p0, 0, pa0); ATT_PK4(p0, 8, pa1); ATT_PK4(p1, 0, pa2); ATT_PK4(p1, 8, pa3);
#undef ATT_PK4
        ATT_SBAR();
        { const int vb = vb0 + v_cur * V_SLOT;
          pv_all(o, vb, pa0, pa1, pa2, pa3); }
        ATT_SBAR();
        asm volatile("s_waitcnt lgkmcnt(0)\n\ts_barrier" ::: "memory");
        ATT_SBAR();
        s_cur = (s_cur == 2) ? 0 : s_cur + 1; s_n2 = (s_n2 == 2) ? 0 : s_n2 + 1; v_cur = (v_cur + 1) & 3; v_n2 = (v_n2 + 1) & 3;
    }
    if (wid < 4) asm volatile("s_barrier" ::: "memory");
    if (hi == 0) wsf[32 + r32] = l_reg; asm volatile("s_waitcnt lgkmcnt(0)" ::: "memory");
#pragma unroll
    for (int r = 0; r < 16; ++r) { const int orow = crow(r, hi); const float rl = __builtin_amdgcn_rcpf(wsf[32 + orow]);
#pragma unroll
        for (int d = 0; d < 4; ++d) { const unsigned w = cvtpk(o[d][r] * rl, 0.f); Ow[(size_t)orow * ldo + d * 32 + r32] = (bf16_t)(w & 0xffffu); } }
    asm volatile("s_waitcnt lgkmcnt(0)" ::: "memory");
#undef ATT_ISSUE
}

__host__ __device__ __forceinline__ int v16_byte(int key, int col) { return (((key >> 3) * 8 + (col >> 4)) << 8) + (key & 7) * 32 + (col & 15) * 2; }
__host__ __device__ __forceinline__ void v16_inv(int b, int& key, int& col) { const int s = b >> 8, w = b & 255; key = (s >> 3) * 8 + (w >> 5); col = (s & 7) * 16 + ((w & 31) >> 1); }
__host__ __device__ __forceinline__ int v16_rd_base(int lane) { const int g = lane >> 4, q = (lane & 15) >> 2, p = lane & 3; return (g >> 1) * 2048 + (4 * (g & 1) + q) * 32 + 8 * p; }
__host__ __device__ constexpr int v16_rd_off(int t, int h, int dg) { return (4 * t + 2 * h) * 2048 + dg * 256; }
typedef float f32x4a __attribute__((ext_vector_type(4)));
__device__ __forceinline__ float xmax16(float v) { auto r = __builtin_amdgcn_permlane16_swap(__float_as_uint(v), __float_as_uint(v), false, false); return __builtin_fmaxf(__uint_as_float(r[0]), __uint_as_float(r[1])); }
__device__ __forceinline__ float xmax32(float v) { auto r = __builtin_amdgcn_permlane32_swap(__float_as_uint(v), __float_as_uint(v), false, false); return __builtin_fmaxf(__uint_as_float(r[0]), __uint_as_float(r[1])); }
__device__ __forceinline__ float xsum16(float v) { auto r = __builtin_amdgcn_permlane16_swap(__float_as_uint(v), __float_as_uint(v), false, false); return __uint_as_float(r[0]) + __uint_as_float(r[1]); }
__device__ __forceinline__ float xsum32(float v) { auto r = __builtin_amdgcn_permlane32_swap(__float_as_uint(v), __float_as_uint(v), false, false); return __uint_as_float(r[0]) + __uint_as_float(r[1]); }
template <int OFF> __device__ __forceinline__ s16x4 tr_read16(int vb) { s16x4 r; asm volatile("ds_read_b64_tr_b16 %0, %1 offset:%2" : "=&v"(r) : "v"(vb), "i"(OFF) : "memory"); return r; }

template <int T> __device__ __forceinline__ void pv_half16(f32x4a (&o)[2][8], f32x4a (&ol)[2], bf16x8 onesb, int vb, bf16x8 p0, bf16x8 p1) {
#define ATT_VRD(dg_, lo_, hi_) do { lo_ = tr_read16<v16_rd_off(T, 0, (dg_))>(vb); hi_ = tr_read16<v16_rd_off(T, 1, (dg_))>(vb); } while (0)
#define ATT_PV(dg_, lo_, hi_) do { const bf16x8 b__ = (bf16x8){lo_[0], lo_[1], lo_[2], lo_[3], hi_[0], hi_[1], hi_[2], hi_[3]}; \
        o[0][dg_] = __builtin_amdgcn_mfma_f32_16x16x32_bf16(p0, b__, o[0][dg_], 0, 0, 0); o[1][dg_] = __builtin_amdgcn_mfma_f32_16x16x32_bf16(p1, b__, o[1][dg_], 0, 0, 0); } while (0)
    s16x4 l0, h0, l1, h1, l2, h2, l3, h3;
    ATT_VRD(0, l0, h0); ATT_VRD(1, l1, h1); ATT_VRD(2, l2, h2); ATT_VRD(3, l3, h3);
    asm volatile("s_waitcnt lgkmcnt(6)" ::: "memory"); ATT_SBAR(); ATT_PV(0, l0, h0); ATT_SBAR(); ATT_VRD(4, l0, h0);
    asm volatile("s_waitcnt lgkmcnt(6)" ::: "memory"); ATT_SBAR(); ATT_PV(1, l1, h1); ATT_SBAR(); ATT_VRD(5, l1, h1);
    asm volatile("s_waitcnt lgkmcnt(6)" ::: "memory"); ATT_SBAR(); ATT_PV(2, l2, h2); ATT_SBAR(); ATT_VRD(6, l2, h2);
    asm volatile("s_waitcnt lgkmcnt(6)" ::: "memory"); ATT_SBAR(); ATT_PV(3, l3, h3); ATT_SBAR(); ATT_VRD(7, l3, h3);
    asm volatile("s_waitcnt lgkmcnt(6)" ::: "memory"); ATT_SBAR(); ATT_PV(4, l0, h0); ATT_SBAR();
    asm volatile("s_waitcnt lgkmcnt(4)" ::: "memory"); ATT_SBAR(); ATT_PV(5, l1, h1); ATT_SBAR();
    asm volatile("s_waitcnt lgkmcnt(2)" ::: "memory"); ATT_SBAR(); ATT_PV(6, l2, h2); ATT_SBAR();
    asm volatile("s_waitcnt lgkmcnt(0)" ::: "memory"); ATT_SBAR(); ATT_PV(7, l3, h3);
    ol[0] = __builtin_amdgcn_mfma_f32_16x16x32_bf16(p0, onesb, ol[0], 0, 0, 0); ol[1] = __builtin_amdgcn_mfma_f32_16x16x32_bf16(p1, onesb, ol[1], 0, 0, 0);
    ATT_SBAR();
#undef ATT_PV
#undef ATT_VRD
}
__device__ __forceinline__ float att_max3(float a, float b, float c) { float r; asm("v_max3_f32 %0, %1, %2, %3" : "=v"(r) : "v"(a), "v"(b), "v"(c)); return r; }
__device__ __forceinline__ float att_max2(float a, float b) { float r; asm("v_max_f32_e32 %0, %1, %2" : "=v"(r) : "v"(a), "v"(b)); return r; }
__device__ __forceinline__ void attn_mla16(const bf16_t* __restrict__ Qw, int ldq, const bf16_t* __restrict__ Kn, const bf16_t* __restrict__ Kr, const bf16_t* __restrict__ Vg, int ldk,
                                           bf16_t* __restrict__ Ow, int ldo, int NT, ATT_LAS unsigned char* shm) {
    constexpr int PIECES = 5;
    int tid_ = threadIdx.x; asm volatile("" : "+v"(tid_));
    const int tid = tid_, lane = tid & 63, qi = lane & 15, g = lane >> 4; const int wid = __builtin_amdgcn_readfirstlane(tid >> 6);
    const unsigned lds0 = (unsigned)(size_t)shm;
    ATT_LAS float* wsf = (ATT_LAS float*)(shm + WSC_OFF) + wid * 64;
    unsigned ok0, ok1, orr, ov0, ov1;
    { int R, c; kn_inv(wid * 1024 + lane * 16, R, c); ok0 = (unsigned)(R * ldk + c * 8) * 2u; kn_inv((wid + 8) * 1024 + lane * 16, R, c); ok1 = (unsigned)(R * ldk + c * 8) * 2u;
      kr_inv(wid * 1024 + lane * 16, R, c); orr = (unsigned)(R * 64 + c * 8) * 2u;
      int k, col; v16_inv(wid * 1024 + lane * 16, k, col); ov0 = (unsigned)(k * ldk + col) * 2u; v16_inv((wid + 8) * 1024 + lane * 16, k, col); ov1 = (unsigned)(k * ldk + col) * 2u; }
    const unsigned tstepB = 128u * (unsigned)ldk;
    const char* kp = (const char*)Kn; const char* rp = (const char*)Kr; const char* vp = (const char*)Vg;
    const unsigned dk0 = lds0 + KN_OFF + wid * 1024, dr = lds0 + KR_OFF + wid * 1024, dv0 = lds0 + V_OFF + wid * 1024;
#define ATT_ISSUE16(s, sv) do { const unsigned s_ = (unsigned)(s), sv_ = (unsigned)(sv); \
        glds16x5(ok0, ok1, orr, ov0, ov1, kp, rp, vp, (unsigned)__builtin_amdgcn_readfirstlane(dk0 + s_ * KN_SLOT), (unsigned)__builtin_amdgcn_readfirstlane(dr + s_ * KR_SLOT), (unsigned)__builtin_amdgcn_readfirstlane(dv0 + sv_ * V_SLOT)); \
        kp += tstepB; rp += 64 * 64 * 2; vp += tstepB; } while (0)
    const bool lead = wid < 4;
    ATT_ISSUE16(0, 0); if (NT > 1) ATT_ISSUE16(1, 1); if (!lead && NT > 2) ATT_ISSUE16(2, 2);
    bf16x8 qf[2][6];
#pragma unroll
    for (int qg = 0; qg < 2; ++qg)
#pragma unroll
        for (int s = 0; s < 6; ++s) qf[qg][s] = *(const bf16x8*)(Qw + (size_t)(16 * qg + qi) * ldq + 32 * s + 8 * g);
#pragma unroll
    for (int qg = 0; qg < 2; ++qg)
#pragma unroll
        for (int s = 0; s < 6; ++s) asm volatile("" : "+v"(qf[qg][s]));
    constexpr float THR = 8.f;
    float m_reg[2] = {0.f, 0.f};
    f32x4a ol[2]; ol[0] = (f32x4a){0.f, 0.f, 0.f, 0.f}; ol[1] = ol[0];
    const short one_ = qi == 0 ? (short)0x3F80 : (short)0; const bf16x8 onesb = (bf16x8){one_, one_, one_, one_, one_, one_, one_, one_};
    f32x4a negm[2]; negm[0] = (f32x4a){0.f, 0.f, 0.f, 0.f}; negm[1] = negm[0]; asm volatile("" : "+v"(negm[0]), "+v"(negm[1]));
    f32x4a o[2][8];
#pragma unroll
    for (int qg = 0; qg < 2; ++qg)
#pragma unroll
        for (int dg = 0; dg < 8; ++dg) o[qg][dg] = (f32x4a){0.f, 0.f, 0.f, 0.f};
    const ATT_LAS unsigned char* kn0 = shm + KN_OFF; const ATT_LAS unsigned char* kr0 = shm + KR_OFF;
    const int vb0 = (int)(lds0 + V_OFF) + v16_rd_base(lane);
    int v_cur = 0, v_n2 = 2;
    bf16x8 pq1[2]; pq1[0] = (bf16x8){0, 0, 0, 0, 0, 0, 0, 0}; pq1[1] = pq1[0];
    ATT_WAIT_BAR(0);
    if (wid >= 4) asm volatile("s_barrier" ::: "memory");
    auto tile = [&](auto ks_, const int j) __attribute__((always_inline)) {
        constexpr int KS = decltype(ks_)::value;
        ATT_SBAR();
        if (j > 0) pv_half16<1>(o, ol, onesb, vb0 + ((v_cur + 3) & 3) * V_SLOT, pq1[0], pq1[1]);
        ATT_SBAR();
        f32x4a c[4][2];
        { const ATT_LAS unsigned char* kb = kn0 + KS * KN_SLOT; const ATT_LAS unsigned char* rb = kr0 + KS * KR_SLOT;
#define ATT_KF16(i_) (((i_) >> 2) < 4 ? *(const ATT_LAS bf16x8*)(kb + kn_byte(16 * ((i_) & 3) + qi, 4 * ((i_) >> 2) + g)) : *(const ATT_LAS bf16x8*)(rb + kr_byte(16 * ((i_) & 3) + qi, 4 * (((i_) >> 2) - 4) + g)))
          bf16x8 kf[24 + 4];
          kf[0] = ATT_KF16(0); kf[1] = ATT_KF16(1); kf[2] = ATT_KF16(2); kf[3] = ATT_KF16(3);
#pragma unroll
          for (int i = 0; i < 24; ++i) { const int s = i >> 2, kg = i & 3;
              if (i + 4 < 24) kf[i + 4] = ATT_KF16(i + 4);
              ATT_SBAR();
              if (s == 0) { c[kg][0] = __builtin_amdgcn_mfma_f32_16x16x32_bf16(kf[i], qf[0][0], negm[0], 0, 0, 0); c[kg][1] = __builtin_amdgcn_mfma_f32_16x16x32_bf16(kf[i], qf[1][0], negm[1], 0, 0, 0); }
              else { c[kg][0] = __builtin_amdgcn_mfma_f32_16x16x32_bf16(kf[i], qf[0][s], c[kg][0], 0, 0, 0); c[kg][1] = __builtin_amdgcn_mfma_f32_16x16x32_bf16(kf[i], qf[1][s], c[kg][1], 0, 0, 0); }
              ATT_SBAR();
          }
#undef ATT_KF16
        }
        ATT_SBAR();
        if (lead) asm volatile("s_waitcnt lgkmcnt(0)\n\ts_barrier" ::: "memory"); else if (j + 2 < NT) { ATT_WAIT_BAR(PIECES); } else { ATT_WAIT_BAR(0); }
        ATT_SBAR();
        if (lead) { if (j + 2 < NT) ATT_ISSUE16((KS + 2) % 3, v_n2); } else { if (j + 3 < NT) ATT_ISSUE16(KS, (v_cur + 3) & 3); }
        ATT_SBAR();
        asm volatile("s_nop 7\n\ts_nop 7" ::: "memory");
        float mx[2], mxx;
        { float a_, b_;
          asm volatile("v_max3_f32 %0, %2, %3, %4\n\tv_max3_f32 %1, %5, %6, %7\n\tv_max3_f32 %0, %0, %8, %9\n\tv_max3_f32 %1, %1, %10, %11\n\tv_max3_f32 %0, %0, %12, %13\n\tv_max3_f32 %1, %1, %14, %15\n\t"
                       "v_max3_f32 %0, %0, %16, %17\n\tv_max_f32_e32 %0, %0, %1"
                       : "=&v"(a_), "=&v"(b_)
                       : "v"(c[0][0][0]), "v"(c[0][0][1]), "v"(c[0][0][2]), "v"(c[0][0][3]), "v"(c[1][0][0]), "v"(c[1][0][1]), "v"(c[1][0][2]), "v"(c[1][0][3]),
                         "v"(c[2][0][0]), "v"(c[2][0][1]), "v"(c[2][0][2]), "v"(c[2][0][3]), "v"(c[3][0][0]), "v"(c[3][0][1]), "v"(c[3][0][2]), "v"(c[3][0][3]));
          mx[0] = a_; }
        { float a_, b_, m_;
          asm volatile("v_max3_f32 %0, %3, %4, %5\n\tv_max3_f32 %1, %6, %7, %8\n\tv_max3_f32 %0, %0, %9, %10\n\tv_max3_f32 %1, %1, %11, %12\n\tv_max3_f32 %0, %0, %13, %14\n\tv_max3_f32 %1, %1, %15, %16\n\t"
                       "v_max3_f32 %0, %0, %17, %18\n\tv_max_f32_e32 %0, %0, %1\n\tv_max_f32_e32 %2, %0, %19"
                       : "=&v"(a_), "=&v"(b_), "=&v"(m_)
                       : "v"(c[0][1][0]), "v"(c[0][1][1]), "v"(c[0][1][2]), "v"(c[0][1][3]), "v"(c[1][1][0]), "v"(c[1][1][1]), "v"(c[1][1][2]), "v"(c[1][1][3]),
                         "v"(c[2][1][0]), "v"(c[2][1][1]), "v"(c[2][1][2]), "v"(c[2][1][3]), "v"(c[3][1][0]), "v"(c[3][1][1]), "v"(c[3][1][2]), "v"(c[3][1][3]), "v"(mx[0]));
          mx[1] = a_; mxx = m_; }
        if (j == 0 || __any(mxx > THR)) {
#pragma unroll
            for (int qg = 0; qg < 2; ++qg) {
                const float rmx = xmax32(xmax16(mx[qg]));
                const float dl = (j == 0) ? rmx : __builtin_fmaxf(rmx, 0.f); m_reg[qg] += dl;
#pragma unroll
                for (int kg = 0; kg < 4; ++kg) c[kg][qg] = c[kg][qg] - dl;
                negm[qg] = (f32x4a){-m_reg[qg], -m_reg[qg], -m_reg[qg], -m_reg[qg]}; asm volatile("" : "+v"(negm[qg]));
                const float f = __builtin_amdgcn_exp2f(-dl);
                if (j != 0 && g == 0) wsf[16 * qg + qi] = f; }
            if (j != 0) { asm volatile("s_waitcnt lgkmcnt(0)" ::: "memory");
#pragma unroll
                for (int qg = 0; qg < 2; ++qg) { const f32x4a a = *(const ATT_LAS f32x4a*)(wsf + 16 * qg + 4 * g);
#pragma unroll
                    for (int dg = 0; dg < 8; ++dg) o[qg][dg] = o[qg][dg] * a;
                    ol[qg] = ol[qg] * a; }
                asm volatile("s_waitcnt lgkmcnt(0)" ::: "memory"); }
        }
        bf16x8 pa[2][2];
        { unsigned wq[16];
#define ATT_CREF(f_) c[((f_) >> 2) & 3][(f_) >> 4][(f_) & 3]
#define ATT_EX(f_) asm volatile("v_exp_f32_e32 %0, %0" : "+v"(ATT_CREF(f_)))
#define ATT_CV(k_) asm volatile("v_cvt_pk_bf16_f32 %0, %1, %2" : "=v"(wq[k_]) : "v"(ATT_CREF(2 * (k_))), "v"(ATT_CREF(2 * (k_) + 1)))
#define ATT_E8(b_) ATT_EX((b_)); ATT_EX((b_) + 1); ATT_EX((b_) + 2); ATT_EX((b_) + 3); ATT_EX((b_) + 4); ATT_EX((b_) + 5); ATT_EX((b_) + 6); ATT_EX((b_) + 7)
#define ATT_C8(b_) ATT_CV((b_)); ATT_CV((b_) + 1); ATT_CV((b_) + 2); ATT_CV((b_) + 3); ATT_CV((b_) + 4); ATT_CV((b_) + 5); ATT_CV((b_) + 6); ATT_CV((b_) + 7)
          ATT_E8(0); ATT_E8(8); ATT_C8(0); ATT_E8(16); ATT_E8(24); ATT_C8(8);
#undef ATT_C8
#undef ATT_E8
#define ATT_STEP(k_) (void)0
#undef ATT_STEP
#undef ATT_CV
#undef ATT_EX
#undef ATT_CREF
#pragma unroll
          for (int qg = 0; qg < 2; ++qg)
#pragma unroll
              for (int t = 0; t < 2; ++t) { u32x4 w = {wq[8 * qg + 4 * t], wq[8 * qg + 4 * t + 1], wq[8 * qg + 4 * t + 2], wq[8 * qg + 4 * t + 3]}; pa[qg][t] = __builtin_bit_cast(bf16x8, w); } }
        ATT_SBAR();
        pv_half16<0>(o, ol, onesb, vb0 + v_cur * V_SLOT, pa[0][0], pa[1][0]);
        pq1[0] = pa[0][1]; pq1[1] = pa[1][1];
        ATT_SBAR();
        if (!lead) asm volatile("s_waitcnt lgkmcnt(0)\n\ts_barrier" ::: "memory"); else if (j + 2 < NT) { ATT_WAIT_BAR(PIECES); } else { ATT_WAIT_BAR(0); }
        ATT_SBAR();
        v_cur = (v_cur + 1) & 3; v_n2 = (v_n2 + 1) & 3;
    };
    { int j = 0;
      for (; j + 3 <= NT; j += 3) { tile(std::integral_constant<int, 0>{}, j); tile(std::integral_constant<int, 1>{}, j + 1); tile(std::integral_constant<int, 2>{}, j + 2); }
      if (j < NT) { tile(std::integral_constant<int, 0>{}, j); ++j; if (j < NT) tile(std::integral_constant<int, 1>{}, j); } }
    if (wid < 4) asm volatile("s_barrier" ::: "memory");
    pv_half16<1>(o, ol, onesb, vb0 + ((v_cur + 3) & 3) * V_SLOT, pq1[0], pq1[1]);
    asm volatile("s_waitcnt lgkmcnt(0)\n\ts_barrier" ::: "memory");
    if (qi == 0) { *(ATT_LAS f32x4a*)(wsf + 32 + 4 * g) = ol[0]; *(ATT_LAS f32x4a*)(wsf + 48 + 4 * g) = ol[1]; }
    asm volatile("s_waitcnt lgkmcnt(0)" ::: "memory");
#pragma unroll
    for (int qg = 0; qg < 2; ++qg) { const f32x4a lv = *(const ATT_LAS f32x4a*)(wsf + 32 + 16 * qg + 4 * g);
#pragma unroll
        for (int r = 0; r < 4; ++r) { const float rl = __builtin_amdgcn_rcpf(lv[r]);
#pragma unroll
            for (int dg = 0; dg < 8; ++dg) { const unsigned w = cvtpk(o[qg][dg][r] * rl, 0.f); Ow[(size_t)(16 * qg + 4 * g + r) * ldo + 16 * dg + qi] = (bf16_t)(w & 0xffffu); } } }
    asm volatile("s_waitcnt lgkmcnt(0)" ::: "memory");
#undef ATT_ISSUE16
}
#undef ATT_WAIT_BAR
#undef ATT_SBAR
}
#define GAS __attribute__((address_space(1)))
#define LAS __attribute__((address_space(3)))
typedef unsigned short bf16;
typedef unsigned v4u __attribute__((ext_vector_type(4)));
typedef float f32x4 __attribute__((ext_vector_type(4)));
typedef short bf16x8 __attribute__((ext_vector_type(8)));
typedef GAS unsigned gu32;
typedef GAS unsigned long long gu64;
#define RLX_AGENT __ATOMIC_RELAXED, __HIP_MEMORY_SCOPE_AGENT
#define LDS_WAIT() asm volatile("s_waitcnt lgkmcnt(0)" ::: "memory")
#define VM_WAIT() asm volatile("s_waitcnt vmcnt(0)" ::: "memory")
__device__ __forceinline__ unsigned long long rt() { return __builtin_amdgcn_s_memrealtime(); }
__device__ __forceinline__ unsigned f2bf(float f) { unsigned u = __builtin_bit_cast(unsigned, f); return (u + 0x7fffu + ((u >> 16) & 1u)) >> 16; }
__device__ __forceinline__ unsigned pk2(float lo, float hi) { return f2bf(lo) | (f2bf(hi) << 16); }

#define XB_TMO      128
#define XB_XCNT(j)  (256  + 64 * (j))
#define XB_XSUB(j)  (1280 + 64 * (j))
#define XB_XGEN(j)  (2304 + 64 * (j))
#define XB_TOP      3328
#define XB_TOPGEN   3392
#define XCD_BAR_WORDS 3456
#define XB_SPIN_CAP (1u << 18)

__device__ __forceinline__ unsigned xb_ld(unsigned* p)              { return __hip_atomic_load(p, __ATOMIC_RELAXED, __HIP_MEMORY_SCOPE_AGENT); }
__device__ __forceinline__ unsigned xb_add(unsigned* p, unsigned v) { return __hip_atomic_fetch_add(p, v, __ATOMIC_RELAXED, __HIP_MEMORY_SCOPE_AGENT); }
__device__ __forceinline__ unsigned xb_xcc_id() { return (unsigned)__builtin_amdgcn_s_getreg((3 << 11) | 20) & 0xFu; }
#define XB_SPIN(cond, bar) do { unsigned _sp = 0; while (cond) { __builtin_amdgcn_s_sleep(1); \
    if ((++_sp & 255u) == 0u) { if (xb_ld(&(bar)[XB_TMO])) break; if (_sp > XB_SPIN_CAP) { atomicAdd(&(bar)[XB_TMO], 1u); break; } } } } while (0)

struct XcdBarrier {
    unsigned* bar; unsigned x;
    volatile LAS unsigned* st;
};

__device__ __forceinline__ XcdBarrier xcd_barrier_post(unsigned* bar, volatile LAS unsigned* st) {
    XcdBarrier b; b.bar = bar; b.x = xb_xcc_id(); b.st = st;
    if (threadIdx.x == 0) (void)xb_add(&bar[XB_XCNT(b.x)], 1u);
    return b;
}
__device__ __forceinline__ void xcd_barrier_complete(unsigned* bar, unsigned x, unsigned& nloc, unsigned& nx) {
    const unsigned G = gridDim.x * gridDim.y * gridDim.z;
    unsigned sum, cnt, mine, sp = 0u;
    for (;;) {
        sum = 0u; cnt = 0u; mine = 0u;
#pragma unroll
        for (unsigned j = 0; j < 16; ++j) { const unsigned c = xb_ld(&bar[XB_XCNT(j)]); sum += c; cnt += (c > 0u) ? 1u : 0u; mine = (j == x) ? c : mine; }
        if (sum == G) break;
        __builtin_amdgcn_s_sleep(1);
        if ((++sp & 255u) == 0u) { if (xb_ld(&bar[XB_TMO])) break; if (sp > XB_SPIN_CAP) { atomicAdd(&bar[XB_TMO], 1u); break; } }
    }
    nloc = mine > 0u ? mine : 1u; nx = cnt > 0u ? cnt : 1u;
}

__device__ __forceinline__ void xcd_barrier(const XcdBarrier& b) {
    asm volatile("s_waitcnt vmcnt(0)" ::: "memory");
    __syncthreads();
    if (threadIdx.x == 0) {
        unsigned* bar = b.bar;
        __builtin_amdgcn_s_waitcnt(0);
        unsigned nloc = b.st[0], nx = b.st[1];
        if (nloc == 0u) { xcd_barrier_complete(bar, b.x, nloc, nx); b.st[0] = nloc; b.st[1] = nx; }
        const unsigned old = xb_add(&bar[XB_XSUB(b.x)], 1u);
        const unsigned gen = old / nloc;
        if (old + 1u == (gen + 1u) * nloc) {
            __builtin_amdgcn_fence(__ATOMIC_RELEASE, "agent");
            asm volatile("s_waitcnt vmcnt(0)" ::: "memory");
            const unsigned og = xb_add(&bar[XB_TOP], 1u);
            const unsigned tg = og / nx;
            if (og + 1u == (tg + 1u) * nx) xb_add(&bar[XB_TOPGEN], 1u);
            else XB_SPIN(xb_ld(&bar[XB_TOPGEN]) == tg, bar);
            __builtin_amdgcn_fence(__ATOMIC_ACQUIRE, "agent");
            xb_add(&bar[XB_XGEN(b.x)], 1u);
            asm volatile("s_waitcnt vmcnt(0)" ::: "memory");
        } else {
            XB_SPIN(xb_ld(&bar[XB_XGEN(b.x)]) == gen, bar);
            __builtin_amdgcn_fence(__ATOMIC_ACQUIRE, "agent");
            asm volatile("s_waitcnt vmcnt(0)" ::: "memory");
        }
    }
    __syncthreads();
}

constexpr int NWAVES = 8;
constexpr int T = 24576, TP = 16384, DM = 2048, DFF = 8192, PLE = 256, DEPTH = 4;
constexpr int LATN = 1280;
constexpr float EPS = 1e-6f;
constexpr int MCH = 8192, NCH = 3;
constexpr size_t MiB = 1u << 20;
constexpr size_t WS_CTL = 0, CTL_ZERO_BYTES = 1 * MiB;
constexpr size_t WS_ROT = 1 * MiB;
constexpr size_t WS_BT = 5 * MiB;
constexpr size_t WS_STAT = 6 * MiB;
constexpr size_t SS_XIN = WS_STAT, SS_X2 = WS_STAT + 128 * 1024, SS_E = WS_STAT + 256 * 1024, PS_Q = WS_STAT + 1 * MiB, PS_KV = WS_STAT + 2 * MiB, PS_H = WS_STAT + 3 * MiB, PS_E = WS_STAT + 6 * MiB, PS_X = WS_STAT + 9 * MiB;
constexpr size_t WS_W = 18 * MiB;
constexpr size_t W_MLA = 20 * MiB, W_SWA = 20 * MiB, W_LAYER = 73 * MiB;
constexpr size_t WO_WD = 0, WO_WUQ = 5 * MiB, WO_WUKV = 8 * MiB, WO_WOM = 12 * MiB;
constexpr size_t WO_WQKV = 0, WO_WOS = 12 * MiB;
constexpr size_t WO_UP = 0, WO_DN = 32 * MiB, WO_PU = 64 * MiB, WO_G = 65 * MiB;
constexpr size_t WS_WMLA = WS_W, WS_WSWA = WS_WMLA + 2 * W_MLA, WS_WLAY = WS_WSWA + 2 * W_SWA, WS_WEND = WS_WLAY + 4 * W_LAYER;
constexpr size_t WS_PB = WS_WEND;
constexpr size_t WS_XB = WS_PB + 12 * MiB;
constexpr size_t WS_H = WS_XB + 96 * MiB;
constexpr size_t WS_CQ = WS_H, WS_CKV = WS_H + 24 * MiB;
constexpr size_t WS_R = WS_H + 96 * MiB;
constexpr size_t WS_E = WS_R, WS_HID = WS_R + 96 * MiB;
constexpr size_t WS_Q = WS_R, WS_KV = WS_R + 144 * MiB, WS_KR = WS_KV + 192 * MiB;
constexpr size_t WS_QKV = WS_R;
constexpr size_t WS_XB1_UNUSED = WS_R + 144 * MiB;
constexpr size_t WS_END = WS_KR + 3 * MiB;
static_assert(PS_X + (size_t)T * 32 * 4 <= WS_W && WS_HID + 128 * MiB <= WS_END && WS_END <= 1000 * MiB, "d_ws map");
constexpr int CW_BAR = 4096;
constexpr int RING_OFF = 0, RING_BYTES = 131072;
constexpr int LDSCTL_OFF = 143360, MISC_OFF = LDSCTL_OFF + 320;
constexpr int LDS_BYTES = 147456;
static_assert(MISC_OFF + 128 <= LDS_BYTES && att::ATT_LDS_BYTES <= LDSCTL_OFF && RING_BYTES <= LDSCTL_OFF, "LDS map");

__device__ __forceinline__ float wave_sum(float v) {
#pragma unroll
    for (int o = 1; o < 64; o <<= 1) v += __shfl_xor(v, o);
    return v;
}
__device__ __forceinline__ float sq4(f32x4 v) { return (v.x * v.x + v.y * v.y) + (v.z * v.z + v.w * v.w); }
typedef unsigned u32x2 __attribute__((ext_vector_type(2)));
typedef unsigned u32x4 __attribute__((ext_vector_type(4)));
__device__ __forceinline__ u32x2 pk4(f32x4 v) { u32x2 r; r.x = pg8::cvt_pk_bf16(v.x, v.y); r.y = pg8::cvt_pk_bf16(v.z, v.w); return r; }
__device__ __forceinline__ f32x4 unpk4(u32x2 w) { f32x4 e; e.x = __uint_as_float(w.x << 16); e.y = __uint_as_float(w.x & 0xffff0000u); e.z = __uint_as_float(w.y << 16); e.w = __uint_as_float(w.y & 0xffff0000u); return e; }

__device__ __forceinline__ int cmap(int mode, int n) {
    if (mode == 1) { if (n < 1024) return n; if (n >= 1088) return -1; const int r = n - 1024; return 1024 + (r >> 1) + 32 * (r & 1); }
    if (mode == 2) { const int h = n / 192, r = n % 192; if (r < 128) return n; const int q = r - 128; return h * 192 + 128 + (q >> 1) + 32 * (q & 1); }
    return n;
}
__device__ __forceinline__ void p0_transpose_item(const float* W, int K, int Nsrc, int Ndst, bf16* WT, int mode, const float* gain, LAS float* scr, int item, int lane) {
    const int nblk = Ndst / 32, kb = item / nblk, nb = item % nblk, k0 = 64 * kb, n0 = 32 * nb;
    const int sc = cmap(mode, n0 + (lane & 31));
#pragma unroll 8
    for (int i = 0; i < 32; ++i) { const int kk = 2 * i + (lane >> 5); scr[kk * 33 + (lane & 31)] = sc >= 0 ? W[(size_t)(k0 + kk) * Nsrc + sc] * (gain ? gain[k0 + kk] : 1.f) : 0.f; }
    LDS_WAIT(); asm volatile("" ::: "memory");
    const int c = lane & 7;
#pragma unroll
    for (int j = 0; j < 4; ++j) { const int n = (lane >> 3) + 8 * j; const LAS float* s = scr + (8 * c) * 33 + n;
        v4u o; o.x = pk2(s[0 * 33], s[1 * 33]); o.y = pk2(s[2 * 33], s[3 * 33]); o.z = pk2(s[4 * 33], s[5 * 33]); o.w = pk2(s[6 * 33], s[7 * 33]);
        *(GAS v4u*)(WT + (size_t)(n0 + n) * K + k0 + 8 * c) = o; }
    LDS_WAIT(); asm volatile("" ::: "memory");
}
__device__ __forceinline__ void p0_fast_item(const float* W, int K, int N, bf16* WT, const float* gain, LAS unsigned char* scr, int item, int lane) {
    const int nblk = N / 64, kb = item / nblk, nb = item % nblk, k0 = 64 * kb, n0 = 64 * nb, q = lane & 15, g = lane >> 4;
    f32x4 a[8], b[8];
    const float* src = W + (size_t)(k0 + 2 * g) * N + n0 + 4 * q;
#pragma unroll
    for (int i = 0; i < 8; ++i) { a[i] = *(const f32x4*)(src + (size_t)(8 * i) * N); b[i] = *(const f32x4*)(src + (size_t)(8 * i + 1) * N); }
    if (gain) {
#pragma unroll
        for (int i = 0; i < 8; ++i) { const float ga = gain[k0 + 8 * i + 2 * g], gb = gain[k0 + 8 * i + 2 * g + 1]; a[i] = a[i] * ga; b[i] = b[i] * gb; } }
#pragma unroll
    for (int i = 0; i < 8; ++i)
#pragma unroll
        for (int e = 0; e < 4; ++e) *(LAS unsigned*)(scr + (4 * q + e) * 128 + ((i ^ (q & 7)) << 4) + 4 * g) = pg8::cvt_pk_bf16(a[i][e], b[i][e]);
    LDS_WAIT(); asm volatile("" ::: "memory");
    const int c = lane & 7;
#pragma unroll
    for (int j = 0; j < 8; ++j) { const int n = (lane >> 3) + 8 * j; const v4u v = *(const LAS v4u*)(scr + n * 128 + ((c ^ ((n >> 2) & 7)) << 4));
        *(GAS v4u*)(WT + (size_t)(n0 + n) * K + k0 + 8 * c) = v; }
    LDS_WAIT(); asm volatile("" ::: "memory");
}

template <int R> __device__ __forceinline__ void thin_c_rows(int m0, int stride, int lane, const bf16* XB1, const float* g1, bf16* XB, const bf16* H,
                                                             const float* psh, float* ssx2, const float* pp, const float* psm, bf16* PB) {
    u32x4 hw[R][4], xw[R][4]; float ph[R]; f32x4 pv_[R];
#pragma unroll
    for (int rr = 0; rr < R; ++rr) { const int m = m0 + rr * stride; const bf16* hr = H + (size_t)m * DM; const bf16* xr = XB1 + (size_t)m * DM;
#pragma unroll
        for (int q = 0; q < 4; ++q) { hw[rr][q] = *(const u32x4*)(hr + 512 * q + 8 * lane); xw[rr][q] = *(const u32x4*)(xr + 512 * q + 8 * lane); }
        ph[rr] = lane < 32 ? psh[(size_t)m * 32 + lane] : 0.f;
        const float* pr = m < TP ? pp + (size_t)m * PLE : psm + (size_t)(m - TP) * PLE; pv_[rr] = *(const f32x4*)(pr + 4 * lane); }
#pragma unroll
    for (int rr = 0; rr < R; ++rr) { const int m = m0 + rr * stride;
        const float rh = __builtin_amdgcn_rsqf(wave_sum(ph[rr]) * (1.0f / DM) + EPS); float sx = 0.f;
        f32x4 v[4][2];
#pragma unroll
        for (int q = 0; q < 4; ++q) {
            v[q][0] = unpk4((u32x2){xw[rr][q].x, xw[rr][q].y}) + unpk4((u32x2){hw[rr][q].x, hw[rr][q].y}) * rh * *(const f32x4*)(g1 + 512 * q + 8 * lane);
            v[q][1] = unpk4((u32x2){xw[rr][q].z, xw[rr][q].w}) + unpk4((u32x2){hw[rr][q].z, hw[rr][q].w}) * rh * *(const f32x4*)(g1 + 512 * q + 8 * lane + 4);
            sx += sq4(v[q][0]) + sq4(v[q][1]); }
        sx = wave_sum(sx); if (lane == 0) ssx2[m] = sx;
        { const float rx = __builtin_amdgcn_rsqf(sx * (1.0f / DM) + EPS);
#pragma unroll
          for (int q = 0; q < 4; ++q) { const u32x2 lo = pk4(v[q][0] * rx), hi = pk4(v[q][1] * rx); *(u32x4*)(XB + (size_t)m * DM + 512 * q + 8 * lane) = (u32x4){lo.x, lo.y, hi.x, hi.y}; } }
        *(u32x2*)(PB + (size_t)m * PLE + 4 * lane) = pk4(pv_[rr]); }
}
template <int R> __device__ __forceinline__ void thin_d_rows(int m0, int stride, int lane, const float* g3, bf16* XB, const bf16* H, const float* psh, const float* pse, float* sse, const float* ssx2) {
    u32x4 xw[R][4], hw[R][4]; float ph[R], pe[R], sx2[R];
#pragma unroll
    for (int rr = 0; rr < R; ++rr) { const int m = m0 + rr * stride; const bf16* hr = H + (size_t)m * DM; const bf16* xr = XB + (size_t)m * DM;
#pragma unroll
        for (int q = 0; q < 4; ++q) { hw[rr][q] = *(const u32x4*)(hr + 512 * q + 8 * lane); xw[rr][q] = *(const u32x4*)(xr + 512 * q + 8 * lane); }
        ph[rr] = lane < 32 ? psh[(size_t)m * 32 + lane] : 0.f; pe[rr] = lane < 32 ? pse[(size_t)m * 32 + lane] : 0.f; sx2[rr] = ssx2[m]; }
#pragma unroll
    for (int rr = 0; rr < R; ++rr) { const int m = m0 + rr * stride; bf16* xr = XB + (size_t)m * DM;
        const float rh = __builtin_amdgcn_rsqf(wave_sum(ph[rr]) * (1.0f / DM) + EPS);
        { const float se = wave_sum(pe[rr]); if (lane == 0) sse[m] = se; }
        const float ux = __builtin_sqrtf(sx2[rr] * (1.0f / DM) + EPS);
#pragma unroll
        for (int q = 0; q < 4; ++q) {
            const u32x2 lo = pk4(unpk4((u32x2){xw[rr][q].x, xw[rr][q].y}) * ux + unpk4((u32x2){hw[rr][q].x, hw[rr][q].y}) * rh * *(const f32x4*)(g3 + 512 * q + 8 * lane));
            const u32x2 hi = pk4(unpk4((u32x2){xw[rr][q].z, xw[rr][q].w}) * ux + unpk4((u32x2){hw[rr][q].z, hw[rr][q].w}) * rh * *(const f32x4*)(g3 + 512 * q + 8 * lane + 4));
            *(u32x4*)(xr + 512 * q + 8 * lane) = (u32x4){lo.x, lo.y, hi.x, hi.y}; } }
}

struct Args { const float* in[20]; float* out; unsigned char* ws; };
#define ZERO() ({ int z__; asm volatile("s_mov_b32 %0, 0" : "=s"(z__)); z__; })
#define WSP(T_, off) ((T_*)(args.ws + (size_t)(off) + (size_t)ZERO()))
#define INP(k) (args.in[(k) + ZERO()])
__global__ void __launch_bounds__(NWAVES * 64, 2) trunk_fwd(Args args) {
    extern __shared__ __attribute__((aligned(16))) unsigned char lds_raw[];
    LAS unsigned char* lds = (LAS unsigned char*)lds_raw;
    volatile LAS unsigned* MISC = (volatile LAS unsigned*)(lds + MISC_OFF);
    const int tid = threadIdx.x, lane0 = tid & 63, wave = __builtin_amdgcn_readfirstlane(tid >> 6);
#define LANE_DECL() int lane = lane0; asm volatile("" : "+v"(lane)); int gwl = gw; asm volatile("" : "+s"(gwl))
    const int G = gridDim.x; const int bx = blockIdx.x; const int vcu = (G % 8 == 0) ? (bx % 8) * (G / 8) + bx / 8 : bx;
    for (int u = tid; u < (LDS_BYTES - LDSCTL_OFF) / 4; u += NWAVES * 64) ((LAS unsigned*)(lds + LDSCTL_OFF))[u] = 0u;
    __syncthreads();
    XcdBarrier bar = xcd_barrier_post((unsigned*)(args.ws + WS_CTL) + CW_BAR, MISC + 8);
#define GRID_BAR() xcd_barrier(bar)
    const int gw = vcu * NWAVES + wave, NGW = G * NWAVES;
    constexpr float QSCALE = 0.07216878364870322f * 1.4426950408889634f;

    {
        LANE_DECL(); LAS unsigned char* scr8 = lds + RING_OFF + wave * 16384; LAS float* scr = (LAS float*)scr8;
        unsigned char* ws = args.ws;
        int rot_ = 0;
#define CVT(Wsrc, K_, Nsrc_, Ndst_, dst_, mode_, gain_) do { const int nit_ = ((K_) / 64) * ((Ndst_) / 32); \
            for (int it_ = (gwl + NGW - rot_) % NGW; it_ < nit_; it_ += NGW) p0_transpose_item((Wsrc), (K_), (Nsrc_), (Ndst_), (dst_), (mode_), (gain_), scr, it_, lane); rot_ = (rot_ + nit_) % NGW; } while (0)
#define CVTF(Wsrc, K_, N_, dst_, gain_) do { const int nit_ = ((K_) / 64) * ((N_) / 64); \
            for (int it_ = (gwl + NGW - rot_) % NGW; it_ < nit_; it_ += NGW) p0_fast_item((Wsrc), (K_), (N_), (dst_), (gain_), scr8, it_, lane); rot_ = (rot_ + nit_) % NGW; } while (0)
        const float* gains = args.in[4];
        for (int j = 0; j < 2; ++j) {
            unsigned char* wm = ws + WS_WMLA + j * W_MLA; unsigned char* wsw = ws + WS_WSWA + j * W_SWA;
            CVT(args.in[5] + (size_t)j * DM * 1088, DM, 1088, LATN, (bf16*)(wm + WO_WD), 1, gains + (size_t)(2 * j * 4 + 0) * DM);
            CVT(args.in[8] + (size_t)j * 512 * 3072, 512, 3072, 3072, (bf16*)(wm + WO_WUQ), 2, args.in[6] + j * 512);
            CVTF(args.in[9] + (size_t)j * 512 * 4096, 512, 4096, (bf16*)(wm + WO_WUKV), args.in[7] + j * 512);
            CVTF(args.in[10] + (size_t)j * DM * DM, DM, DM, (bf16*)(wm + WO_WOM), (const float*)nullptr);
            CVTF(args.in[11] + (size_t)j * DM * 3072, DM, 3072, (bf16*)(wsw + WO_WQKV), gains + (size_t)((2 * j + 1) * 4 + 0) * DM);
            CVTF(args.in[13] + (size_t)j * DM * DM, DM, DM, (bf16*)(wsw + WO_WOS), (const float*)nullptr);
        }
        for (int L = 0; L < DEPTH; ++L) {
            unsigned char* wl = ws + WS_WLAY + L * W_LAYER;
            CVTF(args.in[15] + (size_t)L * DM * DFF, DM, DFF, (bf16*)(wl + WO_UP), gains + (size_t)(L * 4 + 2) * DM);
            CVTF(args.in[16] + (size_t)L * DFF * DM, DFF, DM, (bf16*)(wl + WO_DN), (const float*)nullptr);
            CVTF(args.in[17] + (size_t)L * PLE * DM, PLE, DM, (bf16*)(wl + WO_PU), (const float*)nullptr);
            CVTF(args.in[18] + (size_t)L * DM * DM, DM, DM, (bf16*)(wl + WO_G), (const float*)nullptr);
        }
#undef CVT
#undef CVTF
        float* rot = (float*)(ws + WS_ROT);
        for (int i = vcu * (NWAVES * 64) + tid; i < 16384 * 32; i += G * NWAVES * 64) {
            const int pos = i >> 5, d = i & 31; double inv = 1.0; for (int k = 0; k < d; ++k) inv *= 0.74989420933245582730;
            const double turns = (double)pos * inv * 0.15915494309189533577; const float fr = (float)(turns - __builtin_rint(turns));
            rot[2 * i] = __builtin_amdgcn_cosf(fr); rot[2 * i + 1] = __builtin_amdgcn_sinf(fr);
        }
        float* btg = (float*)(ws + WS_BT);
        for (int i = vcu * (NWAVES * 64) + tid; i < 16 * att::BT_STRIDE; i += G * NWAVES * 64) {
            const int h = i / att::BT_STRIDE, idx = i % att::BT_STRIDE, rel = idx - att::BT_ZERO, n = rel < 0 ? -rel : rel;
            int b = n < 8 ? n : 8 + (n >= 12) + (n >= 16) + (n >= 23) + (n >= 32) + (n >= 46) + (n >= 64) + (n >= 91); if (b > 15) b = 15; if (rel > 0) b += 16;
            btg[i] = n <= 128 ? args.in[14][b * 16 + h] * 1.4426950408889634f : -1e30f;
        }
    }
    { LANE_DECL(); const float* xin0 = INP(0); const float* xin1 = INP(1); bf16* XB = (bf16*)(args.out + ZERO()); float* ssx = WSP(float, SS_XIN);
      for (int m = gwl; m < T; m += NGW) {
        const float* xr = m < TP ? xin0 + (size_t)m * DM : xin1 + (size_t)(m - TP) * DM;
        f32x4 v[8]; float ss = 0.f;
#pragma unroll
        for (int q = 0; q < 8; ++q) { v[q] = *(const f32x4*)(xr + 256 * q + 4 * lane); ss += sq4(v[q]); }
        ss = wave_sum(ss);
#pragma unroll
        for (int q = 0; q < 8; ++q) *(u32x2*)(XB + (size_t)m * DM + 256 * q + 4 * lane) = pk4(v[q]);
        if (lane == 0) ssx[m] = ss;
      } }
    GRID_BAR();
    for (int L = 0; L < DEPTH; ++L) {
        const int j = L >> 1; const bool mla = (L & 1) == 0;
        if (mla) {
#ifndef DBG_NO_GEMM
            { pg8::Gemm g{(const bf16*)(args.out + ZERO()), WSP(bf16, WS_WMLA + j * W_MLA + WO_WD), T, LATN, DM}; pg8::StaticOrder S; S.init(T, LATN, G, bx + ZERO());
              pg8::EpiLat E{WSP(bf16, WS_CQ), WSP(bf16, WS_CKV), WSP(bf16, WS_KR), WSP(float, SS_XIN), WSP(float, PS_Q), WSP(float, PS_KV), WSP(float, WS_ROT)};
              pg8::gemm_phase<pg8::EpiLat, pg8::StaticOrder, true, true>(lds + RING_OFF, g, S, E);
            }
#endif
            GRID_BAR();
#ifndef DBG_NO_GEMM
            { pg8::Gemm g{WSP(bf16, WS_CQ), WSP(bf16, WS_WMLA + j * W_MLA + WO_WUQ), T, 3072, 512}; pg8::StaticOrder S; S.init(T, 3072, G, bx + ZERO()); pg8::EpiQRope E{WSP(bf16, WS_Q), 3072, WSP(float, WS_ROT), QSCALE, WSP(float, PS_Q)};
              pg8::gemm_phase<pg8::EpiQRope, pg8::StaticOrder, true, true>(lds + RING_OFF, g, S, E);
            }
            { pg8::Gemm g{WSP(bf16, WS_CKV), WSP(bf16, WS_WMLA + j * W_MLA + WO_WUKV), T, 4096, 512}; pg8::StaticOrder S; S.init(T, 4096, G, bx + ZERO());
              pg8::EpiBf16<0, 8, false> E{WSP(bf16, WS_KV), 4096, WSP(float, PS_KV), 1.0f / 512.0f, nullptr, 0};
              pg8::gemm_phase<pg8::EpiBf16<0, 8, false>, pg8::StaticOrder, true, true>(lds + RING_OFF, g, S, E);
            }
#endif
            GRID_BAR();
#ifndef DBG_NO_MLA
            { const bf16* QB = WSP(bf16, WS_Q); const bf16* KVB = WSP(bf16, WS_KV); const bf16* KRB = WSP(bf16, WS_KR); bf16* OB = WSP(bf16, WS_XB);
              for (int u = vcu; u < 1536; u += G) {
                int s0, S_, h, qb;
                if (u < 1024) { s0 = 0; S_ = TP; h = u >> 6; qb = u & 63; } else { const int v = u - 1024; s0 = TP + (v >> 8) * 4096; S_ = 4096; h = (v & 255) >> 4; qb = v & 15; }
                const int q0 = s0 + qb * 256 + wave * 32;
                att::attn_mla16(QB + (size_t)q0 * 3072 + h * 192, 3072, KVB + (size_t)s0 * 4096 + h * 256, KRB + (size_t)s0 * 64, KVB + (size_t)s0 * 4096 + h * 256 + 128, 4096,
                                OB + (size_t)q0 * DM + h * 128, DM, S_ / 64, lds + RING_OFF);
              } }
#endif
        } else {
#ifndef DBG_NO_GEMM
            { pg8::Gemm g{(const bf16*)(args.out + ZERO()), WSP(bf16, WS_WSWA + j * W_SWA + WO_WQKV), T, 3072, DM}; pg8::StaticOrder S; S.init(T, 3072, G, bx + ZERO());
              pg8::EpiBf16<0, 1, false> E{WSP(bf16, WS_QKV), 3072, WSP(float, SS_XIN), 1.0f / 2048.0f, nullptr, 0};
              pg8::gemm_phase<pg8::EpiBf16<0, 1, false>, pg8::StaticOrder, true, true>(lds + RING_OFF, g, S, E);
            }
#endif
            GRID_BAR();
#ifndef DBG_NO_SWA
            { LAS float* btl = (LAS float*)(lds + RING_OFF + att::BT_OFF); const float* btg = WSP(float, WS_BT);
              int tl = tid; asm volatile("" : "+v"(tl));
              for (int i = tl; i < 16 * att::BT_STRIDE; i += NWAVES * 64) btl[i] = btg[i];
              __syncthreads();
              const float* sink = INP(12) + j * 16; const bf16* QKV = WSP(bf16, WS_QKV); bf16* OB = WSP(bf16, WS_XB);
              for (int u = vcu; u < 1536; u += G) {
                  const int kvh = u / 384, rb = u % 384, q0 = rb * 64; int s0, S_;
                  if (q0 < TP) { s0 = 0; S_ = TP; } else { s0 = TP + ((q0 - TP) >> 12) * 4096; S_ = 4096; }
                  const int lo = max(q0 - 128, s0), hi_ = min(q0 + 192, s0 + S_), NT = (hi_ - lo) >> 6;
                  const int hq = kvh * 4 + (wave & 3), qw = q0 + 32 * (wave >> 2);
                  att::attn_unit<true>(QKV + (size_t)qw * 3072 + hq * 128, 3072, QKV + (size_t)lo * 3072 + 2048 + kvh * 128, nullptr, QKV + (size_t)lo * 3072 + 2560 + kvh * 128, 3072,
                                       OB + (size_t)qw * DM + hq * 128, DM, NT, lo - qw, 0.08838834764831845f * 1.4426950408889634f, sink[hq] * 1.4426950408889634f, lds + RING_OFF, btl + hq * att::BT_STRIDE);
              } }
#endif
        }
        GRID_BAR();
#ifndef DBG_NO_GEMM
        { const bf16* wo = mla ? WSP(bf16, WS_WMLA + j * W_MLA + WO_WOM) : WSP(bf16, WS_WSWA + j * W_SWA + WO_WOS);
          pg8::Gemm g{WSP(bf16, WS_XB), wo, T, DM, DM}; pg8::StaticOrder S; S.init(T, DM, G, bx + ZERO()); pg8::EpiBf16<0, 0, true> E{WSP(bf16, WS_H), DM, nullptr, 0.f, WSP(float, PS_H), 0};
          pg8::gemm_phase<pg8::EpiBf16<0, 0, true>, pg8::StaticOrder, true, true>(lds + RING_OFF, g, S, E);
        }
#endif
        GRID_BAR();
        { LANE_DECL(); const float* xin0 = INP(0); const float* xin1 = INP(1); const bf16* XB1 = (const bf16*)(args.out + ZERO()); const float* g1 = INP(4) + (size_t)(L * 4 + 1) * DM;
          bf16* XB = WSP(bf16, WS_XB); const bf16* H = WSP(bf16, WS_H); const float* psh = WSP(float, PS_H); float* ssx2 = WSP(float, SS_X2);
          const float* pp = INP(2) + (size_t)L * TP * PLE; const float* psm = INP(3) + (size_t)L * (T - TP) * PLE; bf16* PB = WSP(bf16, WS_PB);
          constexpr int RC = 2; int m0 = gwl;
          for (; m0 + (RC - 1) * NGW < T; m0 += RC * NGW) thin_c_rows<RC>(m0, NGW, lane, XB1, g1, XB, H, psh, ssx2, pp, psm, PB);
          for (; m0 < T; m0 += NGW) thin_c_rows<1>(m0, NGW, lane, XB1, g1, XB, H, psh, ssx2, pp, psm, PB);
        }
        GRID_BAR();
        for (int c = 0; c < NCH; ++c) {
#ifndef DBG_NO_GEMM
            { pg8::Gemm g{WSP(bf16, WS_XB) + (size_t)c * MCH * DM, WSP(bf16, WS_WLAY + L * W_LAYER + WO_UP), MCH, DFF, DM}; pg8::StaticOrder S; S.init(MCH, DFF, G, bx + ZERO());
              pg8::EpiBf16<1, 0, false> E{WSP(bf16, WS_HID), DFF, nullptr, 0.f, nullptr, c * MCH};
              pg8::gemm_phase<pg8::EpiBf16<1, 0, false>, pg8::StaticOrder, true, true>(lds + RING_OFF, g, S, E);
            }
#endif
            GRID_BAR();
#ifndef DBG_NO_GEMM
            { pg8::Gemm g{WSP(bf16, WS_HID), WSP(bf16, WS_WLAY + L * W_LAYER + WO_DN), MCH, DM, DFF}; pg8::StaticOrder S; S.init(MCH, DM, G, bx + ZERO());
              pg8::EpiBf16<0, 0, true> E{WSP(bf16, WS_H) + (size_t)c * MCH * DM, DM, nullptr, 0.f, WSP(float, PS_H), c * MCH};
              pg8::gemm_phase<pg8::EpiBf16<0, 0, true>, pg8::StaticOrder, true, true>(lds + RING_OFF, g, S, E);
            }
            if (c == 0) {
              pg8::Gemm g{WSP(bf16, WS_PB), WSP(bf16, WS_WLAY + L * W_LAYER + WO_PU), T, DM, PLE + ZERO()}; pg8::StaticOrder S; S.init(T, DM, G, bx + ZERO());
              pg8::EpiBf16<0, 0, true> E{WSP(bf16, WS_E), DM, nullptr, 0.f, WSP(float, PS_E), 0};
              pg8::gemm_phase<pg8::EpiBf16<0, 0, true>, pg8::StaticOrder, true, true>(lds + RING_OFF, g, S, E);
            }
#endif
            GRID_BAR();
        }
        { LANE_DECL(); const float* g3 = INP(4) + (size_t)(L * 4 + 3) * DM; bf16* XB = WSP(bf16, WS_XB); const bf16* H = WSP(bf16, WS_H); const float* psh = WSP(float, PS_H); const float* pse = WSP(float, PS_E); float* sse = WSP(float, SS_E); const float* ssx2 = WSP(float, SS_X2);
          constexpr int RD = 4; int m0 = gwl;
          for (; m0 + (RD - 1) * NGW < T; m0 += RD * NGW) thin_d_rows<RD>(m0, NGW, lane, g3, XB, H, psh, pse, sse, ssx2);
          for (; m0 < T; m0 += NGW) thin_d_rows<1>(m0, NGW, lane, g3, XB, H, psh, pse, sse, ssx2);
        }
        GRID_BAR();
#ifndef DBG_NO_GEMM
        { pg8::Gemm g{WSP(bf16, WS_XB), WSP(bf16, WS_WLAY + L * W_LAYER + WO_G), T, DM, DM}; pg8::StaticOrder S; S.init(T, DM, G, bx + ZERO());
          pg8::EpiGate E{WSP(bf16, WS_XB), WSP(bf16, WS_E), (L + 1 < DEPTH) ? (bf16*)(args.out + ZERO()) : (bf16*)nullptr, args.out + ZERO(), DM, WSP(float, SS_E), INP(19) + (size_t)L * DM, WSP(float, PS_X)};
          pg8::gemm_phase<pg8::EpiGate, pg8::StaticOrder, true, true>(lds + RING_OFF, g, S, E);
        }
#endif
        if (L + 1 < DEPTH) {
            GRID_BAR();
            { LANE_DECL(); const float* psx = WSP(float, PS_X); float* ssx = WSP(float, SS_XIN);
              for (int m = gwl; m < T; m += NGW) { const float s = wave_sum(lane < 32 ? psx[(size_t)m * 32 + lane] : 0.f); if (lane == 0) ssx[m] = s; } }
            GRID_BAR();
        }
    }
#undef GRID_BAR
}

extern "C" void kernel_launch(void* const* d_in, const int* in_sizes, int n_in, void* d_out, int out_size, void* d_ws, size_t ws_size, hipStream_t stream) {
    static int grid = 0;
    if (grid == 0) {
        if (n_in != 20 || out_size != T * DM || ws_size < WS_END) { fprintf(stderr, "kernel_launch: unexpected shapes: n_in %d out %d ws %zu (need %zu)\n", n_in, out_size, ws_size, (size_t)WS_END); grid = -1; return; }
        int dev = 0, cus = 0, per_cu = 0;
        if (hipGetDevice(&dev) != hipSuccess || hipDeviceGetAttribute(&cus, hipDeviceAttributeMultiprocessorCount, dev) != hipSuccess) { grid = -1; return; }
        if (hipFuncSetAttribute((const void*)trunk_fwd, hipFuncAttributeMaxDynamicSharedMemorySize, LDS_BYTES) != hipSuccess) { fprintf(stderr, "kernel_launch: hipFuncSetAttribute failed\n"); grid = -1; return; }
        if (hipOccupancyMaxActiveBlocksPerMultiprocessor(&per_cu, (const void*)trunk_fwd, NWAVES * 64, LDS_BYTES) != hipSuccess || per_cu < 1) fprintf(stderr, "kernel_launch: occupancy query reports %d\n", per_cu);
        (void)hipGetLastError();
        grid = cus;
    }
    if (grid < 0) return;
    if (hipMemsetAsync((char*)d_ws + WS_CTL, 0, CTL_ZERO_BYTES, stream) != hipSuccess) return;
    Args a{};
    for (int i = 0; i < 20; ++i) a.in[i] = (const float*)d_in[i];
    a.out = (float*)d_out; a.ws = (unsigned char*)d_ws;
    hipLaunchKernelGGL(trunk_fwd, dim3(grid), dim3(NWAVES * 64), LDS_BYTES, stream, a);
    const hipError_t le = hipPeekAtLastError();
    if (le != hipSuccess) fprintf(stderr, "kernel_launch: launch failed: %s\n", hipGetErrorName(le));
}
```

```cpp
#include <hip/hip_runtime.h>
#include <cstdio>
#include <cstdint>
namespace pg8 {
#define PG8_LAS __attribute__((address_space(3)))
typedef unsigned short bf16_t;
typedef short bf16x8 __attribute__((ext_vector_type(8)));
typedef float f32x4 __attribute__((ext_vector_type(4)));
typedef unsigned u32x4 __attribute__((ext_vector_type(4)));
constexpr int BM = 256, BK = 64, HALF = 128, HTB = HALF * BK * 2  , STAGE_BYTES = 8 * HTB, NXCD = 8, WGM = 8;

__host__ __device__ __forceinline__ int lds_byte(int r, int c) { const int st = (r >> 4) * 2 + (c >> 5), rr = r & 15, cc = c & 31, ob = rr * 64 + cc * 2; return st * 1024 + (ob ^ (((ob >> 9) & 1) << 5)); }
__host__ __device__ __forceinline__ void stage_rc(int b, int& R, int& C) { const int st = b / 1024, sb = b % 1024, swz = sb ^ (((sb >> 9) & 1) << 5); R = (st >> 1) * 16 + swz / 64; C = (st & 1) * 32 + (swz % 64) / 2; }
__host__ __device__ __forceinline__ int perm32(int rho) { const int n = rho >> 4, i = rho & 15; return 8 * (i >> 2) + 4 * n + (i & 3); }

struct Unit { int pm, pn; };
struct Gemm { const bf16_t* A; const bf16_t* Bt; int M, N, K; };

struct StaticOrder {
    int nM, nN, nwg, G, c;
    __host__ __device__ void init(int M, int N, int G_, int c_) { nM = M / BM; nN = N / BM; nwg = nM * nN; G = G_; c = c_; }
    __host__ __device__ bool next(int i, Unit& u) const {
        const long L = (long)i * G + c; if (L >= nwg) return false;
        int wgid = (int)L; { const int q = nwg / NXCD, r = nwg % NXCD, xcd = wgid % NXCD, off = wgid / NXCD; wgid = (xcd < r ? xcd * (q + 1) : r * (q + 1) + (xcd - r) * q) + off; }
        const int nig = WGM * nN; int gid, rem;
        if ((nig & (nig - 1)) == 0) { gid = wgid >> __builtin_ctz(nig); rem = wgid & (nig - 1); } else { gid = wgid / nig; rem = wgid % nig; }
        const int fm = gid * WGM, gsz = (nM - fm) < WGM ? (nM - fm) : WGM;
        static_assert((WGM & (WGM - 1)) == 0, "WGM must be a power of two");
        if (gsz == WGM) { u.pm = fm + (rem & (WGM - 1)); u.pn = rem / WGM; } else { u.pm = fm + (rem % gsz); u.pn = rem / gsz; }
        return true;
    }
    __device__ __forceinline__ void a_ready(const Unit&) const {}
    __device__ __forceinline__ void done(const Unit&) const {}
};

__device__ __forceinline__ unsigned cvt_pk_bf16(float lo, float hi) { unsigned r; asm volatile("v_cvt_pk_bf16_f32 %0, %1, %2" : "=v"(r) : "v"(lo), "v"(hi)); return r; }
typedef float f32x2 __attribute__((ext_vector_type(2)));

constexpr float RMS_EPS = 1e-6f;
template <int NP> __device__ __forceinline__ float row_rs(const float* ss, int row, float inv_d) {
    float s;
    if (NP == 1) s = ss[row];
    else { const f32x4 a = *(const f32x4*)(ss + (size_t)row * 8), b = *(const f32x4*)(ss + (size_t)row * 8 + 4); s = ((a[0] + a[1]) + (a[2] + a[3])) + ((b[0] + b[1]) + (b[2] + b[3])); }
    return __builtin_amdgcn_rsqf(s * inv_d + RMS_EPS);
}
__device__ __forceinline__ void stat_put(float* ps, int row, int ns, int slot, float part, int fq) {
    part += __shfl_xor(part, 16); part += __shfl_xor(part, 32);
    if (fq == 0) ps[(size_t)row * ns + slot] = part;
}
__device__ __forceinline__ float sq4v(f32x4 v) { return (v[0] * v[0] + v[1] * v[1]) + (v[2] * v[2] + v[3] * v[3]); }

template <int ACT  , int RS  , bool STAT  > struct EpiBf16 {
    static constexpr bool PERM = true, AFTER_DRAIN = false;
    bf16_t* O; int ldc; const float* ss_in; float inv_d; float* ss_out; int row_off;
    __device__ __forceinline__ void operator()(const f32x4 (&acc)[2][2][4][2], const Unit& u, int wr, int wc, int fr, int fq) const {
        const int row0 = u.pm * BM + wr * 64 + fr, col0 = u.pn * BM + wc * 32 + 8 * fq;
#pragma unroll
        for (int ai = 0; ai < 2; ++ai)
#pragma unroll
            for (int m = 0; m < 4; ++m) { const int row = row0 + ai * HALF + m * 16; bf16_t* rowp = O + (size_t)row * ldc + col0;
                float rs = 1.f; if (RS) { rs = row_rs<(RS ? RS : 1)>(ss_in, row_off + row, inv_d); if (ACT == 1) rs = rs * rs; }
                float part = 0.f;
#pragma unroll
                for (int bj = 0; bj < 2; ++bj) { f32x4 v0 = acc[ai][bj][m][0], v1 = acc[ai][bj][m][1];
                    if (ACT == 1) {
#pragma unroll
                        for (int e = 0; e < 4; ++e) { const float a = fmaxf(v0[e], 0.f), b = fmaxf(v1[e], 0.f); v0[e] = a * a; v1[e] = b * b; } }
                    if (RS) { v0 = v0 * rs; v1 = v1 * rs; }
                    if (STAT) part += sq4v(v0) + sq4v(v1);
                    u32x4 w; w.x = cvt_pk_bf16(v0[0], v0[1]); w.y = cvt_pk_bf16(v0[2], v0[3]); w.z = cvt_pk_bf16(v1[0], v1[1]); w.w = cvt_pk_bf16(v1[2], v1[3]);
                    *(u32x4*)(rowp + bj * HALF) = w; }
                if (STAT) stat_put(ss_out, row_off + row, 32, u.pn * 4 + wc, part, fq); }
    }
};
struct EpiLat {
    static constexpr bool PERM = true, AFTER_DRAIN = false;
    bf16_t* CQ; bf16_t* CKV; bf16_t* KR; const float* ss_in; float* ssq; float* sskv; const float* rot;
    __device__ __forceinline__ void operator()(const f32x4 (&acc)[2][2][4][2], const Unit& u, int wr, int wc, int fr, int fq) const {
        const int row0 = u.pm * BM + wr * 64 + fr, col0 = u.pn * BM + wc * 32 + 8 * fq;
        if (u.pn < 4) { float* ssd = u.pn < 2 ? ssq : sskv; bf16_t* C = (u.pn < 2 ? CQ : CKV) + (u.pn & 1) * BM + wc * 32 + 8 * fq;
#pragma unroll
            for (int ai = 0; ai < 2; ++ai)
#pragma unroll
                for (int m = 0; m < 4; ++m) { const int row = row0 + ai * HALF + m * 16; const float rs = row_rs<1>(ss_in, row, 1.0f / 2048.0f); float part = 0.f;
#pragma unroll
                    for (int bj = 0; bj < 2; ++bj) { const f32x4 v0 = acc[ai][bj][m][0] * rs, v1 = acc[ai][bj][m][1] * rs; part += sq4v(v0) + sq4v(v1);
                        u32x4 w; w.x = cvt_pk_bf16(v0[0], v0[1]); w.y = cvt_pk_bf16(v0[2], v0[3]); w.z = cvt_pk_bf16(v1[0], v1[1]); w.w = cvt_pk_bf16(v1[2], v1[3]);
                        *(u32x4*)(C + (size_t)row * 512 + bj * HALF) = w; }
                    stat_put(ssd, row, 8, (u.pn & 1) * 4 + wc, part, fq); }
        } else if (wc < 2) { const int d0 = 16 * wc + 4 * fq;
#pragma unroll
            for (int ai = 0; ai < 2; ++ai)
#pragma unroll
                for (int m = 0; m < 4; ++m) { const int row = row0 + ai * HALF + m * 16; const float rs = row_rs<1>(ss_in, row, 1.0f / 2048.0f); const int pos = row < 16384 ? row : ((row - 16384) & 4095);
                    const f32x4 v0 = acc[ai][0][m][0] * rs, v1 = acc[ai][0][m][1] * rs;
                    const f32x4 cs0 = *(const f32x4*)(rot + ((size_t)pos * 32 + d0) * 2), cs1 = *(const f32x4*)(rot + ((size_t)pos * 32 + d0 + 2) * 2);
                    u32x4 w; w.x = cvt_pk_bf16(v0[0] * cs0[0] - v0[1] * cs0[1], v0[1] * cs0[0] + v0[0] * cs0[1]); w.y = cvt_pk_bf16(v0[2] * cs0[2] - v0[3] * cs0[3], v0[3] * cs0[2] + v0[2] * cs0[3]);
                    w.z = cvt_pk_bf16(v1[0] * cs1[0] - v1[1] * cs1[1], v1[1] * cs1[0] + v1[0] * cs1[1]); w.w = cvt_pk_bf16(v1[2] * cs1[2] - v1[3] * cs1[3], v1[3] * cs1[2] + v1[2] * cs1[3]);
                    *(u32x4*)(KR + (size_t)row * 64 + 32 * wc + 8 * fq) = w; }
        }
    }
};
struct EpiQRope {
    static constexpr bool PERM = true, AFTER_DRAIN = false;
    bf16_t* O; int ldc; const float* rot; float scale; const float* ss_in;
    __device__ __forceinline__ void operator()(const f32x4 (&acc)[2][2][4][2], const Unit& u, int wr, int wc, int fr, int fq) const {
        const int row0 = u.pm * BM + wr * 64 + fr, col0 = u.pn * BM + wc * 32 + 8 * fq;
#pragma unroll
        for (int ai = 0; ai < 2; ++ai)
#pragma unroll
            for (int m = 0; m < 4; ++m) { const int row = row0 + ai * HALF + m * 16; const float rs = row_rs<8>(ss_in, row, 1.0f / 512.0f) * scale; const int pos = row < 16384 ? row : ((row - 16384) & 4095);
#pragma unroll
                for (int bj = 0; bj < 2; ++bj) {
                    const int sb = u.pn * BM + bj * HALF + wc * 32, hr = sb % 192; const bool rope = hr >= 128; const int d0 = ((hr - 128) >> 1) + 4 * fq;
                    f32x4 v0 = acc[ai][bj][m][0] * rs, v1 = acc[ai][bj][m][1] * rs;
                    if (rope) {
                        const f32x4 cs0 = *(const f32x4*)(rot + ((size_t)pos * 32 + d0) * 2), cs1 = *(const f32x4*)(rot + ((size_t)pos * 32 + d0 + 2) * 2);
                        f32x4 o0, o1;
                        o0[0] = v0[0] * cs0[0] - v0[1] * cs0[1]; o0[1] = v0[1] * cs0[0] + v0[0] * cs0[1];
                        o0[2] = v0[2] * cs0[2] - v0[3] * cs0[3]; o0[3] = v0[3] * cs0[2] + v0[2] * cs0[3];
                        o1[0] = v1[0] * cs1[0] - v1[1] * cs1[1]; o1[1] = v1[1] * cs1[0] + v1[0] * cs1[1];
                        o1[2] = v1[2] * cs1[2] - v1[3] * cs1[3]; o1[3] = v1[3] * cs1[2] + v1[2] * cs1[3];
                        v0 = o0; v1 = o1; }
                    u32x4 w; w.x = cvt_pk_bf16(v0[0], v0[1]); w.y = cvt_pk_bf16(v0[2], v0[3]); w.z = cvt_pk_bf16(v1[0], v1[1]); w.w = cvt_pk_bf16(v1[2], v1[3]);
                    *(u32x4*)(O + (size_t)row * ldc + col0 + bj * HALF) = w; } }
    }
};
struct EpiGate {
    static constexpr bool PERM = true, AFTER_DRAIN = false;
    const bf16_t* XBin; const bf16_t* E; bf16_t* XBout; float* OUT; int ldc; const float* sse; const float* pn; float* ss_out;
    __device__ __forceinline__ void operator()(const f32x4 (&acc)[2][2][4][2], const Unit& u, int wr, int wc, int fr, int fq) const {
        const int row0 = u.pm * BM + wr * 64 + fr, col0 = u.pn * BM + wc * 32 + 8 * fq;
        f32x4 g[2][2];
#pragma unroll
        for (int bj = 0; bj < 2; ++bj)
#pragma unroll
            for (int n = 0; n < 2; ++n) g[bj][n] = *(const f32x4*)(pn + col0 + bj * HALF + 4 * n);
#pragma unroll
        for (int am = 0; am < 4; ++am) { const int ai = am >> 1, m0 = (am & 1) * 2;
            u32x4 xw[4][2], ew[4][2]; float re[4];
#pragma unroll
            for (int m = m0; m < m0 + 2; ++m) { const int row = row0 + ai * HALF + m * 16; const size_t off = (size_t)row * ldc + col0; re[m] = sse[row];
#pragma unroll
                for (int bj = 0; bj < 2; ++bj) { xw[m][bj] = *(const u32x4*)(XBin + off + bj * HALF); ew[m][bj] = *(const u32x4*)(E + off + bj * HALF); } }
#pragma unroll
            for (int m = m0; m < m0 + 2; ++m) { const int row = row0 + ai * HALF + m * 16; const size_t off = (size_t)row * ldc + col0; const float rs = __builtin_amdgcn_rsqf(re[m] * (1.0f / 2048.0f) + RMS_EPS); float part = 0.f;
#pragma unroll
                for (int bj = 0; bj < 2; ++bj) { f32x4 r[2];
#pragma unroll
                    for (int n = 0; n < 2; ++n) { const unsigned x0 = n ? xw[m][bj].z : xw[m][bj].x, x1 = n ? xw[m][bj].w : xw[m][bj].y, e0 = n ? ew[m][bj].z : ew[m][bj].x, e1 = n ? ew[m][bj].w : ew[m][bj].y;
                        f32x4 x; x[0] = __uint_as_float(x0 << 16); x[1] = __uint_as_float(x0 & 0xffff0000u); x[2] = __uint_as_float(x1 << 16); x[3] = __uint_as_float(x1 & 0xffff0000u);
                        f32x4 ev; ev[0] = __uint_as_float(e0 << 16); ev[1] = __uint_as_float(e0 & 0xffff0000u); ev[2] = __uint_as_float(e1 << 16); ev[3] = __uint_as_float(e1 & 0xffff0000u);
                        ev = ev * g[bj][n] * rs; const f32x4 a = acc[ai][bj][m][n];
#pragma unroll
                        for (int k = 0; k < 4; ++k) { const float sg = __builtin_amdgcn_rcpf(1.0f + __builtin_amdgcn_exp2f(-1.4426950408889634f * a[k])); r[n][k] = x[k] + ev[k] * sg; } }
                    if (XBout) { part += sq4v(r[0]) + sq4v(r[1]); u32x4 w; w.x = cvt_pk_bf16(r[0][0], r[0][1]); w.y = cvt_pk_bf16(r[0][2], r[0][3]); w.z = cvt_pk_bf16(r[1][0], r[1][1]); w.w = cvt_pk_bf16(r[1][2], r[1][3]);
                        *(u32x4*)(XBout + off + bj * HALF) = w; }
                    else { *(f32x4*)(OUT + off + bj * HALF) = r[0]; *(f32x4*)(OUT + off + bj * HALF + 4) = r[1]; } }
                if (XBout) stat_put(ss_out, row, 32, u.pn * 4 + wc, part, fq); }
            asm volatile("" ::: "memory"); }
    }
};
__device__ __forceinline__ void pg8_dma2(unsigned v0, unsigned v1, const void* base, unsigned dst) { unsigned keep;
    asm volatile("s_mov_b32 %0, m0\n\ts_mov_b32 m0, %4\n\ts_nop 0\n\tglobal_load_lds_dwordx4 %1, %3\n\ts_add_u32 m0, m0, 0x2000\n\ts_nop 0\n\tglobal_load_lds_dwordx4 %2, %3\n\ts_mov_b32 m0, %0"
                 : "=&s"(keep) : "v"(v0), "v"(v1), "s"(base), "s"(dst) : "memory", "scc"); }
__device__ __forceinline__ void pg8_dma6(unsigned v0, unsigned v1, unsigned v2, unsigned v3, unsigned v4, unsigned v5, const void* b0, const void* b1, const void* b2, unsigned d0, unsigned d1, unsigned d2) { unsigned keep;
    asm volatile("s_mov_b32 %0, m0\n\ts_mov_b32 m0, %10\n\ts_nop 0\n\tglobal_load_lds_dwordx4 %1, %7\n\ts_add_u32 m0, m0, 0x2000\n\ts_nop 0\n\tglobal_load_lds_dwordx4 %2, %7\n\t"
                 "s_mov_b32 m0, %11\n\ts_nop 0\n\tglobal_load_lds_dwordx4 %3, %8\n\ts_add_u32 m0, m0, 0x2000\n\ts_nop 0\n\tglobal_load_lds_dwordx4 %4, %8\n\t"
                 "s_mov_b32 m0, %12\n\ts_nop 0\n\tglobal_load_lds_dwordx4 %5, %9\n\ts_add_u32 m0, m0, 0x2000\n\ts_nop 0\n\tglobal_load_lds_dwordx4 %6, %9\n\ts_mov_b32 m0, %0"
                 : "=&s"(keep) : "v"(v0), "v"(v1), "v"(v2), "v"(v3), "v"(v4), "v"(v5), "s"(b0), "s"(b1), "s"(b2), "s"(d0), "s"(d1), "s"(d2) : "memory", "scc"); }
#ifndef PG8_DPOS
#define PG8_DPOS 0
#endif
template <class Epi, class Sched, bool ALIGN_EPI = false, bool SP2 = false>
__device__ __forceinline__ void gemm_phase(PG8_LAS unsigned char* lds, const Gemm g, const Sched& S, const Epi& E) {
    int tid_ = threadIdx.x; asm volatile("" : "+v"(tid_));
    const int tid = tid_, wid = __builtin_amdgcn_readfirstlane(tid >> 6), lane = tid & 63, wr = wid >> 2, wc = wid & 3, fr = lane & 15, fq = lane >> 4;
    const int K = g.K, nt = K / BK;
    unsigned voffA[2], voffB[2];
#pragma unroll
    for (int i = 0; i < 2; ++i) { int R, C; stage_rc(tid * 16 + i * 8192, R, C); const int Rb = Epi::PERM ? ((R & ~31) + perm32(R & 31)) : R;
        voffA[i] = (unsigned)(R * K + C) * 2u; voffB[i] = (unsigned)(Rb * K + C) * 2u; }
    const size_t kstep = (size_t)(BK * 2);
    const size_t hstep = (size_t)HALF * K * 2;
    const size_t tstep = 2 * hstep;
    const unsigned ldsw = (unsigned)wid * 1024u;
    const unsigned ldsb = (unsigned)__builtin_amdgcn_readfirstlane((int)((unsigned)(size_t)lds + ldsw));
    const int aoff = lds_byte(wr * 64 + fr, fq * 8), boff = lds_byte(wc * 32 + fr, fq * 8);
#define PG8_SA(b, h) (((b) * 2 + (h)) * HTB)
#define PG8_SB(b, h) ((4 + (b) * 2 + (h)) * HTB)
#define PG8_STAGE(bufoff, gbase, voff) pg8_dma2((voff)[0], (voff)[1], (gbase), ldsb + (unsigned)(bufoff))
#define PG8_STAGE3(o0, g0, v0, o1, g1, v1, o2, g2, v2) pg8_dma6((v0)[0], (v0)[1], (v1)[0], (v1)[1], (v2)[0], (v2)[1], (g0), (g1), (g2), ldsb + (unsigned)(o0), ldsb + (unsigned)(o1), ldsb + (unsigned)(o2))
#define PG8_LDA(dst, b, h) do { _Pragma("unroll") for (int m = 0; m < 4; ++m) _Pragma("unroll") for (int k = 0; k < 2; ++k) dst[m][k] = *(const PG8_LAS bf16x8*)(lds + PG8_SA(b, h) + aoff + m * 2048 + k * 1024); } while (0)
#define PG8_LDB(dst, b, h) do { _Pragma("unroll") for (int n = 0; n < 2; ++n) _Pragma("unroll") for (int k = 0; k < 2; ++k) dst[n][k] = *(const PG8_LAS bf16x8*)(lds + PG8_SB(b, h) + boff + n * 2048 + k * 1024); } while (0)
#define PG8_MMA(ai, bj, At, Bt) do { __builtin_amdgcn_s_setprio(1); _Pragma("unroll") for (int m = 0; m < 4; ++m) _Pragma("unroll") for (int n = 0; n < 2; ++n) _Pragma("unroll") for (int k = 0; k < 2; ++k) \
        acc[ai][bj][m][n] = __builtin_amdgcn_mfma_f32_16x16x32_bf16(Bt[n][k], At[m][k], acc[ai][bj][m][n], 0, 0, 0); __builtin_amdgcn_s_setprio(0); } while (0)
#define PG8_WAIT_V(n) asm volatile("s_waitcnt vmcnt(" #n ")" ::: "memory")
#define PG8_WAIT_L(n) asm volatile("s_waitcnt lgkmcnt(" #n ")" ::: "memory")
#define PG8_BAR __builtin_amdgcn_s_barrier()
#define PG8_SCHED __builtin_amdgcn_sched_barrier(0)
    Unit cur, nxt; int ui = 0;
    if (!S.next(0, cur)) return;
    typedef double f64x2z __attribute__((ext_vector_type(2)));
    f32x4 acc[2][2][4][2];
#pragma unroll
    for (int a = 0; a < 2; ++a)
#pragma unroll
        for (int b = 0; b < 2; ++b)
#pragma unroll
            for (int m = 0; m < 4; ++m)
#pragma unroll
                for (int n = 0; n < 2; ++n) { double z0_, z1_; asm volatile("v_mov_b64 %0, 0\n\tv_mov_b64 %1, 0" : "=v"(z0_), "=v"(z1_)); const f64x2z zz_ = {z0_, z1_}; acc[a][b][m][n] = __builtin_bit_cast(f32x4, zz_); }
    bf16x8 At[4][2], B0[2][2], B1[2][2];
    const char* cA = (const char*)g.A + (size_t)cur.pm * tstep; const char* cB = (const char*)g.Bt + (size_t)cur.pn * tstep;
    S.a_ready(cur);
    if constexpr (SP2) {
        PG8_STAGE(PG8_SB(0, 0), cB, voffB); PG8_STAGE(PG8_SB(0, 1), cB + hstep, voffB); PG8_STAGE(PG8_SA(0, 0), cA, voffA); PG8_STAGE(PG8_SA(0, 1), cA + hstep, voffA);
        if (wr == 1) PG8_BAR;
        PG8_WAIT_V(2); PG8_BAR;
        PG8_STAGE(PG8_SB(1, 0), cB + kstep, voffB); PG8_STAGE(PG8_SA(1, 0), cA + kstep, voffA); PG8_STAGE(PG8_SB(1, 1), cB + hstep + kstep, voffB);
        PG8_WAIT_V(6); PG8_BAR;
    } else {
        PG8_STAGE(PG8_SB(0, 0), cB, voffB); PG8_STAGE(PG8_SA(0, 0), cA, voffA); PG8_STAGE(PG8_SB(0, 1), cB + hstep, voffB); PG8_STAGE(PG8_SA(0, 1), cA + hstep, voffA);
        if (wr == 1) PG8_BAR;
        PG8_WAIT_V(4); PG8_BAR;
        PG8_STAGE(PG8_SB(1, 0), cB + kstep, voffB); PG8_STAGE(PG8_SA(1, 0), cA + kstep, voffA); PG8_STAGE(PG8_SB(1, 1), cB + hstep + kstep, voffB);
        PG8_WAIT_V(6); PG8_BAR;
    }
    for (;;) {
        const bool has_next = S.next(ui + 1, nxt);
        const char* nA = has_next ? (const char*)g.A + (size_t)nxt.pm * tstep : cA; const char* nB = has_next ? (const char*)g.Bt + (size_t)nxt.pn * tstep : cB;
        for (int t = 0; t < nt; t += 2) {
            const bool last = (t == nt - 2);
            const char* a1 = cA + (size_t)(t + 1) * kstep;
            const char* a2 = last ? nA : cA + (size_t)(t + 2) * kstep; const char* b2 = last ? nB : cB + (size_t)(t + 2) * kstep;
            const char* a3 = a2 + kstep; const char* b3 = b2 + kstep;
            if (last && has_next) S.a_ready(nxt);
            if constexpr (SP2) {
#if PG8_DPOS == 0
            PG8_LDB(B0, 0, 0); PG8_LDB(B1, 0, 1); PG8_SCHED; PG8_LDA(At, 0, 0); PG8_STAGE(PG8_SA(1, 1), a1 + hstep, voffA);
            PG8_WAIT_V(8); PG8_WAIT_L(0); PG8_BAR; PG8_MMA(0, 0, At, B0); PG8_MMA(0, 1, At, B1); PG8_BAR; PG8_SCHED;
#elif PG8_DPOS == 1
            PG8_LDB(B0, 0, 0); PG8_LDB(B1, 0, 1); PG8_SCHED; PG8_LDA(At, 0, 0);
            PG8_WAIT_V(6); PG8_WAIT_L(0); PG8_BAR; PG8_SCHED; PG8_STAGE(PG8_SA(1, 1), a1 + hstep, voffA); PG8_SCHED; PG8_MMA(0, 0, At, B0); PG8_MMA(0, 1, At, B1); PG8_BAR; PG8_SCHED;
#else
            PG8_LDB(B0, 0, 0); PG8_LDB(B1, 0, 1); PG8_SCHED; PG8_LDA(At, 0, 0);
            PG8_WAIT_V(6); PG8_WAIT_L(0); PG8_BAR; PG8_MMA(0, 0, At, B0); PG8_SCHED; PG8_STAGE(PG8_SA(1, 1), a1 + hstep, voffA); PG8_SCHED; PG8_MMA(0, 1, At, B1); PG8_BAR; PG8_SCHED;
#endif
#if PG8_DPOS == 0
            PG8_LDA(At, 0, 1); PG8_STAGE3(PG8_SB(0, 0), b2, voffB, PG8_SB(0, 1), b2 + hstep, voffB, PG8_SA(0, 0), a2, voffA);
            PG8_WAIT_V(8); PG8_WAIT_L(0); PG8_BAR; PG8_MMA(1, 0, At, B0); PG8_MMA(1, 1, At, B1); PG8_BAR; PG8_SCHED;
#elif PG8_DPOS == 1
            PG8_LDA(At, 0, 1);
            PG8_WAIT_V(2); PG8_WAIT_L(0); PG8_BAR; PG8_SCHED; PG8_STAGE3(PG8_SB(0, 0), b2, voffB, PG8_SB(0, 1), b2 + hstep, voffB, PG8_SA(0, 0), a2, voffA); PG8_SCHED; PG8_MMA(1, 0, At, B0); PG8_MMA(1, 1, At, B1); PG8_BAR; PG8_SCHED;
#else
            PG8_LDA(At, 0, 1);
            PG8_WAIT_V(2); PG8_WAIT_L(0); PG8_BAR; PG8_MMA(1, 0, At, B0); PG8_SCHED; PG8_STAGE3(PG8_SB(0, 0), b2, voffB, PG8_SB(0, 1), b2 + hstep, voffB, PG8_SA(0, 0), a2, voffA); PG8_SCHED; PG8_MMA(1, 1, At, B1); PG8_BAR; PG8_SCHED;
#endif
#if PG8_DPOS == 0
            PG8_LDB(B0, 1, 0); PG8_LDB(B1, 1, 1); PG8_SCHED; PG8_LDA(At, 1, 0); PG8_STAGE(PG8_SA(0, 1), a2 + hstep, voffA);
            PG8_WAIT_V(8); PG8_WAIT_L(0); PG8_BAR; PG8_MMA(0, 0, At, B0); PG8_MMA(0, 1, At, B1); PG8_BAR; PG8_SCHED;
#elif PG8_DPOS == 1
            PG8_LDB(B0, 1, 0); PG8_LDB(B1, 1, 1); PG8_SCHED; PG8_LDA(At, 1, 0);
            PG8_WAIT_V(6); PG8_WAIT_L(0); PG8_BAR; PG8_SCHED; PG8_STAGE(PG8_SA(0, 1), a2 + hstep, voffA); PG8_SCHED; PG8_MMA(0, 0, At, B0); PG8_MMA(0, 1, At, B1); PG8_BAR; PG8_SCHED;
#else
            PG8_LDB(B0, 1, 0); PG8_LDB(B1, 1, 1); PG8_SCHED; PG8_LDA(At, 1, 0);
            PG8_WAIT_V(6); PG8_WAIT_L(0); PG8_BAR; PG8_MMA(0, 0, At, B0); PG8_SCHED; PG8_STAGE(PG8_SA(0, 1), a2 + hstep, voffA); PG8_SCHED; PG8_MMA(0, 1, At, B1); PG8_BAR; PG8_SCHED;
#endif
#if PG8_DPOS == 0
            PG8_LDA(At, 1, 1); PG8_STAGE3(PG8_SB(1, 0), b3, voffB, PG8_SB(1, 1), b3 + hstep, voffB, PG8_SA(1, 0), a3, voffA);
            PG8_WAIT_V(8); PG8_WAIT_L(0); PG8_BAR; PG8_MMA(1, 0, At, B0); PG8_MMA(1, 1, At, B1); PG8_BAR; PG8_SCHED;
#elif PG8_DPOS == 1
            PG8_LDA(At, 1, 1);
            PG8_WAIT_V(2); PG8_WAIT_L(0); PG8_BAR; PG8_SCHED; PG8_STAGE3(PG8_SB(1, 0), b3, voffB, PG8_SB(1, 1), b3 + hstep, voffB, PG8_SA(1, 0), a3, voffA); PG8_SCHED; PG8_MMA(1, 0, At, B0); PG8_MMA(1, 1, At, B1); PG8_BAR; PG8_SCHED;
#else
            PG8_LDA(At, 1, 1);
            PG8_WAIT_V(2); PG8_WAIT_L(0); PG8_BAR; PG8_MMA(1, 0, At, B0); PG8_SCHED; PG8_STAGE3(PG8_SB(1, 0), b3, voffB, PG8_SB(1, 1), b3 + hstep, voffB, PG8_SA(1, 0), a3, voffA); PG8_SCHED; PG8_MMA(1, 1, At, B1); PG8_BAR; PG8_SCHED;
#endif
            } else {
            PG8_LDB(B0, 0, 0); PG8_SCHED; PG8_LDA(At, 0, 0); PG8_STAGE(PG8_SA(1, 1), a1 + hstep, voffA);
            PG8_WAIT_L(8); PG8_BAR; PG8_WAIT_L(0); PG8_MMA(0, 0, At, B0); PG8_BAR; PG8_SCHED;
            PG8_LDB(B1, 0, 1); PG8_STAGE(PG8_SB(0, 0), b2, voffB);
            PG8_BAR; PG8_WAIT_L(0); PG8_MMA(0, 1, At, B1); PG8_BAR;
            PG8_LDA(At, 0, 1); PG8_STAGE(PG8_SA(0, 0), a2, voffA);
            PG8_BAR; PG8_WAIT_L(0); PG8_MMA(1, 0, At, B0); PG8_BAR; PG8_SCHED;
            PG8_STAGE(PG8_SB(0, 1), b2 + hstep, voffB);
            PG8_WAIT_V(6); PG8_BAR; PG8_MMA(1, 1, At, B1); PG8_BAR;
            PG8_LDB(B0, 1, 0); PG8_SCHED; PG8_LDA(At, 1, 0); PG8_STAGE(PG8_SA(0, 1), a2 + hstep, voffA);
            PG8_WAIT_L(8); PG8_BAR; PG8_WAIT_L(0); PG8_MMA(0, 0, At, B0); PG8_BAR; PG8_SCHED;
            PG8_LDB(B1, 1, 1); PG8_STAGE(PG8_SB(1, 0), b3, voffB);
            PG8_BAR; PG8_WAIT_L(0); PG8_MMA(0, 1, At, B1); PG8_BAR;
            PG8_LDA(At, 1, 1); PG8_STAGE(PG8_SA(1, 0), a3, voffA);
            PG8_BAR; PG8_WAIT_L(0); PG8_MMA(1, 0, At, B0); PG8_BAR; PG8_SCHED;
            PG8_STAGE(PG8_SB(1, 1), b3 + hstep, voffB);
            PG8_WAIT_V(6); PG8_BAR; PG8_MMA(1, 1, At, B1); PG8_BAR;
            }
        }
        if constexpr (ALIGN_EPI) { if (wr == 0) PG8_BAR; }
        if constexpr (!Epi::AFTER_DRAIN) { E(acc, cur, wr, wc, fr, fq); S.done(cur); }
        if (!has_next) break;
#pragma unroll
        for (int a = 0; a < 2; ++a)
#pragma unroll
            for (int b = 0; b < 2; ++b)
#pragma unroll
                for (int m = 0; m < 4; ++m)
#pragma unroll
                    for (int n = 0; n < 2; ++n) { double z0_, z1_; asm volatile("v_mov_b64 %0, 0\n\tv_mov_b64 %1, 0" : "=v"(z0_), "=v"(z1_)); const f64x2z zz_ = {z0_, z1_}; acc[a][b][m][n] = __builtin_bit_cast(f32x4, zz_); }
        cur = nxt; cA = nA; cB = nB; ++ui;
        if constexpr (ALIGN_EPI) { if (wr == 1) PG8_BAR; }
    }
    PG8_WAIT_V(0);
    if constexpr (!ALIGN_EPI) { if (wr == 0) PG8_BAR; }
    PG8_BAR;
    if constexpr (Epi::AFTER_DRAIN) { E.fused(acc, cur, wr, wc, fr, fq, lds, wid, lane); S.done(cur); }
#undef PG8_SA
#undef PG8_SB
#undef PG8_STAGE
#undef PG8_STAGE3
#undef PG8_LDA
#undef PG8_LDB
#undef PG8_MMA
#undef PG8_WAIT_V
#undef PG8_WAIT_L
#undef PG8_BAR
#undef PG8_SCHED
}
}

#include <type_traits>
namespace att {
typedef short bf16x8 __attribute__((ext_vector_type(8)));
typedef short s16x4 __attribute__((ext_vector_type(4)));
typedef float f32x16 __attribute__((ext_vector_type(16)));
typedef unsigned u32x4 __attribute__((ext_vector_type(4)));
typedef unsigned short bf16_t;
#define ATT_LAS __attribute__((address_space(3)))
#define ATT_SBAR() __builtin_amdgcn_sched_barrier(0)
constexpr int KN_OFF = 0, KN_SLOT = 16384, KR_OFF = 49152, KR_SLOT = 8192, V_OFF = 73728, V_SLOT = 16384, WSC_OFF = V_OFF + 4 * V_SLOT, BT_OFF = KR_OFF, ATT_LDS_BYTES = WSC_OFF + 8 * 256;
constexpr int BT_STRIDE = 384, BT_ZERO = 191;
__host__ __device__ __forceinline__ int crow(int r, int hi) { return (r & 3) + 8 * (r >> 2) + 4 * hi; }
__device__ __forceinline__ unsigned cvtpk(float lo, float hi) { unsigned r; asm volatile("v_cvt_pk_bf16_f32 %0, %1, %2" : "=v"(r) : "v"(lo), "v"(hi)); return r; }
__host__ __device__ __forceinline__ int kn_byte(int R, int c) { return R * 256 + ((c ^ (R & 15)) << 4); }
__host__ __device__ __forceinline__ int kr_byte(int R, int c) { return R * 128 + ((c ^ ((R >> 1) & 7)) << 4); }
__host__ __device__ __forceinline__ int v_st(int k, int c) { const int kk = (k & ~0xC) | ((k & 4) << 1) | ((k & 8) >> 1); return ((kk >> 3) * 4 + (c >> 5)) * 512 + ((kk & 7) * 32 + (c & 31)) * 2; }
__host__ __device__ __forceinline__ int v_rd_base(int lane) { return ((lane & 3) << 3) | (((lane >> 2) & 3) << 6) | (((lane >> 4) & 1) << 5) | (((lane >> 5) & 1) << 8); }
__host__ __device__ constexpr int v_rd_off(int d0, int ks, int half) { return d0 * 512 + ks * 4096 + half * 2048; }
__host__ __device__ __forceinline__ void kn_inv(int b, int& R, int& c) { R = b >> 8; c = ((b >> 4) & 15) ^ (R & 15); }
__host__ __device__ __forceinline__ void kr_inv(int b, int& R, int& c) { R = b >> 7; c = ((b >> 4) & 7) ^ ((R >> 1) & 7); }
__host__ __device__ __forceinline__ void v_inv(int b, int& k, int& col) { const int s = b >> 9, w = b & 511, kk = ((s >> 2) << 3) | (w >> 6); k = (kk & ~0xC) | ((kk & 4) << 1) | ((kk & 8) >> 1); col = (s & 3) * 32 + ((w & 63) >> 1); }

__device__ __forceinline__ void glds16(const void* gsrc, unsigned lds_dst) { unsigned keep;
    asm volatile("s_mov_b32 %0, m0\n\ts_mov_b32 m0, %2\n\ts_nop 0\n\tglobal_load_lds_dwordx4 %1, off\n\ts_mov_b32 m0, %0" : "=&s"(keep) : "v"(gsrc), "s"(lds_dst) : "memory"); }
__device__ __forceinline__ void glds16x5(unsigned ok0, unsigned ok1, unsigned orr, unsigned ov0, unsigned ov1, const void* kb, const void* rb, const void* vb, unsigned dk, unsigned dr, unsigned dv) { unsigned keep;
    asm volatile("s_mov_b32 %0, m0\n\ts_mov_b32 m0, %9\n\ts_nop 0\n\tglobal_load_lds_dwordx4 %1, %6\n\ts_add_u32 m0, m0, 0x2000\n\ts_nop 0\n\tglobal_load_lds_dwordx4 %2, %6\n\t"
                 "s_mov_b32 m0, %10\n\ts_nop 0\n\tglobal_load_lds_dwordx4 %3, %7\n\ts_mov_b32 m0, %11\n\ts_nop 0\n\tglobal_load_lds_dwordx4 %4, %8\n\ts_add_u32 m0, m0, 0x2000\n\ts_nop 0\n\tglobal_load_lds_dwordx4 %5, %8\n\ts_mov_b32 m0, %0"
                 : "=&s"(keep) : "v"(ok0), "v"(ok1), "v"(orr), "v"(ov0), "v"(ov1), "s"(kb), "s"(rb), "s"(vb), "s"(dk), "s"(dr), "s"(dv) : "memory", "scc"); }
template <int OFF> __device__ __forceinline__ s16x4 tr_read(int vb) { s16x4 r; asm volatile("ds_read_b64_tr_b16 %0, %1 offset:%2" : "=&v"(r) : "v"(vb), "i"(OFF) : "memory"); return r; }
struct VFrag { s16x4 l0, h0, l1, h1, l2, h2, l3, h3; };
template <int D0> __device__ __forceinline__ void v_load(VFrag& f, int vb) {
    f.l0 = tr_read<v_rd_off(D0, 0, 0)>(vb); f.h0 = tr_read<v_rd_off(D0, 0, 1)>(vb); f.l1 = tr_read<v_rd_off(D0, 1, 0)>(vb); f.h1 = tr_read<v_rd_off(D0, 1, 1)>(vb);
    f.l2 = tr_read<v_rd_off(D0, 2, 0)>(vb); f.h2 = tr_read<v_rd_off(D0, 2, 1)>(vb); f.l3 = tr_read<v_rd_off(D0, 3, 0)>(vb); f.h3 = tr_read<v_rd_off(D0, 3, 1)>(vb);
}
__device__ __forceinline__ void pv_mma(f32x16& od, const VFrag& f, bf16x8 pa0, bf16x8 pa1, bf16x8 pa2, bf16x8 pa3) {
#define ATT_PK(L, H) (bf16x8){L[0], L[1], L[2], L[3], H[0], H[1], H[2], H[3]}
    od = __builtin_amdgcn_mfma_f32_32x32x16_bf16(pa0, ATT_PK(f.l0, f.h0), od, 0, 0, 0);
    od = __builtin_amdgcn_mfma_f32_32x32x16_bf16(pa1, ATT_PK(f.l1, f.h1), od, 0, 0, 0);
    od = __builtin_amdgcn_mfma_f32_32x32x16_bf16(pa2, ATT_PK(f.l2, f.h2), od, 0, 0, 0);
    od = __builtin_amdgcn_mfma_f32_32x32x16_bf16(pa3, ATT_PK(f.l3, f.h3), od, 0, 0, 0);
#undef ATT_PK
}
__device__ __forceinline__ void pv_all(f32x16* o, int vb, bf16x8 pa0, bf16x8 pa1, bf16x8 pa2, bf16x8 pa3) {
    VFrag fa, fb;
    v_load<0>(fa, vb); v_load<1>(fb, vb);
    asm volatile("s_waitcnt lgkmcnt(8)" ::: "memory"); ATT_SBAR(); pv_mma(o[0], fa, pa0, pa1, pa2, pa3); ATT_SBAR();
    v_load<2>(fa, vb);
    asm volatile("s_waitcnt lgkmcnt(8)" ::: "memory"); ATT_SBAR(); pv_mma(o[1], fb, pa0, pa1, pa2, pa3); ATT_SBAR();
    v_load<3>(fb, vb);
    asm volatile("s_waitcnt lgkmcnt(8)" ::: "memory"); ATT_SBAR(); pv_mma(o[2], fa, pa0, pa1, pa2, pa3); ATT_SBAR();
    asm volatile("s_waitcnt lgkmcnt(0)" ::: "memory"); ATT_SBAR(); pv_mma(o[3], fb, pa0, pa1, pa2, pa3); ATT_SBAR();
}
#define ATT_WAIT_BAR(N) asm volatile("s_waitcnt vmcnt(%0) lgkmcnt(0)\n\ts_barrier" :: "n"(N) : "memory")

template <bool SWA>
__device__ __forceinline__ void attn_unit(const bf16_t* __restrict__ Qw, int ldq, const bf16_t* __restrict__ Kn, const bf16_t* __restrict__ Kr, const bf16_t* __restrict__ Vg, int ldk,
                                          bf16_t* __restrict__ Ow, int ldo, int NT, int qk_rel0  , float C, float sinkl,
                                          ATT_LAS unsigned char* shm, const ATT_LAS float* bt) {
    constexpr int NQ = SWA ? 8 : 12;
    constexpr int PIECES = SWA ? 4 : 5;
    int tid_ = threadIdx.x; asm volatile("" : "+v"(tid_));
    const int tid = tid_, lane = tid & 63, r32 = lane & 31, hi = lane >> 5; const int wid = __builtin_amdgcn_readfirstlane(tid >> 6);
    const unsigned lds0 = (unsigned)(size_t)shm;
    ATT_LAS float* wsf = (ATT_LAS float*)(shm + WSC_OFF) + wid * 64;
    const bf16_t* ksrc0; const bf16_t* ksrc1; const bf16_t* rsrc = nullptr; const bf16_t* vsrc0; const bf16_t* vsrc1;
    { int R, c; kn_inv(wid * 1024 + lane * 16, R, c); ksrc0 = Kn + (size_t)R * ldk + c * 8; kn_inv((wid + 8) * 1024 + lane * 16, R, c); ksrc1 = Kn + (size_t)R * ldk + c * 8;
      if (!SWA) { kr_inv(wid * 1024 + lane * 16, R, c); rsrc = Kr + (size_t)R * 64 + c * 8; }
      int k, col; v_inv(wid * 1024 + lane * 16, k, col); vsrc0 = Vg + (size_t)k * ldk + col; v_inv((wid + 8) * 1024 + lane * 16, k, col); vsrc1 = Vg + (size_t)k * ldk + col; }
    const size_t tstep = (size_t)64 * ldk;
    const unsigned dk0 = lds0 + KN_OFF + wid * 1024, dk1 = dk0 + 8192, dr = lds0 + KR_OFF + wid * 1024, dv0 = lds0 + V_OFF + wid * 1024, dv1 = dv0 + 8192;
#define ATT_ISSUE(t, s, sv) do { const size_t to_ = (size_t)(t) * tstep; const unsigned s_ = (unsigned)(s), sv_ = (unsigned)(sv); \
        glds16(ksrc0 + to_, (unsigned)__builtin_amdgcn_readfirstlane(dk0 + s_ * KN_SLOT)); glds16(ksrc1 + to_, (unsigned)__builtin_amdgcn_readfirstlane(dk1 + s_ * KN_SLOT)); \
        if (!SWA) glds16(rsrc + (size_t)(t) * 64 * 64, (unsigned)__builtin_amdgcn_readfirstlane(dr + s_ * KR_SLOT)); \
        glds16(vsrc0 + to_, (unsigned)__builtin_amdgcn_readfirstlane(dv0 + sv_ * V_SLOT)); glds16(vsrc1 + to_, (unsigned)__builtin_amdgcn_readfirstlane(dv1 + sv_ * V_SLOT)); } while (0)
    ATT_ISSUE(0, 0, 0); if (NT > 1) ATT_ISSUE(1, 1, 1);
    bf16x8 qr[NQ];
#pragma unroll
    for (int d0 = 0; d0 < NQ; ++d0) qr[d0] = *(const bf16x8*)(Qw + (size_t)r32 * ldq + d0 * 16 + hi * 8);
#pragma unroll
    for (int d0 = 0; d0 < NQ; ++d0) asm volatile("" : "+v"(qr[d0]));
    constexpr float THR = 8.f;
    float m_reg = SWA ? sinkl : 0.f, l_reg = SWA ? 1.f : 0.f;
    f32x16 negm;
#pragma unroll
    for (int r = 0; r < 16; ++r) negm[r] = 0.f;
    f32x16 o[4];
#pragma unroll
    for (int d = 0; d < 4; ++d)
#pragma unroll
        for (int r = 0; r < 16; ++r) o[d][r] = 0.f;
    const ATT_LAS unsigned char* kn0 = shm + KN_OFF; const ATT_LAS unsigned char* kr0 = shm + KR_OFF;
    const int vb0 = (int)(lds0 + V_OFF) + v_rd_base(lane);
    int s_cur = 0, s_n2 = 2, v_cur = 0, v_n2 = 2;
    ATT_WAIT_BAR(0);
    if (wid >= 4) asm volatile("s_barrier" ::: "memory");
    for (int j = 0; j < NT; ++j) {
        if (j + 2 < NT) ATT_ISSUE(j + 2, s_n2, v_n2);
        ATT_SBAR();
        f32x16 p0, p1;
        { const ATT_LAS unsigned char* kb = kn0 + s_cur * KN_SLOT; const ATT_LAS unsigned char* rb = kr0 + s_cur * KR_SLOT;
#define ATT_KF(d0_, half_) ((d0_) < 8 ? *(const ATT_LAS bf16x8*)(kb + kn_byte((half_) * 32 + r32, (d0_) * 2 + hi)) : *(const ATT_LAS bf16x8*)(rb + kr_byte((half_) * 32 + r32, ((d0_) - 8) * 2 + hi)))
          bf16x8 fa[NQ + 2], fb[NQ + 2];
          fa[0] = ATT_KF(0, 0); fb[0] = ATT_KF(0, 1); fa[1] = ATT_KF(1, 0); fb[1] = ATT_KF(1, 1);
#pragma unroll
          for (int d0 = 0; d0 < NQ; ++d0) {
              if (d0 + 2 < NQ) { fa[d0 + 2] = ATT_KF(d0 + 2, 0); fb[d0 + 2] = ATT_KF(d0 + 2, 1); }
              ATT_SBAR();
              if (d0 == 0) { p0 = __builtin_amdgcn_mfma_f32_32x32x16_bf16(fa[0], qr[0], negm, 0, 0, 0); p1 = __builtin_amdgcn_mfma_f32_32x32x16_bf16(fb[0], qr[0], negm, 0, 0, 0); }
              else { p0 = __builtin_amdgcn_mfma_f32_32x32x16_bf16(fa[d0], qr[d0], p0, 0, 0, 0); p1 = __builtin_amdgcn_mfma_f32_32x32x16_bf16(fb[d0], qr[d0], p1, 0, 0, 0); }
              ATT_SBAR();
          }
#undef ATT_KF
        }
        ATT_SBAR();
        if (j + 2 < NT) { ATT_WAIT_BAR(PIECES); } else { ATT_WAIT_BAR(0); }
        ATT_SBAR();
        if constexpr (SWA) {
            const ATT_LAS float* btb = bt + (qk_rel0 + j * 64 - r32 + BT_ZERO + 4 * hi);
#pragma unroll
            for (int r = 0; r < 16; ++r) { const int cr = (r & 3) + 8 * (r >> 2);
                p0[r] = fmaf(p0[r], C, btb[cr]); p1[r] = fmaf(p1[r], C, btb[cr + 32]); }
            float pmax = p0[0];
#pragma unroll
            for (int r = 1; r < 16; ++r) pmax = fmaxf(pmax, p0[r]);
#pragma unroll
            for (int r = 0; r < 16; ++r) pmax = fmaxf(pmax, p1[r]);
            { auto rr = __builtin_amdgcn_permlane32_swap(__float_as_uint(pmax), __float_as_uint(pmax), false, false); pmax = fmaxf(__uint_as_float(rr[0]), __uint_as_float(rr[1])); }
            const float mn = fmaxf(m_reg, pmax), alpha = __builtin_amdgcn_exp2f(m_reg - mn); m_reg = mn;
            float ps = 0.f;
#pragma unroll
            for (int r = 0; r < 16; ++r) { p0[r] = __builtin_amdgcn_exp2f(p0[r] - mn); p1[r] = __builtin_amdgcn_exp2f(p1[r] - mn); ps += p0[r] + p1[r]; }
            { auto rr = __builtin_amdgcn_permlane32_swap(__float_as_uint(ps), __float_as_uint(ps), false, false); ps = __uint_as_float(rr[0]) + __uint_as_float(rr[1]); }
            l_reg = l_reg * alpha + ps;
            if (__any(alpha < 1.f)) { if (hi == 0) wsf[r32] = alpha; asm volatile("s_waitcnt lgkmcnt(0)" ::: "memory");
#pragma unroll
                for (int r = 0; r < 16; ++r) { const float a = wsf[crow(r, hi)];
#pragma unroll
                    for (int d = 0; d < 4; ++d) o[d][r] *= a; }
                asm volatile("s_waitcnt lgkmcnt(0)" ::: "memory"); }
        } else {
#define ATT_MX3(a, b, c) __builtin_fmaxf(__builtin_fmaxf((a), (b)), (c))
            float ma = ATT_MX3(p0[0], p0[1], p1[0]), mb = ATT_MX3(p0[2], p0[3], p1[1]); ma = ATT_MX3(ma, p1[2], p1[3]);
#pragma unroll
            for (int r = 4; r < 16; r += 4) { ma = ATT_MX3(ma, p0[r], p0[r + 1]); mb = ATT_MX3(mb, p0[r + 2], p0[r + 3]); ma = ATT_MX3(ma, p1[r], p1[r + 1]); mb = ATT_MX3(mb, p1[r + 2], p1[r + 3]); }
#undef ATT_MX3
            float pmax = __builtin_fmaxf(ma, mb);
            { auto rr = __builtin_amdgcn_permlane32_swap(__float_as_uint(pmax), __float_as_uint(pmax), false, false); pmax = __builtin_fmaxf(__uint_as_float(rr[0]), __uint_as_float(rr[1])); }
            if (j == 0 || __any(pmax > THR)) {
                const float dl = (j == 0) ? pmax : __builtin_fmaxf(pmax, 0.f); m_reg += dl;
#pragma unroll
                for (int r = 0; r < 16; ++r) { p0[r] -= dl; p1[r] -= dl; negm[r] = -m_reg; }
                const float f = __builtin_amdgcn_exp2f(-dl); l_reg *= f;
                if (j != 0) { if (hi == 0) wsf[r32] = f; asm volatile("s_waitcnt lgkmcnt(0)" ::: "memory");
#pragma unroll
                    for (int r = 0; r < 16; ++r) { const float a = wsf[crow(r, hi)];
#pragma unroll
                        for (int d = 0; d < 4; ++d) o[d][r] *= a; }
                    asm volatile("s_waitcnt lgkmcnt(0)" ::: "memory"); }
            }
            float ps0 = 0.f, ps1 = 0.f;
#pragma unroll
            for (int r = 0; r < 16; ++r) { p0[r] = __builtin_amdgcn_exp2f(p0[r]); p1[r] = __builtin_amdgcn_exp2f(p1[r]); ps0 += p0[r]; ps1 += p1[r]; }
            float ps = ps0 + ps1;
            { auto rr = __builtin_amdgcn_permlane32_swap(__float_as_uint(ps), __float_as_uint(ps), false, false); ps = __uint_as_float(rr[0]) + __uint_as_float(rr[1]); }
            l_reg += ps;
        }
        bf16x8 pa0, pa1, pa2, pa3;
#define ATT_PK4(P, BASE, OUT) do { unsigned a0 = cvtpk(P[BASE + 0], P[BASE + 1]), a1 = cvtpk(P[BASE + 2], P[BASE + 3]);   \
        unsigned b0_ = cvtpk(P[BASE + 4], P[BASE + 5]), b1_ = cvtpk(P[BASE + 6], P[BASE + 7]);                              \
        auto r0 = __builtin_amdgcn_permlane32_swap(a0, b0_, false, false); auto r1 = __builtin_amdgcn_permlane32_swap(a1, b1_, false, false); \
        u32x4 w = {r0[0], r1[0], r0[1], r1[1]}; OUT = __builtin_bit_cast(bf16x8, w); } while (0)
        ATT_PK4(p0, 0, pa0); ATT_PK4(p0, 8, pa1); ATT_PK4(p1, 0, pa2); ATT_PK4(p1, 8, pa3);
#undef ATT_PK4
        ATT_SBAR();
        { const int vb = vb0 + v_cur * V_SLOT;
          pv_all(o, vb, pa0, pa1, pa2, pa3); }
        ATT_SBAR();
        asm volatile("s_waitcnt lgkmcnt(0)\n\ts_barrier" ::: "memory");
        ATT_SBAR();
        s_cur = (s_cur == 2) ? 0 : s_cur + 1; s_n2 = (s_n2 == 2) ? 0 : s_n2 + 1; v_cur = (v_cur + 1) & 3; v_n2 = (v_n2 + 1) & 3;
    }
    if (wid < 4) asm volatile("s_barrier" ::: "memory");
    if (hi == 0) wsf[32 + r32] = l_reg; asm volatile("s_waitcnt lgkmcnt(0)" ::: "memory");
#pragma unroll
    for (int r = 0; r < 16; ++r) { const int orow = crow(r, hi); const float rl = __builtin_amdgcn_rcpf(wsf[32 + orow]);
#pragma unroll
        for (int d = 0; d < 4; ++d) { const unsigned w = cvtpk(o[d][r] * rl, 0.f); Ow[(size_t)orow * ldo + d * 32 + r32] = (bf16_t)(w & 0xffffu); } }
    asm volatile("s_waitcnt lgkmcnt(0)" ::: "memory");
#undef ATT_ISSUE
}

__host__ __device__ __forceinline__ int v16_byte(int key, int col) { return (((key >> 3) * 8 + (col >> 4)) << 8) + (key & 7) * 32 + (col & 15) * 2; }
__host__ __device__ __forceinline__ void v16_inv(int b, int& key, int& col) { const int s = b >> 8, w = b & 255; key = (s >> 3) * 8 + (w >> 5); col = (s & 7) * 16 + ((w & 31) >> 1); }
__host__ __device__ __forceinline__ int v16_rd_base(int lane) { const int g = lane >> 4, q = (lane & 15) >> 2, p = lane & 3; return (g >> 1) * 2048 + (4 * (g & 1) + q) * 32 + 8 * p; }
__host__ __device__ constexpr int v16_rd_off(int t, int h, int dg) { return (4 * t + 2 * h) * 2048 + dg * 256; }
typedef float f32x4a __attribute__((ext_vector_type(4)));
__device__ __forceinline__ float xmax16(float v) { auto r = __builtin_amdgcn_permlane16_swap(__float_as_uint(v), __float_as_uint(v), false, false); return __builtin_fmaxf(__uint_as_float(r[0]), __uint_as_float(r[1])); }
__device__ __forceinline__ float xmax32(float v) { auto r = __builtin_amdgcn_permlane32_swap(__float_as_uint(v), __float_as_uint(v), false, false); return __builtin_fmaxf(__uint_as_float(r[0]), __uint_as_float(r[1])); }
__device__ __forceinline__ float xsum16(float v) { auto r = __builtin_amdgcn_permlane16_swap(__float_as_uint(v), __float_as_uint(v), false, false); return __uint_as_float(r[0]) + __uint_as_float(r[1]); }
__device__ __forceinline__ float xsum32(float v) { auto r = __builtin_amdgcn_permlane32_swap(__float_as_uint(v), __float_as_uint(v), false, false); return __uint_as_float(r[0]) + __uint_as_float(r[1]); }
template <int OFF> __device__ __forceinline__ s16x4 tr_read16(int vb) { s16x4 r; asm volatile("ds_read_b64_tr_b16 %0, %1 offset:%2" : "=&v"(r) : "v"(vb), "i"(OFF) : "memory"); return r; }

template <int T> __device__ __forceinline__ void pv_half16(f32x4a (&o)[2][8], f32x4a (&ol)[2], bf16x8 onesb, int vb, bf16x8 p0, bf16x8 p1) {
#define ATT_VRD(dg_, lo_, hi_) do { lo_ = tr_read16<v16_rd_off(T, 0, (dg_))>(vb); hi_ = tr_read16<v16_rd_off(T, 1, (dg_))>(vb); } while (0)
#define ATT_PV(dg_, lo_, hi_) do { const bf16x8 b__ = (bf16x8){lo_[0], lo_[1], lo_[2], lo_[3], hi_[0], hi_[1], hi_[2], hi_[3]}; \
        o[0][dg_] = __builtin_amdgcn_mfma_f32_16x16x32_bf16(p0, b__, o[0][dg_], 0, 0, 0); o[1][dg_] = __builtin_amdgcn_mfma_f32_16x16x32_bf16(p1, b__, o[1][dg_], 0, 0, 0); } while (0)
    s16x4 l0, h0, l1, h1, l2, h2, l3, h3;
    ATT_VRD(0, l0, h0); ATT_VRD(1, l1, h1); ATT_VRD(2, l2, h2); ATT_VRD(3, l3, h3);
    asm volatile("s_waitcnt lgkmcnt(6)" ::: "memory"); ATT_SBAR(); ATT_PV(0, l0, h0); ATT_SBAR(); ATT_VRD(4, l0, h0);
    asm volatile("s_waitcnt lgkmcnt(6)" ::: "memory"); ATT_SBAR(); ATT_PV(1, l1, h1); ATT_SBAR(); ATT_VRD(5, l1, h1);
    asm volatile("s_waitcnt lgkmcnt(6)" ::: "memory"); ATT_SBAR(); ATT_PV(2, l2, h2); ATT_SBAR(); ATT_VRD(6, l2, h2);
    asm volatile("s_waitcnt lgkmcnt(6)" ::: "memory"); ATT_SBAR(); ATT_PV(3, l3, h3); ATT_SBAR(); ATT_VRD(7, l3, h3);
    asm volatile("s_waitcnt lgkmcnt(6)" ::: "memory"); ATT_SBAR(); ATT_PV(4, l0, h0); ATT_SBAR();
    asm volatile("s_waitcnt lgkmcnt(4)" ::: "memory"); ATT_SBAR(); ATT_PV(5, l1, h1); ATT_SBAR();
    asm volatile("s_waitcnt lgkmcnt(2)" ::: "memory"); ATT_SBAR(); ATT_PV(6, l2, h2); ATT_SBAR();
    asm volatile("s_waitcnt lgkmcnt(0)" ::: "memory"); ATT_SBAR(); ATT_PV(7, l3, h3);
    ol[0] = __builtin_amdgcn_mfma_f32_16x16x32_bf16(p0, onesb, ol[0], 0, 0, 0); ol[1] = __builtin_amdgcn_mfma_f32_16x16x32_bf16(p1, onesb, ol[1], 0, 0, 0);
    ATT_SBAR();
#undef ATT_PV
#undef ATT_VRD
}
__device__ __forceinline__ float att_max3(float a, float b, float c) { float r; asm("v_max3_f32 %0, %1, %2, %3" : "=v"(r) : "v"(a), "v"(b), "v"(c)); return r; }
__device__ __forceinline__ float att_max2(float a, float b) { float r; asm("v_max_f32_e32 %0, %1, %2" : "=v"(r) : "v"(a), "v"(b)); return r; }
__device__ __forceinline__ void attn_mla16(const bf16_t* __restrict__ Qw, int ldq, const bf16_t* __restrict__ Kn, const bf16_t* __restrict__ Kr, const bf16_t* __restrict__ Vg, int ldk,
                                           bf16_t* __restrict__ Ow, int ldo, int NT, ATT_LAS unsigned char* shm) {
    constexpr int PIECES = 5;
    int tid_ = threadIdx.x; asm volatile("" : "+v"(tid_));
    const int tid = tid_, lane = tid & 63, qi = lane & 15, g = lane >> 4; const int wid = __builtin_amdgcn_readfirstlane(tid >> 6);
    const unsigned lds0 = (unsigned)(size_t)shm;
    ATT_LAS float* wsf = (ATT_LAS float*)(shm + WSC_OFF) + wid * 64;
    unsigned ok0, ok1, orr, ov0, ov1;
    { int R, c; kn_inv(wid * 1024 + lane * 16, R, c); ok0 = (unsigned)(R * ldk + c * 8) * 2u; kn_inv((wid + 8) * 1024 + lane * 16, R, c); ok1 = (unsigned)(R * ldk + c * 8) * 2u;
      kr_inv(wid * 1024 + lane * 16, R, c); orr = (unsigned)(R * 64 + c * 8) * 2u;
      int k, col; v16_inv(wid * 1024 + lane * 16, k, col); ov0 = (unsigned)(k * ldk + col) * 2u; v16_inv((wid + 8) * 1024 + lane * 16, k, col); ov1 = (unsigned)(k * ldk + col) * 2u; }
    const unsigned tstepB = 128u * (unsigned)ldk;
    const char* kp = (const char*)Kn; const char* rp = (const char*)Kr; const char* vp = (const char*)Vg;
    const unsigned dk0 = lds0 + KN_OFF + wid * 1024, dr = lds0 + KR_OFF + wid * 1024, dv0 = lds0 + V_OFF + wid * 1024;
#define ATT_ISSUE16(s, sv) do { const unsigned s_ = (unsigned)(s), sv_ = (unsigned)(sv); \
        glds16x5(ok0, ok1, orr, ov0, ov1, kp, rp, vp, (unsigned)__builtin_amdgcn_readfirstlane(dk0 + s_ * KN_SLOT), (unsigned)__builtin_amdgcn_readfirstlane(dr + s_ * KR_SLOT), (unsigned)__builtin_amdgcn_readfirstlane(dv0 + sv_ * V_SLOT)); \
        kp += tstepB; rp += 64 * 64 * 2; vp += tstepB; } while (0)
    const bool lead = wid < 4;
    ATT_ISSUE16(0, 0); if (NT > 1) ATT_ISSUE16(1, 1); if (!lead && NT > 2) ATT_ISSUE16(2, 2);
    bf16x8 qf[2][6];
#pragma unroll
    for (int qg = 0; qg < 2; ++qg)
#pragma unroll
        for (int s = 0; s < 6; ++s) qf[qg][s] = *(const bf16x8*)(Qw + (size_t)(16 * qg + qi) * ldq + 32 * s + 8 * g);
#pragma unroll
    for (int qg = 0; qg < 2; ++qg)
#pragma unroll
        for (int s = 0; s < 6; ++s) asm volatile("" : "+v"(qf[qg][s]));
    constexpr float THR = 8.f;
    float m_reg[2] = {0.f, 0.f};
    f32x4a ol[2]; ol[0] = (f32x4a){0.f, 0.f, 0.f, 0.f}; ol[1] = ol[0];
    const short one_ = qi == 0 ? (short)0x3F80 : (short)0; const bf16x8 onesb = (bf16x8){one_, one_, one_, one_, one_, one_, one_, one_};
    f32x4a negm[2]; negm[0] = (f32x4a){0.f, 0.f, 0.f, 0.f}; negm[1] = negm[0]; asm volatile("" : "+v"(negm[0]), "+v"(negm[1]));
    f32x4a o[2][8];
#pragma unroll
    for (int qg = 0; qg < 2; ++qg)
#pragma unroll
        for (int dg = 0; dg < 8; ++dg) o[qg][dg] = (f32x4a){0.f, 0.f, 0.f, 0.f};
    const ATT_LAS unsigned char* kn0 = shm + KN_OFF; const ATT_LAS unsigned char* kr0 = shm + KR_OFF;
    const int vb0 = (int)(lds0 + V_OFF) + v16_rd_base(lane);
    int v_cur = 0, v_n2 = 2;
    bf16x8 pq1[2]; pq1[0] = (bf16x8){0, 0, 0, 0, 0, 0, 0, 0}; pq1[1] = pq1[0];
    ATT_WAIT_BAR(0);
    if (wid >= 4) asm volatile("s_barrier" ::: "memory");
    auto tile = [&](auto ks_, const int j) __attribute__((always_inline)) {
        constexpr int KS = decltype(ks_)::value;
        ATT_SBAR();
        if (j > 0) pv_half16<1>(o, ol, onesb, vb0 + ((v_cur + 3) & 3) * V_SLOT, pq1[0], pq1[1]);
        ATT_SBAR();
        f32x4a c[4][2];
        { const ATT_LAS unsigned char* kb = kn0 + KS * KN_SLOT; const ATT_LAS unsigned char* rb = kr0 + KS * KR_SLOT;
#define ATT_KF16(i_) (((i_) >> 2) < 4 ? *(const ATT_LAS bf16x8*)(kb + kn_byte(16 * ((i_) & 3) + qi, 4 * ((i_) >> 2) + g)) : *(const ATT_LAS bf16x8*)(rb + kr_byte(16 * ((i_) & 3) + qi, 4 * (((i_) >> 2) - 4) + g)))
          bf16x8 kf[24 + 4];
          kf[0] = ATT_KF16(0); kf[1] = ATT_KF16(1); kf[2] = ATT_KF16(2); kf[3] = ATT_KF16(3);
#pragma unroll
          for (int i = 0; i < 24; ++i) { const int s = i >> 2, kg = i & 3;
              if (i + 4 < 24) kf[i + 4] = ATT_KF16(i + 4);
              ATT_SBAR();
              if (s == 0) { c[kg][0] = __builtin_amdgcn_mfma_f32_16x16x32_bf16(kf[i], qf[0][0], negm[0], 0, 0, 0); c[kg][1] = __builtin_amdgcn_mfma_f32_16x16x32_bf16(kf[i], qf[1][0], negm[1], 0, 0, 0); }
              else { c[kg][0] = __builtin_amdgcn_mfma_f32_16x16x32_bf16(kf[i], qf[0][s], c[kg][0], 0, 0, 0); c[kg][1] = __builtin_amdgcn_mfma_f32_16x16x32_bf16(kf[i], qf[1][s], c[kg][1], 0, 0, 0); }
              ATT_SBAR();
          }
#undef ATT_KF16
        }
        ATT_SBAR();
        if (lead) asm volatile("s_waitcnt lgkmcnt(0)\n\ts_barrier" ::: "memory"); else if (j + 2 < NT) { ATT_WAIT_BAR(PIECES); } else { ATT_WAIT_BAR(0); }
        ATT_SBAR();
        if (lead) { if (j + 2 < NT) ATT_ISSUE16((KS + 2) % 3, v_n2); } else { if (j + 3 < NT) ATT_ISSUE16(KS, (v_cur + 3) & 3); }
        ATT_SBAR();
        asm volatile("s_nop 7\n\ts_nop 7" ::: "memory");
        float mx[2], mxx;
        { float a_, b_;
          asm volatile("v_max3_f32 %0, %2, %3, %4\n\tv_max3_f32 %1, %5, %6, %7\n\tv_max3_f32 %0, %0, %8, %9\n\tv_max3_f32 %1, %1, %10, %11\n\tv_max3_f32 %0, %0, %12, %13\n\tv_max3_f32 %1, %1, %14, %15\n\t"
                       "v_max3_f32 %0, %0, %16, %17\n\tv_max_f32_e32 %0, %0, %1"
                       : "=&v"(a_), "=&v"(b_)
                       : "v"(c[0][0][0]), "v"(c[0][0][1]), "v"(c[0][0][2]), "v"(c[0][0][3]), "v"(c[1][0][0]), "v"(c[1][0][1]), "v"(c[1][0][2]), "v"(c[1][0][3]),
                         "v"(c[2][0][0]), "v"(c[2][0][1]), "v"(c[2][0][2]), "v"(c[2][0][3]), "v"(c[3][0][0]), "v"(c[3][0][1]), "v"(c[3][0][2]), "v"(c[3][0][3]));
          mx[0] = a_; }
        { float a_, b_, m_;
          asm volatile("v_max3_f32 %0, %3, %4, %5\n\tv_max3_f32 %1, %6, %7, %8\n\tv_max3_f32 %0, %0, %9, %10\n\tv_max3_f32 %1, %1, %11, %12\n\tv_max3_f32 %0, %0, %13, %14\n\tv_max3_f32 %1, %1, %15, %16\n\t"
                       "v_max3_f32 %0, %0, %17, %18\n\tv_max_f32_e32 %0, %0, %1\n\tv_max_f32_e32 %2, %0, %19"
                       : "=&v"(a_), "=&v"(b_), "=&v"(m_)
                       : "v"(c[0][1][0]), "v"(c[0][1][1]), "v"(c[0][1][2]), "v"(c[0][1][3]), "v"(c[1][1][0]), "v"(c[1][1][1]), "v"(c[1][1][2]), "v"(c[1][1][3]),
                         "v"(c[2][1][0]), "v"(c[2][1][1]), "v"(c[2][1][2]), "v"(c[2][1][3]), "v"(c[3][1][0]), "v"(c[3][1][1]), "v"(c[3][1][2]), "v"(c[3][1][3]), "v"(mx[0]));
          mx[1] = a_; mxx = m_; }
        if (j == 0 || __any(mxx > THR)) {
#pragma unroll
            for (int qg = 0; qg < 2; ++qg) {
                const float rmx = xmax32(xmax16(mx[qg]));
                const float dl = (j == 0) ? rmx : __builtin_fmaxf(rmx, 0.f); m_reg[qg] += dl;
#pragma unroll
                for (int kg = 0; kg < 4; ++kg) c[kg][qg] = c[kg][qg] - dl;
                negm[qg] = (f32x4a){-m_reg[qg], -m_reg[qg], -m_reg[qg], -m_reg[qg]}; asm volatile("" : "+v"(negm[qg]));
                const float f = __builtin_amdgcn_exp2f(-dl);
                if (j != 0 && g == 0) wsf[16 * qg + qi] = f; }
            if (j != 0) { asm volatile("s_waitcnt lgkmcnt(0)" ::: "memory");
#pragma unroll
                for (int qg = 0; qg < 2; ++qg) { const f32x4a a = *(const ATT_LAS f32x4a*)(wsf + 16 * qg + 4 * g);
#pragma unroll
                    for (int dg = 0; dg < 8; ++dg) o[qg][dg] = o[qg][dg] * a;
                    ol[qg] = ol[qg] * a; }
                asm volatile("s_waitcnt lgkmcnt(0)" ::: "memory"); }
        }
        bf16x8 pa[2][2];
        { unsigned wq[16];
#define ATT_CREF(f_) c[((f_) >> 2) & 3][(f_) >> 4][(f_) & 3]
#define ATT_EX(f_) asm volatile("v_exp_f32_e32 %0, %0" : "+v"(ATT_CREF(f_)))
#define ATT_CV(k_) asm volatile("v_cvt_pk_bf16_f32 %0, %1, %2" : "=v"(wq[k_]) : "v"(ATT_CREF(2 * (k_))), "v"(ATT_CREF(2 * (k_) + 1)))
#define ATT_E8(b_) ATT_EX((b_)); ATT_EX((b_) + 1); ATT_EX((b_) + 2); ATT_EX((b_) + 3); ATT_EX((b_) + 4); ATT_EX((b_) + 5); ATT_EX((b_) + 6); ATT_EX((b_) + 7)
#define ATT_C8(b_) ATT_CV((b_)); ATT_CV((b_) + 1); ATT_CV((b_) + 2); ATT_CV((b_) + 3); ATT_CV((b_) + 4); ATT_CV((b_) + 5); ATT_CV((b_) + 6); ATT_CV((b_) + 7)
          ATT_E8(0); ATT_E8(8); ATT_C8(0); ATT_E8(16); ATT_E8(24); ATT_C8(8);
#undef ATT_C8
#undef ATT_E8
#define ATT_STEP(k_) (void)0
#undef ATT_STEP
#undef ATT_CV
#undef ATT_EX
#undef ATT_CREF
#pragma unroll
          for (int qg = 0; qg < 2; ++qg)
#pragma unroll
              for (int t = 0; t < 2; ++t) { u32x4 w = {wq[8 * qg + 4 * t], wq[8 * qg + 4 * t + 1], wq[8 * qg + 4 * t + 2], wq[8 * qg + 4 * t + 3]}; pa[qg][t] = __builtin_bit_cast(bf16x8, w); } }
        ATT_SBAR();
        pv_half16<0>(o, ol, onesb, vb0 + v_cur * V_SLOT, pa[0][0], pa[1][0]);
        pq1[0] = pa[0][1]; pq1[1] = pa[1][1];
        ATT_SBAR();
        if (!lead) asm volatile("s_waitcnt lgkmcnt(0)\n\ts_barrier" ::: "memory"); else if (j + 2 < NT) { ATT_WAIT_BAR(PIECES); } else { ATT_WAIT_BAR(0); }
        ATT_SBAR();
        v_cur = (v_cur + 1) & 3; v_n2 = (v_n2 + 1) & 3;
    };
    { int j = 0;
      for (; j + 3 <= NT; j += 3) { tile(std::integral_constant<int, 0>{}, j); tile(std::integral_constant<int, 1>{}, j + 1); tile(std::integral_constant<int, 2>{}, j + 2); }
      if (j < NT) { tile(std::integral_constant<int, 0>{}, j); ++j; if (j < NT) tile(std::integral_constant<int, 1>{}, j); } }
    if (wid < 4) asm volatile("s_barrier" ::: "memory");
    pv_half16<1>(o, ol, onesb, vb0 + ((v_cur + 3) & 3) * V_SLOT, pq1[0], pq1[1]);
    asm volatile("s_waitcnt lgkmcnt(0)\n\ts_barrier" ::: "memory");
    if (qi == 0) { *(ATT_LAS f32x4a*)(wsf + 32 + 4 * g) = ol[0]; *(ATT_LAS f32x4a*)(wsf + 48 + 4 * g) = ol[1]; }
    asm volatile("s_waitcnt lgkmcnt(0)" ::: "memory");
#pragma unroll
    for (int qg = 0; qg < 2; ++qg) { const f32x4a lv = *(const ATT_LAS f32x4a*)(wsf + 32 + 16 * qg + 4 * g);
#pragma unroll
        for (int r = 0; r < 4; ++r) { const float rl = __builtin_amdgcn_rcpf(lv[r]);
#pragma unroll
            for (int dg = 0; dg < 8; ++dg) { const unsigned w = cvtpk(o[qg][dg][r] * rl, 0.f); Ow[(size_t)(16 * qg + 4 * g + r) * ldo + 16 * dg + qi] = (bf16_t)(w & 0xffffu); } } }
    asm volatile("s_waitcnt lgkmcnt(0)" ::: "memory");
#undef ATT_ISSUE16
}
#undef ATT_WAIT_BAR
#undef ATT_SBAR
}
#define GAS __attribute__((address_space(1)))
#define LAS __attribute__((address_space(3)))
typedef unsigned short bf16;
typedef unsigned v4u __attribute__((ext_vector_type(4)));
typedef float f32x4 __attribute__((ext_vector_type(4)));
typedef short bf16x8 __attribute__((ext_vector_type(8)));
typedef GAS unsigned gu32;
typedef GAS unsigned long long gu64;
#define RLX_AGENT __ATOMIC_RELAXED, __HIP_MEMORY_SCOPE_AGENT
#define LDS_WAIT() asm volatile("s_waitcnt lgkmcnt(0)" ::: "memory")
#define VM_WAIT() asm volatile("s_waitcnt vmcnt(0)" ::: "memory")
__device__ __forceinline__ unsigned long long rt() { return __builtin_amdgcn_s_memrealtime(); }
__device__ __forceinline__ unsigned f2bf(float f) { unsigned u = __builtin_bit_cast(unsigned, f); return (u + 0x7fffu + ((u >> 16) & 1u)) >> 16; }
__device__ __forceinline__ unsigned pk2(float lo, float hi) { return f2bf(lo) | (f2bf(hi) << 16); }

#define XB_TMO      128
#define XB_XCNT(j)  (256  + 64 * (j))
#define XB_XSUB(j)  (1280 + 64 * (j))
#define XB_XGEN(j)  (2304 + 64 * (j))
#define XB_TOP      3328
#define XB_TOPGEN   3392
#define XCD_BAR_WORDS 3456
#define XB_SPIN_CAP (1u << 18)

__device__ __forceinline__ unsigned xb_ld(unsigned* p)              { return __hip_atomic_load(p, __ATOMIC_RELAXED, __HIP_MEMORY_SCOPE_AGENT); }
__device__ __forceinline__ unsigned xb_add(unsigned* p, unsigned v) { return __hip_atomic_fetch_add(p, v, __ATOMIC_RELAXED, __HIP_MEMORY_SCOPE_AGENT); }
__device__ __forceinline__ unsigned xb_xcc_id() { return (unsigned)__builtin_amdgcn_s_getreg((3 << 11) | 20) & 0xFu; }
#define XB_SPIN(cond, bar) do { unsigned _sp = 0; while (cond) { __builtin_amdgcn_s_sleep(1); \
    if ((++_sp & 255u) == 0u) { if (xb_ld(&(bar)[XB_TMO])) break; if (_sp > XB_SPIN_CAP) { atomicAdd(&(bar)[XB_TMO], 1u); break; } } } } while (0)

struct XcdBarrier {
    unsigned* bar; unsigned x;
    volatile LAS unsigned* st;
};

__device__ __forceinline__ XcdBarrier xcd_barrier_post(unsigned* bar, volatile LAS unsigned* st) {
    XcdBarrier b; b.bar = bar; b.x = xb_xcc_id(); b.st = st;
    if (threadIdx.x == 0) (void)xb_add(&bar[XB_XCNT(b.x)], 1u);
    return b;
}
__device__ __forceinline__ void xcd_barrier_complete(unsigned* bar, unsigned x, unsigned& nloc, unsigned& nx) {
    const unsigned G = gridDim.x * gridDim.y * gridDim.z;
    unsigned sum, cnt, mine, sp = 0u;
    for (;;) {
        sum = 0u; cnt = 0u; mine = 0u;
#pragma unroll
        for (unsigned j = 0; j < 16; ++j) { const unsigned c = xb_ld(&bar[XB_XCNT(j)]); sum += c; cnt += (c > 0u) ? 1u : 0u; mine = (j == x) ? c : mine; }
        if (sum == G) break;
        __builtin_amdgcn_s_sleep(1);
        if ((++sp & 255u) == 0u) { if (xb_ld(&bar[XB_TMO])) break; if (sp > XB_SPIN_CAP) { atomicAdd(&bar[XB_TMO], 1u); break; } }
    }
    nloc = mine > 0u ? mine : 1u; nx = cnt > 0u ? cnt : 1u;
}

__device__ __forceinline__ void xcd_barrier(const XcdBarrier& b) {
    asm volatile("s_waitcnt vmcnt(0)" ::: "memory");
    __syncthreads();
    if (threadIdx.x == 0) {
        unsigned* bar = b.bar;
        __builtin_amdgcn_s_waitcnt(0);
        unsigned nloc = b.st[0], nx = b.st[1];
        if (nloc == 0u) { xcd_barrier_complete(bar, b.x, nloc, nx); b.st[0] = nloc; b.st[1] = nx; }
        const unsigned old = xb_add(&bar[XB_XSUB(b.x)], 1u);
        const unsigned gen = old / nloc;
        if (old + 1u == (gen + 1u) * nloc) {
            __builtin_amdgcn_fence(__ATOMIC_RELEASE, "agent");
            asm volatile("s_waitcnt vmcnt(0)" ::: "memory");
            const unsigned og = xb_add(&bar[XB_TOP], 1u);
            const unsigned tg = og / nx;
            if (og + 1u == (tg + 1u) * nx) xb_add(&bar[XB_TOPGEN], 1u);
            else XB_SPIN(xb_ld(&bar[XB_TOPGEN]) == tg, bar);
            __builtin_amdgcn_fence(__ATOMIC_ACQUIRE, "agent");
            xb_add(&bar[XB_XGEN(b.x)], 1u);
            asm volatile("s_waitcnt vmcnt(0)" ::: "memory");
        } else {
            XB_SPIN(xb_ld(&bar[XB_XGEN(b.x)]) == gen, bar);
            __builtin_amdgcn_fence(__ATOMIC_ACQUIRE, "agent");
            asm volatile("s_waitcnt vmcnt(0)" ::: "memory");
        }
    }
    __syncthreads();
}

constexpr int NWAVES = 8;
constexpr int T = 24576, TP = 16384, DM = 2048, DFF = 8192, PLE = 256, DEPTH = 4;
constexpr int LATN = 1280;
constexpr float EPS = 1e-6f;
constexpr int MCH = 8192, NCH = 3;
constexpr size_t MiB = 1u << 20;
constexpr size_t WS_CTL = 0, CTL_ZERO_BYTES = 1 * MiB;
constexpr size_t WS_ROT = 1 * MiB;
constexpr size_t WS_BT = 5 * MiB;
constexpr size_t WS_STAT = 6 * MiB;
constexpr size_t SS_XIN = WS_STAT, SS_X2 = WS_STAT + 128 * 1024, SS_E = WS_STAT + 256 * 1024, PS_Q = WS_STAT + 1 * MiB, PS_KV = WS_STAT + 2 * MiB, PS_H = WS_STAT + 3 * MiB, PS_E = WS_STAT + 6 * MiB, PS_X = WS_STAT + 9 * MiB;
constexpr size_t WS_W = 18 * MiB;
constexpr size_t W_MLA = 20 * MiB, W_SWA = 20 * MiB, W_LAYER = 73 * MiB;
constexpr size_t WO_WD = 0, WO_WUQ = 5 * MiB, WO_WUKV = 8 * MiB, WO_WOM = 12 * MiB;
constexpr size_t WO_WQKV = 0, WO_WOS = 12 * MiB;
constexpr size_t WO_UP = 0, WO_DN = 32 * MiB, WO_PU = 64 * MiB, WO_G = 65 * MiB;
constexpr size_t WS_WMLA = WS_W, WS_WSWA = WS_WMLA + 2 * W_MLA, WS_WLAY = WS_WSWA + 2 * W_SWA, WS_WEND = WS_WLAY + 4 * W_LAYER;
constexpr size_t WS_PB = WS_WEND;
constexpr size_t WS_XB = WS_PB + 12 * MiB;
constexpr size_t WS_H = WS_XB + 96 * MiB;
constexpr size_t WS_CQ = WS_H, WS_CKV = WS_H + 24 * MiB;
constexpr size_t WS_R = WS_H + 96 * MiB;
constexpr size_t WS_E = WS_R, WS_HID = WS_R + 96 * MiB;
constexpr size_t WS_Q = WS_R, WS_KV = WS_R + 144 * MiB, WS_KR = WS_KV + 192 * MiB;
constexpr size_t WS_QKV = WS_R;
constexpr size_t WS_XB1_UNUSED = WS_R + 144 * MiB;
constexpr size_t WS_END = WS_KR + 3 * MiB;
static_assert(PS_X + (size_t)T * 32 * 4 <= WS_W && WS_HID + 128 * MiB <= WS_END && WS_END <= 1000 * MiB, "d_ws map");
constexpr int CW_BAR = 4096;
constexpr int RING_OFF = 0, RING_BYTES = 131072;
constexpr int LDSCTL_OFF = 143360, MISC_OFF = LDSCTL_OFF + 320;
constexpr int LDS_BYTES = 147456;
static_assert(MISC_OFF + 128 <= LDS_BYTES && att::ATT_LDS_BYTES <= LDSCTL_OFF && RING_BYTES <= LDSCTL_OFF, "LDS map");

__device__ __forceinline__ float wave_sum(float v) {
#pragma unroll
    for (int o = 1; o < 64; o <<= 1) v += __shfl_xor(v, o);
    return v;
}
__device__ __forceinline__ float sq4(f32x4 v) { return (v.x * v.x + v.y * v.y) + (v.z * v.z + v.w * v.w); }
typedef unsigned u32x2 __attribute__((ext_vector_type(2)));
typedef unsigned u32x4 __attribute__((ext_vector_type(4)));
__device__ __forceinline__ u32x2 pk4(f32x4 v) { u32x2 r; r.x = pg8::cvt_pk_bf16(v.x, v.y); r.y = pg8::cvt_pk_bf16(v.z, v.w); return r; }
__device__ __forceinline__ f32x4 unpk4(u32x2 w) { f32x4 e; e.x = __uint_as_float(w.x << 16); e.y = __uint_as_float(w.x & 0xffff0000u); e.z = __uint_as_float(w.y << 16); e.w = __uint_as_float(w.y & 0xffff0000u); return e; }

__device__ __forceinline__ int cmap(int mode, int n) {
    if (mode == 1) { if (n < 1024) return n; if (n >= 1088) return -1; const int r = n - 1024; return 1024 + (r >> 1) + 32 * (r & 1); }
    if (mode == 2) { const int h = n / 192, r = n % 192; if (r < 128) return n; const int q = r - 128; return h * 192 + 128 + (q >> 1) + 32 * (q & 1); }
    return n;
}
__device__ __forceinline__ void p0_transpose_item(const float* W, int K, int Nsrc, int Ndst, bf16* WT, int mode, const float* gain, LAS float* scr, int item, int lane) {
    const int nblk = Ndst / 32, kb = item / nblk, nb = item % nblk, k0 = 64 * kb, n0 = 32 * nb;
    const int sc = cmap(mode, n0 + (lane & 31));
#pragma unroll 8
    for (int i = 0; i < 32; ++i) { const int kk = 2 * i + (lane >> 5); scr[kk * 33 + (lane & 31)] = sc >= 0 ? W[(size_t)(k0 + kk) * Nsrc + sc] * (gain ? gain[k0 + kk] : 1.f) : 0.f; }
    LDS_WAIT(); asm volatile("" ::: "memory");
    const int c = lane & 7;
#pragma unroll
    for (int j = 0; j < 4; ++j) { const int n = (lane >> 3) + 8 * j; const LAS float* s = scr + (8 * c) * 33 + n;
        v4u o; o.x = pk2(s[0 * 33], s[1 * 33]); o.y = pk2(s[2 * 33], s[3 * 33]); o.z = pk2(s[4 * 33], s[5 * 33]); o.w = pk2(s[6 * 33], s[7 * 33]);
        *(GAS v4u*)(WT + (size_t)(n0 + n) * K + k0 + 8 * c) = o; }
    LDS_WAIT(); asm volatile("" ::: "memory");
}
__device__ __forceinline__ void p0_fast_item(const float* W, int K, int N, bf16* WT, const float* gain, LAS unsigned char* scr, int item, int lane) {
    const int nblk = N / 64, kb = item / nblk, nb = item % nblk, k0 = 64 * kb, n0 = 64 * nb, q = lane & 15, g = lane >> 4;
    f32x4 a[8], b[8];
    const float* src = W + (size_t)(k0 + 2 * g) * N + n0 + 4 * q;
#pragma unroll
    for (int i = 0; i < 8; ++i) { a[i] = *(const f32x4*)(src + (size_t)(8 * i) * N); b[i] = *(const f32x4*)(src + (size_t)(8 * i + 1) * N); }
    if (gain) {
#pragma unroll
        for (int i = 0; i < 8; ++i) { const float ga = gain[k0 + 8 * i + 2 * g], gb = gain[k0 + 8 * i + 2 * g + 1]; a[i] = a[i] * ga; b[i] = b[i] * gb; } }
#pragma unroll
    for (int i = 0; i < 8; ++i)
#pragma unroll
        for (int e = 0; e < 4; ++e) *(LAS unsigned*)(scr + (4 * q + e) * 128 + ((i ^ (q & 7)) << 4) + 4 * g) = pg8::cvt_pk_bf16(a[i][e], b[i][e]);
    LDS_WAIT(); asm volatile("" ::: "memory");
    const int c = lane & 7;
#pragma unroll
    for (int j = 0; j < 8; ++j) { const int n = (lane >> 3) + 8 * j; const v4u v = *(const LAS v4u*)(scr + n * 128 + ((c ^ ((n >> 2) & 7)) << 4));
        *(GAS v4u*)(WT + (size_t)(n0 + n) * K + k0 + 8 * c) = v; }
    LDS_WAIT(); asm volatile("" ::: "memory");
}

template <int R> __device__ __forceinline__ void thin_c_rows(int m0, int stride, int lane, const bf16* XB1, const float* g1, bf16* XB, const bf16* H,
                                                             const float* psh, float* ssx2, const float* pp, const float* psm, bf16* PB) {
    u32x4 hw[R][4], xw[R][4]; float ph[R]; f32x4 pv_[R];
#pragma unroll
    for (int rr = 0; rr < R; ++rr) { const int m = m0 + rr * stride; const bf16* hr = H + (size_t)m * DM; const bf16* xr = XB1 + (size_t)m * DM;
#pragma unroll
        for (int q = 0; q < 4; ++q) { hw[rr][q] = *(const u32x4*)(hr + 512 * q + 8 * lane); xw[rr][q] = *(const u32x4*)(xr + 512 * q + 8 * lane); }
        ph[rr] = lane < 32 ? psh[(size_t)m * 32 + lane] : 0.f;
        const float* pr = m < TP ? pp + (size_t)m * PLE : psm + (size_t)(m - TP) * PLE; pv_[rr] = *(const f32x4*)(pr + 4 * lane); }
#pragma unroll
    for (int rr = 0; rr < R; ++rr) { const int m = m0 + rr * stride;
        const float rh = __builtin_amdgcn_rsqf(wave_sum(ph[rr]) * (1.0f / DM) + EPS); float sx = 0.f;
        f32x4 v[4][2];
#pragma unroll
        for (int q = 0; q < 4; ++q) {
            v[q][0] = unpk4((u32x2){xw[rr][q].x, xw[rr][q].y}) + unpk4((u32x2){hw[rr][q].x, hw[rr][q].y}) * rh * *(const f32x4*)(g1 + 512 * q + 8 * lane);
            v[q][1] = unpk4((u32x2){xw[rr][q].z, xw[rr][q].w}) + unpk4((u32x2){hw[rr][q].z, hw[rr][q].w}) * rh * *(const f32x4*)(g1 + 512 * q + 8 * lane + 4);
            sx += sq4(v[q][0]) + sq4(v[q][1]); }
        sx = wave_sum(sx); if (lane == 0) ssx2[m] = sx;
        { const float rx = __builtin_amdgcn_rsqf(sx * (1.0f / DM) + EPS);
#pragma unroll
          for (int q = 0; q < 4; ++q) { const u32x2 lo = pk4(v[q][0] * rx), hi = pk4(v[q][1] * rx); *(u32x4*)(XB + (size_t)m * DM + 512 * q + 8 * lane) = (u32x4){lo.x, lo.y, hi.x, hi.y}; } }
        *(u32x2*)(PB + (size_t)m * PLE + 4 * lane) = pk4(pv_[rr]); }
}
template <int R> __device__ __forceinline__ void thin_d_rows(int m0, int stride, int lane, const float* g3, bf16* XB, const bf16* H, const float* psh, const float* pse, float* sse, const float* ssx2) {
    u32x4 xw[R][4], hw[R][4]; float ph[R], pe[R], sx2[R];
#pragma unroll
    for (int rr = 0; rr < R; ++rr) { const int m = m0 + rr * stride; const bf16* hr = H + (size_t)m * DM; const bf16* xr = XB + (size_t)m * DM;
#pragma unroll
        for (int q = 0; q < 4; ++q) { hw[rr][q] = *(const u32x4*)(hr + 512 * q + 8 * lane); xw[rr][q] = *(const u32x4*)(xr + 512 * q + 8 * lane); }
        ph[rr] = lane < 32 ? psh[(size_t)m * 32 + lane] : 0.f; pe[rr] = lane < 32 ? pse[(size_t)m * 32 + lane] : 0.f; sx2[rr] = ssx2[m]; }
#pragma unroll
    for (int rr = 0; rr < R; ++rr) { const int m = m0 + rr * stride; bf16* xr = XB + (size_t)m * DM;
        const float rh = __builtin_amdgcn_rsqf(wave_sum(ph[rr]) * (1.0f / DM) + EPS);
        { const float se = wave_sum(pe[rr]); if (lane == 0) sse[m] = se; }
        const float ux = __builtin_sqrtf(sx2[rr] * (1.0f / DM) + EPS);
#pragma unroll
        for (int q = 0; q < 4; ++q) {
            const u32x2 lo = pk4(unpk4((u32x2){xw[rr][q].x, xw[rr][q].y}) * ux + unpk4((u32x2){hw[rr][q].x, hw[rr][q].y}) * rh * *(const f32x4*)(g3 + 512 * q + 8 * lane));
            const u32x2 hi = pk4(unpk4((u32x2){xw[rr][q].z, xw[rr][q].w}) * ux + unpk4((u32x2){hw[rr][q].z, hw[rr][q].w}) * rh * *(const f32x4*)(g3 + 512 * q + 8 * lane + 4));
            *(u32x4*)(xr + 512 * q + 8 * lane) = (u32x4){lo.x, lo.y, hi.x, hi.y}; } }
}

struct Args { const float* in[20]; float* out; unsigned char* ws; };
#define ZERO() ({ int z__; asm volatile("s_mov_b32 %0, 0" : "=s"(z__)); z__; })
#define WSP(T_, off) ((T_*)(args.ws + (size_t)(off) + (size_t)ZERO()))
#define INP(k) (args.in[(k) + ZERO()])
__global__ void __launch_bounds__(NWAVES * 64, 2) trunk_fwd(Args args) {
    extern __shared__ __attribute__((aligned(16))) unsigned char lds_raw[];
    LAS unsigned char* lds = (LAS unsigned char*)lds_raw;
    volatile LAS unsigned* MISC = (volatile LAS unsigned*)(lds + MISC_OFF);
    const int tid = threadIdx.x, lane0 = tid & 63, wave = __builtin_amdgcn_readfirstlane(tid >> 6);
#define LANE_DECL() int lane = lane0; asm volatile("" : "+v"(lane)); int gwl = gw; asm volatile("" : "+s"(gwl))
    const int G = gridDim.x; const int bx = blockIdx.x; const int vcu = (G % 8 == 0) ? (bx % 8) * (G / 8) + bx / 8 : bx;
    for (int u = tid; u < (LDS_BYTES - LDSCTL_OFF) / 4; u += NWAVES * 64) ((LAS unsigned*)(lds + LDSCTL_OFF))[u] = 0u;
    __syncthreads();
    XcdBarrier bar = xcd_barrier_post((unsigned*)(args.ws + WS_CTL) + CW_BAR, MISC + 8);
#define GRID_BAR() xcd_barrier(bar)
    const int gw = vcu * NWAVES + wave, NGW = G * NWAVES;
    constexpr float QSCALE = 0.07216878364870322f * 1.4426950408889634f;

    {
        LANE_DECL(); LAS unsigned char* scr8 = lds + RING_OFF + wave * 16384; LAS float* scr = (LAS float*)scr8;
        unsigned char* ws = args.ws;
        int rot_ = 0;
#define CVT(Wsrc, K_, Nsrc_, Ndst_, dst_, mode_, gain_) do { const int nit_ = ((K_) / 64) * ((Ndst_) / 32); \
            for (int it_ = (gwl + NGW - rot_) % NGW; it_ < nit_; it_ += NGW) p0_transpose_item((Wsrc), (K_), (Nsrc_), (Ndst_), (dst_), (mode_), (gain_), scr, it_, lane); rot_ = (rot_ + nit_) % NGW; } while (0)
#define CVTF(Wsrc, K_, N_, dst_, gain_) do { const int nit_ = ((K_) / 64) * ((N_) / 64); \
            for (int it_ = (gwl + NGW - rot_) % NGW; it_ < nit_; it_ += NGW) p0_fast_item((Wsrc), (K_), (N_), (dst_), (gain_), scr8, it_, lane); rot_ = (rot_ + nit_) % NGW; } while (0)
        const float* gains = args.in[4];
        for (int j = 0; j < 2; ++j) {
            unsigned char* wm = ws + WS_WMLA + j * W_MLA; unsigned char* wsw = ws + WS_WSWA + j * W_SWA;
            CVT(args.in[5] + (size_t)j * DM * 1088, DM, 1088, LATN, (bf16*)(wm + WO_WD), 1, gains + (size_t)(2 * j * 4 + 0) * DM);
            CVT(args.in[8] + (size_t)j * 512 * 3072, 512, 3072, 3072, (bf16*)(wm + WO_WUQ), 2, args.in[6] + j * 512);
            CVTF(args.in[9] + (size_t)j * 512 * 4096, 512, 4096, (bf16*)(wm + WO_WUKV), args.in[7] + j * 512);
            CVTF(args.in[10] + (size_t)j * DM * DM, DM, DM, (bf16*)(wm + WO_WOM), (const float*)nullptr);
            CVTF(args.in[11] + (size_t)j * DM * 3072, DM, 3072, (bf16*)(wsw + WO_WQKV), gains + (size_t)((2 * j + 1) * 4 + 0) * DM);
            CVTF(args.in[13] + (size_t)j * DM * DM, DM, DM, (bf16*)(wsw + WO_WOS), (const float*)nullptr);
        }
        for (int L = 0; L < DEPTH; ++L) {
            unsigned char* wl = ws + WS_WLAY + L * W_LAYER;
            CVTF(args.in[15] + (size_t)L * DM * DFF, DM, DFF, (bf16*)(wl + WO_UP), gains + (size_t)(L * 4 + 2) * DM);
            CVTF(args.in[16] + (size_t)L * DFF * DM, DFF, DM, (bf16*)(wl + WO_DN), (const float*)nullptr);
            CVTF(args.in[17] + (size_t)L * PLE * DM, PLE, DM, (bf16*)(wl + WO_PU), (const float*)nullptr);
            CVTF(args.in[18] + (size_t)L * DM * DM, DM, DM, (bf16*)(wl + WO_G), (const float*)nullptr);
        }
#undef CVT
#undef CVTF
        float* rot = (float*)(ws + WS_ROT);
        for (int i = vcu * (NWAVES * 64) + tid; i < 16384 * 32; i += G * NWAVES * 64) {
            const int pos = i >> 5, d = i & 31; double inv = 1.0; for (int k = 0; k < d; ++k) inv *= 0.74989420933245582730;
            const double turns = (double)pos * inv * 0.15915494309189533577; const float fr = (float)(turns - __builtin_rint(turns));
            rot[2 * i] = __builtin_amdgcn_cosf(fr); rot[2 * i + 1] = __builtin_amdgcn_sinf(fr);
        }
        float* btg = (float*)(ws + WS_BT);
        for (int i = vcu * (NWAVES * 64) + tid; i < 16 * att::BT_STRIDE; i += G * NWAVES * 64) {
            const int h = i / att::BT_STRIDE, idx = i % att::BT_STRIDE, rel = idx - att::BT_ZERO, n = rel < 0 ? -rel : rel;
            int b = n < 8 ? n : 8 + (n >= 12) + (n >= 16) + (n >= 23) + (n >= 32) + (n >= 46) + (n >= 64) + (n >= 91); if (b > 15) b = 15; if (rel > 0) b += 16;
            btg[i] = n <= 128 ? args.in[14][b * 16 + h] * 1.4426950408889634f : -1e30f;
        }
    }
    { LANE_DECL(); const float* xin0 = INP(0); const float* xin1 = INP(1); bf16* XB = (bf16*)(args.out + ZERO()); float* ssx = WSP(float, SS_XIN);
      for (int m = gwl; m < T; m += NGW) {
        const float* xr = m < TP ? xin0 + (size_t)m * DM : xin1 + (size_t)(m - TP) * DM;
        f32x4 v[8]; float ss = 0.f;
#pragma unroll
        for (int q = 0; q < 8; ++q) { v[q] = *(const f32x4*)(xr + 256 * q + 4 * lane); ss += sq4(v[q]); }
        ss = wave_sum(ss);
#pragma unroll
        for (int q = 0; q < 8; ++q) *(u32x2*)(XB + (size_t)m * DM + 256 * q + 4 * lane) = pk4(v[q]);
        if (lane == 0) ssx[m] = ss;
      } }
    GRID_BAR();
    for (int L = 0; L < DEPTH; ++L) {
        const int j = L >> 1; const bool mla = (L & 1) == 0;
        if (mla) {
#ifndef DBG_NO_GEMM
            { pg8::Gemm g{(const bf16*)(args.out + ZERO()), WSP(bf16, WS_WMLA + j * W_MLA + WO_WD), T, LATN, DM}; pg8::StaticOrder S; S.init(T, LATN, G, bx + ZERO());
              pg8::EpiLat E{WSP(bf16, WS_CQ), WSP(bf16, WS_CKV), WSP(bf16, WS_KR), WSP(float, SS_XIN), WSP(float, PS_Q), WSP(float, PS_KV), WSP(float, WS_ROT)};
              pg8::gemm_phase<pg8::EpiLat, pg8::StaticOrder, true, true>(lds + RING_OFF, g, S, E);
            }
#endif
            GRID_BAR();
#ifndef DBG_NO_GEMM
            { pg8::Gemm g{WSP(bf16, WS_CQ), WSP(bf16, WS_WMLA + j * W_MLA + WO_WUQ), T, 3072, 512}; pg8::StaticOrder S; S.init(T, 3072, G, bx + ZERO()); pg8::EpiQRope E{WSP(bf16, WS_Q), 3072, WSP(float, WS_ROT), QSCALE, WSP(float, PS_Q)};
              pg8::gemm_phase<pg8::EpiQRope, pg8::StaticOrder, true, true>(lds + RING_OFF, g, S, E);
            }
            { pg8::Gemm g{WSP(bf16, WS_CKV), WSP(bf16, WS_WMLA + j * W_MLA + WO_WUKV), T, 4096, 512}; pg8::StaticOrder S; S.init(T, 4096, G, bx + ZERO());
              pg8::EpiBf16<0, 8, false> E{WSP(bf16, WS_KV), 4096, WSP(float, PS_KV), 1.0f / 512.0f, nullptr, 0};
              pg8::gemm_phase<pg8::EpiBf16<0, 8, false>, pg8::StaticOrder, true, true>(lds + RING_OFF, g, S, E);
            }
#endif
            GRID_BAR();
#ifndef DBG_NO_MLA
            { const bf16* QB = WSP(bf16, WS_Q); const bf16* KVB = WSP(bf16, WS_KV); const bf16* KRB = WSP(bf16, WS_KR); bf16* OB = WSP(bf16, WS_XB);
              for (int u = vcu; u < 1536; u += G) {
                int s0, S_, h, qb;
                if (u < 1024) { s0 = 0; S_ = TP; h = u >> 6; qb = u & 63; } else { const int v = u - 1024; s0 = TP + (v >> 8) * 4096; S_ = 4096; h = (v & 255) >> 4; qb = v & 15; }
                const int q0 = s0 + qb * 256 + wave * 32;
                att::attn_mla16(QB + (size_t)q0 * 3072 + h * 192, 3072, KVB + (size_t)s0 * 4096 + h * 256, KRB + (size_t)s0 * 64, KVB + (size_t)s0 * 4096 + h * 256 + 128, 4096,
                                OB + (size_t)q0 * DM + h * 128, DM, S_ / 64, lds + RING_OFF);
              } }
#endif
        } else {
#ifndef DBG_NO_GEMM
            { pg8::Gemm g{(const bf16*)(args.out + ZERO()), WSP(bf16, WS_WSWA + j * W_SWA + WO_WQKV), T, 3072, DM}; pg8::StaticOrder S; S.init(T, 3072, G, bx + ZERO());
              pg8::EpiBf16<0, 1, false> E{WSP(bf16, WS_QKV), 3072, WSP(float, SS_XIN), 1.0f / 2048.0f, nullptr, 0};
              pg8::gemm_phase<pg8::EpiBf16<0, 1, false>, pg8::StaticOrder, true, true>(lds + RING_OFF, g, S, E);
            }
#endif
            GRID_BAR();
#ifndef DBG_NO_SWA
            { LAS float* btl = (LAS float*)(lds + RING_OFF + att::BT_OFF); const float* btg = WSP(float, WS_BT);
              int tl = tid; asm volatile("" : "+v"(tl));
              for (int i = tl; i < 16 * att::BT_STRIDE; i += NWAVES * 64) btl[i] = btg[i];
              __syncthreads();
              const float* sink = INP(12) + j * 16; const bf16* QKV = WSP(bf16, WS_QKV); bf16* OB = WSP(bf16, WS_XB);
              for (int u = vcu; u < 1536; u += G) {
                  const int kvh = u / 384, rb = u % 384, q0 = rb * 64; int s0, S_;
                  if (q0 < TP) { s0 = 0; S_ = TP; } else { s0 = TP + ((q0 - TP) >> 12) * 4096; S_ = 4096; }
                  const int lo = max(q0 - 128, s0), hi_ = min(q0 + 192, s0 + S_), NT = (hi_ - lo) >> 6;
                  const int hq = kvh * 4 + (wave & 3), qw = q0 + 32 * (wave >> 2);
                  att::attn_unit<true>(QKV + (size_t)qw * 3072 + hq * 128, 3072, QKV + (size_t)lo * 3072 + 2048 + kvh * 128, nullptr, QKV + (size_t)lo * 3072 + 2560 + kvh * 128, 3072,
                                       OB + (size_t)qw * DM + hq * 128, DM, NT, lo - qw, 0.08838834764831845f * 1.4426950408889634f, sink[hq] * 1.4426950408889634f, lds + RING_OFF, btl + hq * att::BT_STRIDE);
              } }
#endif
        }
        GRID_BAR();
#ifndef DBG_NO_GEMM
        { const bf16* wo = mla ? WSP(bf16, WS_WMLA + j * W_MLA + WO_WOM) : WSP(bf16, WS_WSWA + j * W_SWA + WO_WOS);
          pg8::Gemm g{WSP(bf16, WS_XB), wo, T, DM, DM}; pg8::StaticOrder S; S.init(T, DM, G, bx + ZERO()); pg8::EpiBf16<0, 0, true> E{WSP(bf16, WS_H), DM, nullptr, 0.f, WSP(float, PS_H), 0};
          pg8::gemm_phase<pg8::EpiBf16<0, 0, true>, pg8::StaticOrder, true, true>(lds + RING_OFF, g, S, E);
        }
#endif
        GRID_BAR();
        { LANE_DECL(); const float* xin0 = INP(0); const float* xin1 = INP(1); const bf16* XB1 = (const bf16*)(args.out + ZERO()); const float* g1 = INP(4) + (size_t)(L * 4 + 1) * DM;
          bf16* XB = WSP(bf16, WS_XB); const bf16* H = WSP(bf16, WS_H); const float* psh = WSP(float, PS_H); float* ssx2 = WSP(float, SS_X2);
          const float* pp = INP(2) + (size_t)L * TP * PLE; const float* psm = INP(3) + (size_t)L * (T - TP) * PLE; bf16* PB = WSP(bf16, WS_PB);
          constexpr int RC = 2; int m0 = gwl;
          for (; m0 + (RC - 1) * NGW < T; m0 += RC * NGW) thin_c_rows<RC>(m0, NGW, lane, XB1, g1, XB, H, psh, ssx2, pp, psm, PB);
          for (; m0 < T; m0 += NGW) thin_c_rows<1>(m0, NGW, lane, XB1, g1, XB, H, psh, ssx2, pp, psm, PB);
        }
        GRID_BAR();
        for (int c = 0; c < NCH; ++c) {
#ifndef DBG_NO_GEMM
            { pg8::Gemm g{WSP(bf16, WS_XB) + (size_t)c * MCH * DM, WSP(bf16, WS_WLAY + L * W_LAYER + WO_UP), MCH, DFF, DM}; pg8::StaticOrder S; S.init(MCH, DFF, G, bx + ZERO());
              pg8::EpiBf16<1, 0, false> E{WSP(bf16, WS_HID), DFF, nullptr, 0.f, nullptr, c * MCH};
              pg8::gemm_phase<pg8::EpiBf16<1, 0, false>, pg8::StaticOrder, true, true>(lds + RING_OFF, g, S, E);
            }
#endif
            GRID_BAR();
#ifndef DBG_NO_GEMM
            { pg8::Gemm g{WSP(bf16, WS_HID), WSP(bf16, WS_WLAY + L * W_LAYER + WO_DN), MCH, DM, DFF}; pg8::StaticOrder S; S.init(MCH, DM, G, bx + ZERO());
              pg8::EpiBf16<0, 0, true> E{WSP(bf16, WS_H) + (size_t)c * MCH * DM, DM, nullptr, 0.f, WSP(float, PS_H), c * MCH};
              pg8::gemm_phase<pg8::EpiBf16<0, 0, true>, pg8::StaticOrder, true, true>(lds + RING_OFF, g, S, E);
            }
            if (c == 0) {
              pg8::Gemm g{WSP(bf16, WS_PB), WSP(bf16, WS_WLAY + L * W_LAYER + WO_PU), T, DM, PLE + ZERO()}; pg8::StaticOrder S; S.init(T, DM, G, bx + ZERO());
              pg8::EpiBf16<0, 0, true> E{WSP(bf16, WS_E), DM, nullptr, 0.f, WSP(float, PS_E), 0};
              pg8::gemm_phase<pg8::EpiBf16<0, 0, true>, pg8::StaticOrder, true, true>(lds + RING_OFF, g, S, E);
            }
#endif
            GRID_BAR();
        }
        { LANE_DECL(); const float* g3 = INP(4) + (size_t)(L * 4 + 3) * DM; bf16* XB = WSP(bf16, WS_XB); const bf16* H = WSP(bf16, WS_H); const float* psh = WSP(float, PS_H); const float* pse = WSP(float, PS_E); float* sse = WSP(float, SS_E); const float* ssx2 = WSP(float, SS_X2);
          constexpr int RD = 4; int m0 = gwl;
          for (; m0 + (RD - 1) * NGW < T; m0 += RD * NGW) thin_d_rows<RD>(m0, NGW, lane, g3, XB, H, psh, pse, sse, ssx2);
          for (; m0 < T; m0 += NGW) thin_d_rows<1>(m0, NGW, lane, g3, XB, H, psh, pse, sse, ssx2);
        }
        GRID_BAR();
#ifndef DBG_NO_GEMM
        { pg8::Gemm g{WSP(bf16, WS_XB), WSP(bf16, WS_WLAY + L * W_LAYER + WO_G), T, DM, DM}; pg8::StaticOrder S; S.init(T, DM, G, bx + ZERO());
          pg8::EpiGate E{WSP(bf16, WS_XB), WSP(bf16, WS_E), (L + 1 < DEPTH) ? (bf16*)(args.out + ZERO()) : (bf16*)nullptr, args.out + ZERO(), DM, WSP(float, SS_E), INP(19) + (size_t)L * DM, WSP(float, PS_X)};
          pg8::gemm_phase<pg8::EpiGate, pg8::StaticOrder, true, true>(lds + RING_OFF, g, S, E);
        }
#endif
        if (L + 1 < DEPTH) {
            GRID_BAR();
            { LANE_DECL(); const float* psx = WSP(float, PS_X); float* ssx = WSP(float, SS_XIN);
              for (int m = gwl; m < T; m += NGW) { const float s = wave_sum(lane < 32 ? psx[(size_t)m * 32 + lane] : 0.f); if (lane == 0) ssx[m] = s; } }
            GRID_BAR();
        }
    }
#undef GRID_BAR
}

extern "C" void kernel_launch(void* const* d_in, const int* in_sizes, int n_in, void* d_out, int out_size, void* d_ws, size_t ws_size, hipStream_t stream) {
    static int grid = 0;
    if (grid == 0) {
        if (n_in != 20 || out_size != T * DM || ws_size < WS_END) { fprintf(stderr, "kernel_launch: unexpected shapes: n_in %d out %d ws %zu (need %zu)\n", n_in, out_size, ws_size, (size_t)WS_END); grid = -1; return; }
        int dev = 0, cus = 0, per_cu = 0;
        if (hipGetDevice(&dev) != hipSuccess || hipDeviceGetAttribute(&cus, hipDeviceAttributeMultiprocessorCount, dev) != hipSuccess) { grid = -1; return; }
        if (hipFuncSetAttribute((const void*)trunk_fwd, hipFuncAttributeMaxDynamicSharedMemorySize, LDS_BYTES) != hipSuccess) { fprintf(stderr, "kernel_launch: hipFuncSetAttribute failed\n"); grid = -1; return; }
        if (hipOccupancyMaxActiveBlocksPerMultiprocessor(&per_cu, (const void*)trunk_fwd, NWAVES * 64, LDS_BYTES) != hipSuccess || per_cu < 1) fprintf(stderr, "kernel_launch: occupancy query reports %d\n", per_cu);
        (void)hipGetLastError();
        grid = cus;
    }
    if (grid < 0) return;
    if (hipMemsetAsync((char*)d_ws + WS_CTL, 0, CTL_ZERO_BYTES, stream) != hipSuccess) return;
    Args a{};
    for (int i = 0; i < 20; ++i) a.in[i] = (const float*)d_in[i];
    a.out = (float*)d_out; a.ws = (unsigned char*)d_ws;
    hipLaunchKernelGGL(trunk_fwd, dim3(grid), dim3(NWAVES * 64), LDS_BYTES, stream, a);
    const hipError_t le = hipPeekAtLastError();
    if (le != hipSuccess) fprintf(stderr, "kernel_launch: launch failed: %s\n", hipGetErrorName(le));
}
```

```cpp
#include <hip/hip_runtime.h>
#include <cstdio>
#include <cstdint>
namespace pg8 {
#define PG8_LAS __attribute__((address_space(3)))
typedef unsigned short bf16_t;
typedef short bf16x8 __attribute__((ext_vector_type(8)));
typedef float f32x4 __attribute__((ext_vector_type(4)));
typedef unsigned u32x4 __attribute__((ext_vector_type(4)));
constexpr int BM = 256, BK = 64, HALF = 128, HTB = HALF * BK * 2  , STAGE_BYTES = 8 * HTB, NXCD = 8, WGM = 8;

__host__ __device__ __forceinline__ int lds_byte(int r, int c) { const int st = (r >> 4) * 2 + (c >> 5), rr = r & 15, cc = c & 31, ob = rr * 64 + cc * 2; return st * 1024 + (ob ^ (((ob >> 9) & 1) << 5)); }
__host__ __device__ __forceinline__ void stage_rc(int b, int& R, int& C) { const int st = b / 1024, sb = b % 1024, swz = sb ^ (((sb >> 9) & 1) << 5); R = (st >> 1) * 16 + swz / 64; C = (st & 1) * 32 + (swz % 64) / 2; }
__host__ __device__ __forceinline__ int perm32(int rho) { const int n = rho >> 4, i = rho & 15; return 8 * (i >> 2) + 4 * n + (i & 3); }

struct Unit { int pm, pn; };
struct Gemm { const bf16_t* A; const bf16_t* Bt; int M, N, K; };

struct StaticOrder {
    int nM, nN, nwg, G, c;
    __host__ __device__ void init(int M, int N, int G_, int c_) { nM = M / BM; nN = N / BM; nwg = nM * nN; G = G_; c = c_; }
    __host__ __device__ bool next(int i, Unit& u) const {
        const long L = (long)i * G + c; if (L >= nwg) return false;
        int wgid = (int)L; { const int q = nwg / NXCD, r = nwg % NXCD, xcd = wgid % NXCD, off = wgid / NXCD; wgid = (xcd < r ? xcd * (q + 1) : r * (q + 1) + (xcd - r) * q) + off; }
        const int nig = WGM * nN; int gid, rem;
        if ((nig & (nig - 1)) == 0) { gid = wgid >> __builtin_ctz(nig); rem = wgid & (nig - 1); } else { gid = wgid / nig; rem = wgid % nig; }
        const int fm = gid * WGM, gsz = (nM - fm) < WGM ? (nM - fm) : WGM;
        constexpr int WGM_SH = 3; static_assert((1 << WGM_SH) == WGM, "WGM must be 1 << WGM_SH");
        if (gsz == WGM) { u.pm = fm + (rem & (WGM - 1)); u.pn = rem >> WGM_SH; } else { u.pm = fm + (rem % gsz); u.pn = rem / gsz; }
        return true;
    }
    __device__ __forceinline__ void a_ready(const Unit&) const {}
    __device__ __forceinline__ void done(const Unit&) const {}
};

__device__ __forceinline__ unsigned cvt_pk_bf16(float lo, float hi) { unsigned r; asm volatile("v_cvt_pk_bf16_f32 %0, %1, %2" : "=v"(r) : "v"(lo), "v"(hi)); return r; }
typedef float f32x2 __attribute__((ext_vector_type(2)));

constexpr float RMS_EPS = 1e-6f;
template <int NP> __device__ __forceinline__ float row_rs(const float* ss, int row, float inv_d) {
    float s;
    if (NP == 1) s = ss[row];
    else { const f32x4 a = *(const f32x4*)(ss + (size_t)row * 8), b = *(const f32x4*)(ss + (size_t)row * 8 + 4); s = ((a[0] + a[1]) + (a[2] + a[3])) + ((b[0] + b[1]) + (b[2] + b[3])); }
    return __builtin_amdgcn_rsqf(s * inv_d + RMS_EPS);
}
__device__ __forceinline__ void stat_put(float* ps, int row, int ns, int slot, float part, int fq) {
    part += __shfl_xor(part, 16); part += __shfl_xor(part, 32);
    if (fq == 0) ps[(size_t)row * ns + slot] = part;
}
__device__ __forceinline__ float sq4v(f32x4 v) { return (v[0] * v[0] + v[1] * v[1]) + (v[2] * v[2] + v[3] * v[3]); }

template <int ACT  , int RS  , bool STAT  > struct EpiBf16 {
    static constexpr bool PERM = true, AFTER_DRAIN = false;
    bf16_t* O; int ldc; const float* ss_in; float inv_d; float* ss_out; int row_off;
    __device__ __forceinline__ void operator()(const f32x4 (&acc)[2][2][4][2], const Unit& u, int wr, int wc, int fr, int fq) const {
        const int row0 = u.pm * BM + wr * 64 + fr, col0 = u.pn * BM + wc * 32 + 8 * fq;
#pragma unroll
        for (int ai = 0; ai < 2; ++ai)
#pragma unroll
            for (int m = 0; m < 4; ++m) { const int row = row0 + ai * HALF + m * 16; bf16_t* rowp = O + (size_t)row * ldc + col0;
                float rs = 1.f; if (RS) { rs = row_rs<(RS ? RS : 1)>(ss_in, row_off + row, inv_d); if (ACT == 1) rs = rs * rs; }
                float part = 0.f;
#pragma unroll
                for (int bj = 0; bj < 2; ++bj) { f32x4 v0 = acc[ai][bj][m][0], v1 = acc[ai][bj][m][1];
                    if (ACT == 1) {
#pragma unroll
                        for (int e = 0; e < 4; ++e) { const float a = fmaxf(v0[e], 0.f), b = fmaxf(v1[e], 0.f); v0[e] = a * a; v1[e] = b * b; } }
                    if (RS) { v0 = v0 * rs; v1 = v1 * rs; }
                    if (STAT) part += sq4v(v0) + sq4v(v1);
                    u32x4 w; w.x = cvt_pk_bf16(v0[0], v0[1]); w.y = cvt_pk_bf16(v0[2], v0[3]); w.z = cvt_pk_bf16(v1[0], v1[1]); w.w = cvt_pk_bf16(v1[2], v1[3]);
                    *(u32x4*)(rowp + bj * HALF) = w; }
                if (STAT) stat_put(ss_out, row_off + row, 32, u.pn * 4 + wc, part, fq); }
    }
};
struct EpiLat {
    static constexpr bool PERM = true, AFTER_DRAIN = false;
    bf16_t* CQ; bf16_t* CKV; bf16_t* KR; const float* ss_in; float* ssq; float* sskv; const float* rot;
    __device__ __forceinline__ void operator()(const f32x4 (&acc)[2][2][4][2], const Unit& u, int wr, int wc, int fr, int fq) const {
        const int row0 = u.pm * BM + wr * 64 + fr, col0 = u.pn * BM + wc * 32 + 8 * fq;
        if (u.pn < 4) { float* ssd = u.pn < 2 ? ssq : sskv; bf16_t* C = (u.pn < 2 ? CQ : CKV) + (u.pn & 1) * BM + wc * 32 + 8 * fq;
#pragma unroll
            for (int ai = 0; ai < 2; ++ai)
#pragma unroll
                for (int m = 0; m < 4; ++m) { const int row = row0 + ai * HALF + m * 16; const float rs = row_rs<1>(ss_in, row, 1.0f / 2048.0f); float part = 0.f;
#pragma unroll
                    for (int bj = 0; bj < 2; ++bj) { const f32x4 v0 = acc[ai][bj][m][0] * rs, v1 = acc[ai][bj][m][1] * rs; part += sq4v(v0) + sq4v(v1);
                        u32x4 w; w.x = cvt_pk_bf16(v0[0], v0[1]); w.y = cvt_pk_bf16(v0[2], v0[3]); w.z = cvt_pk_bf16(v1[0], v1[1]); w.w = cvt_pk_bf16(v1[2], v1[3]);
                        *(u32x4*)(C + (size_t)row * 512 + bj * HALF) = w; }
                    stat_put(ssd, row, 8, (u.pn & 1) * 4 + wc, part, fq); }
        } else if (wc < 2) { const int d0 = 16 * wc + 4 * fq;
#pragma unroll
            for (int ai = 0; ai < 2; ++ai)
#pragma unroll
                for (int m = 0; m < 4; ++m) { const int row = row0 + ai * HALF + m * 16; const float rs = row_rs<1>(ss_in, row, 1.0f / 2048.0f); const int pos = row < 16384 ? row : ((row - 16384) & 4095);
                    const f32x4 v0 = acc[ai][0][m][0] * rs, v1 = acc[ai][0][m][1] * rs;
                    const f32x4 cs0 = *(const f32x4*)(rot + ((size_t)pos * 32 + d0) * 2), cs1 = *(const f32x4*)(rot + ((size_t)pos * 32 + d0 + 2) * 2);
                    u32x4 w; w.x = cvt_pk_bf16(v0[0] * cs0[0] - v0[1] * cs0[1], v0[1] * cs0[0] + v0[0] * cs0[1]); w.y = cvt_pk_bf16(v0[2] * cs0[2] - v0[3] * cs0[3], v0[3] * cs0[2] + v0[2] * cs0[3]);
                    w.z = cvt_pk_bf16(v1[0] * cs1[0] - v1[1] * cs1[1], v1[1] * cs1[0] + v1[0] * cs1[1]); w.w = cvt_pk_bf16(v1[2] * cs1[2] - v1[3] * cs1[3], v1[3] * cs1[2] + v1[2] * cs1[3]);
                    *(u32x4*)(KR + (size_t)row * 64 + 32 * wc + 8 * fq) = w; }
        }
    }
};
struct EpiQRope {
    static constexpr bool PERM = true, AFTER_DRAIN = false;
    bf16_t* O; int ldc; const float* rot; float scale; const float* ss_in;
    __device__ __forceinline__ void operator()(const f32x4 (&acc)[2][2][4][2], const Unit& u, int wr, int wc, int fr, int fq) const {
        const int row0 = u.pm * BM + wr * 64 + fr, col0 = u.pn * BM + wc * 32 + 8 * fq;
#pragma unroll
        for (int ai = 0; ai < 2; ++ai)
#pragma unroll
            for (int m = 0; m < 4; ++m) { const int row = row0 + ai * HALF + m * 16; const float rs = row_rs<8>(ss_in, row, 1.0f / 512.0f) * scale; const int pos = row < 16384 ? row : ((row - 16384) & 4095);
#pragma unroll
                for (int bj = 0; bj < 2; ++bj) {
                    const int sb = u.pn * BM + bj * HALF + wc * 32, hr = sb % 192; const bool rope = hr >= 128; const int d0 = ((hr - 128) >> 1) + 4 * fq;
                    f32x4 v0 = acc[ai][bj][m][0] * rs, v1 = acc[ai][bj][m][1] * rs;
                    if (rope) {
                        const f32x4 cs0 = *(const f32x4*)(rot + ((size_t)pos * 32 + d0) * 2), cs1 = *(const f32x4*)(rot + ((size_t)pos * 32 + d0 + 2) * 2);
                        f32x4 o0, o1;
                        o0[0] = v0[0] * cs0[0] - v0[1] * cs0[1]; o0[1] = v0[1] * cs0[0] + v0[0] * cs0[1];
                        o0[2] = v0[2] * cs0[2] - v0[3] * cs0[3]; o0[3] = v0[3] * cs0[2] + v0[2] * cs0[3];
                        o1[0] = v1[0] * cs1[0] - v1[1] * cs1[1]; o1[1] = v1[1] * cs1[0] + v1[0] * cs1[1];
                        o1[2] = v1[2] * cs1[2] - v1[3] * cs1[3]; o1[3] = v1[3] * cs1[2] + v1[2] * cs1[3];
                        v0 = o0; v1 = o1; }
                    u32x4 w; w.x = cvt_pk_bf16(v0[0], v0[1]); w.y = cvt_pk_bf16(v0[2], v0[3]); w.z = cvt_pk_bf16(v1[0], v1[1]); w.w = cvt_pk_bf16(v1[2], v1[3]);
                    *(u32x4*)(O + (size_t)row * ldc + col0 + bj * HALF) = w; } }
    }
};
struct EpiGate {
    static constexpr bool PERM = true, AFTER_DRAIN = false;
    const bf16_t* XBin; const bf16_t* E; bf16_t* XBout; float* OUT; int ldc; const float* sse; const float* pn; float* ss_out;
    __device__ __forceinline__ void operator()(const f32x4 (&acc)[2][2][4][2], const Unit& u, int wr, int wc, int fr, int fq) const {
        const int row0 = u.pm * BM + wr * 64 + fr, col0 = u.pn * BM + wc * 32 + 8 * fq;
        f32x4 g[2][2];
#pragma unroll
        for (int bj = 0; bj < 2; ++bj)
#pragma unroll
            for (int n = 0; n < 2; ++n) g[bj][n] = *(const f32x4*)(pn + col0 + bj * HALF + 4 * n);
#pragma unroll
        for (int am = 0; am < 4; ++am) { const int ai = am >> 1, m0 = (am & 1) * 2;
            u32x4 xw[4][2], ew[4][2]; float re[4];
#pragma unroll
            for (int m = m0; m < m0 + 2; ++m) { const int row = row0 + ai * HALF + m * 16; const size_t off = (size_t)row * ldc + col0; re[m] = sse[row];
#pragma unroll
                for (int bj = 0; bj < 2; ++bj) { xw[m][bj] = *(const u32x4*)(XBin + off + bj * HALF); ew[m][bj] = *(const u32x4*)(E + off + bj * HALF); } }
#pragma unroll
            for (int m = m0; m < m0 + 2; ++m) { const int row = row0 + ai * HALF + m * 16; const size_t off = (size_t)row * ldc + col0; const float rs = __builtin_amdgcn_rsqf(re[m] * (1.0f / 2048.0f) + RMS_EPS); float part = 0.f;
#pragma unroll
                for (int bj = 0; bj < 2; ++bj) { f32x4 r[2];
#pragma unroll
                    for (int n = 0; n < 2; ++n) { const unsigned x0 = n ? xw[m][bj].z : xw[m][bj].x, x1 = n ? xw[m][bj].w : xw[m][bj].y, e0 = n ? ew[m][bj].z : ew[m][bj].x, e1 = n ? ew[m][bj].w : ew[m][bj].y;
                        f32x4 x; x[0] = __uint_as_float(x0 << 16); x[1] = __uint_as_float(x0 & 0xffff0000u); x[2] = __uint_as_float(x1 << 16); x[3] = __uint_as_float(x1 & 0xffff0000u);
                        f32x4 ev; ev[0] = __uint_as_float(e0 << 16); ev[1] = __uint_as_float(e0 & 0xffff0000u); ev[2] = __uint_as_float(e1 << 16); ev[3] = __uint_as_float(e1 & 0xffff0000u);
                        ev = ev * g[bj][n] * rs; const f32x4 a = acc[ai][bj][m][n];
#pragma unroll
                        for (int k = 0; k < 4; ++k) { const float sg = __builtin_amdgcn_rcpf(1.0f + __builtin_amdgcn_exp2f(-1.4426950408889634f * a[k])); r[n][k] = x[k] + ev[k] * sg; } }
                    if (XBout) { part += sq4v(r[0]) + sq4v(r[1]); u32x4 w; w.x = cvt_pk_bf16(r[0][0], r[0][1]); w.y = cvt_pk_bf16(r[0][2], r[0][3]); w.z = cvt_pk_bf16(r[1][0], r[1][1]); w.w = cvt_pk_bf16(r[1][2], r[1][3]);
                        *(u32x4*)(XBout + off + bj * HALF) = w; }
                    else { *(f32x4*)(OUT + off + bj * HALF) = r[0]; *(f32x4*)(OUT + off + bj * HALF + 4) = r[1]; } }
                if (XBout) stat_put(ss_out, row, 32, u.pn * 4 + wc, part, fq); }
            asm volatile("" ::: "memory"); }
    }
};
__device__ __forceinline__ void pg8_dma2(unsigned v0, unsigned v1, const void* base, unsigned dst) { unsigned keep;
    asm volatile("s_mov_b32 %0, m0\n\ts_mov_b32 m0, %4\n\ts_nop 0\n\tglobal_load_lds_dwordx4 %1, %3\n\ts_add_u32 m0, m0, 0x2000\n\ts_nop 0\n\tglobal_load_lds_dwordx4 %2, %3\n\ts_mov_b32 m0, %0"
                 : "=&s"(keep) : "v"(v0), "v"(v1), "s"(base), "s"(dst) : "memory", "scc"); }
__device__ __forceinline__ void pg8_dma6(unsigned v0, unsigned v1, unsigned v2, unsigned v3, unsigned v4, unsigned v5, const void* b0, const void* b1, const void* b2, unsigned d0, unsigned d1, unsigned d2) { unsigned keep;
    asm volatile("s_mov_b32 %0, m0\n\ts_mov_b32 m0, %10\n\ts_nop 0\n\tglobal_load_lds_dwordx4 %1, %7\n\ts_add_u32 m0, m0, 0x2000\n\ts_nop 0\n\tglobal_load_lds_dwordx4 %2, %7\n\t"
                 "s_mov_b32 m0, %11\n\ts_nop 0\n\tglobal_load_lds_dwordx4 %3, %8\n\ts_add_u32 m0, m0, 0x2000\n\ts_nop 0\n\tglobal_load_lds_dwordx4 %4, %8\n\t"
                 "s_mov_b32 m0, %12\n\ts_nop 0\n\tglobal_load_lds_dwordx4 %5, %9\n\ts_add_u32 m0, m0, 0x2000\n\ts_nop 0\n\tglobal_load_lds_dwordx4 %6, %9\n\ts_mov_b32 m0, %0"
                 : "=&s"(keep) : "v"(v0), "v"(v1), "v"(v2), "v"(v3), "v"(v4), "v"(v5), "s"(b0), "s"(b1), "s"(b2), "s"(d0), "s"(d1), "s"(d2) : "memory", "scc"); }
#ifndef PG8_DPOS
#define PG8_DPOS 0
#endif
template <class Epi, class Sched, bool ALIGN_EPI = false, bool SP2 = false>
__device__ __forceinline__ void gemm_phase(PG8_LAS unsigned char* lds, const Gemm g, const Sched& S, const Epi& E) {
    int tid_ = threadIdx.x; asm volatile("" : "+v"(tid_));
    const int tid = tid_, wid = __builtin_amdgcn_readfirstlane(tid >> 6), lane = tid & 63, wr = wid >> 2, wc = wid & 3, fr = lane & 15, fq = lane >> 4;
    const int K = g.K, nt = K / BK;
    unsigned voffA[2], voffB[2];
#pragma unroll
    for (int i = 0; i < 2; ++i) { int R, C; stage_rc(tid * 16 + i * 8192, R, C); const int Rb = Epi::PERM ? ((R & ~31) + perm32(R & 31)) : R;
        voffA[i] = (unsigned)(R * K + C) * 2u; voffB[i] = (unsigned)(Rb * K + C) * 2u; }
    const size_t kstep = (size_t)(BK * 2);
    const size_t hstep = (size_t)HALF * K * 2;
    const size_t tstep = 2 * hstep;
    const unsigned ldsw = (unsigned)wid * 1024u;
    const unsigned ldsb = (unsigned)__builtin_amdgcn_readfirstlane((int)((unsigned)(size_t)lds + ldsw));
    const int aoff = lds_byte(wr * 64 + fr, fq * 8), boff = lds_byte(wc * 32 + fr, fq * 8);
#define PG8_SA(b, h) (((b) * 2 + (h)) * HTB)
#define PG8_SB(b, h) ((4 + (b) * 2 + (h)) * HTB)
#define PG8_STAGE(bufoff, gbase, voff) pg8_dma2((voff)[0], (voff)[1], (gbase), ldsb + (unsigned)(bufoff))
#define PG8_STAGE3(o0, g0, v0, o1, g1, v1, o2, g2, v2) pg8_dma6((v0)[0], (v0)[1], (v1)[0], (v1)[1], (v2)[0], (v2)[1], (g0), (g1), (g2), ldsb + (unsigned)(o0), ldsb + (unsigned)(o1), ldsb + (unsigned)(o2))
#define PG8_LDA(dst, b, h) do { _Pragma("unroll") for (int m = 0; m < 4; ++m) _Pragma("unroll") for (int k = 0; k < 2; ++k) dst[m][k] = *(const PG8_LAS bf16x8*)(lds + PG8_SA(b, h) + aoff + m * 2048 + k * 1024); } while (0)
#define PG8_LDB(dst, b, h) do { _Pragma("unroll") for (int n = 0; n < 2; ++n) _Pragma("unroll") for (int k = 0; k < 2; ++k) dst[n][k] = *(const PG8_LAS bf16x8*)(lds + PG8_SB(b, h) + boff + n * 2048 + k * 1024); } while (0)
#define PG8_MMA(ai, bj, At, Bt) do { __builtin_amdgcn_s_setprio(1); _Pragma("unroll") for (int m = 0; m < 4; ++m) _Pragma("unroll") for (int n = 0; n < 2; ++n) _Pragma("unroll") for (int k = 0; k < 2; ++k) \
        acc[ai][bj][m][n] = __builtin_amdgcn_mfma_f32_16x16x32_bf16(Bt[n][k], At[m][k], acc[ai][bj][m][n], 0, 0, 0); __builtin_amdgcn_s_setprio(0); } while (0)
#define PG8_WAIT_V(n) asm volatile("s_waitcnt vmcnt(" #n ")" ::: "memory")
#define PG8_WAIT_L(n) asm volatile("s_waitcnt lgkmcnt(" #n ")" ::: "memory")
#define PG8_BAR __builtin_amdgcn_s_barrier()
#define PG8_SCHED __builtin_amdgcn_sched_barrier(0)
    Unit cur, nxt; int ui = 0;
    if (!S.next(0, cur)) return;
    typedef double f64x2z __attribute__((ext_vector_type(2)));
    f32x4 acc[2][2][4][2];
#pragma unroll
    for (int a = 0; a < 2; ++a)
#pragma unroll
        for (int b = 0; b < 2; ++b)
#pragma unroll
            for (int m = 0; m < 4; ++m)
#pragma unroll
                for (int n = 0; n < 2; ++n) { double z0_, z1_; asm volatile("v_mov_b64 %0, 0\n\tv_mov_b64 %1, 0" : "=v"(z0_), "=v"(z1_)); const f64x2z zz_ = {z0_, z1_}; acc[a][b][m][n] = __builtin_bit_cast(f32x4, zz_); }
    bf16x8 At[4][2], B0[2][2], B1[2][2];
    const char* cA = (const char*)g.A + (size_t)cur.pm * tstep; const char* cB = (const char*)g.Bt + (size_t)cur.pn * tstep;
    S.a_ready(cur);
    if constexpr (SP2) {
        PG8_STAGE(PG8_SB(0, 0), cB, voffB); PG8_STAGE(PG8_SB(0, 1), cB + hstep, voffB); PG8_STAGE(PG8_SA(0, 0), cA, voffA); PG8_STAGE(PG8_SA(0, 1), cA + hstep, voffA);
        if (wr == 1) PG8_BAR;
        PG8_WAIT_V(2); PG8_BAR;
        PG8_STAGE(PG8_SB(1, 0), cB + kstep, voffB); PG8_STAGE(PG8_SA(1, 0), cA + kstep, voffA); PG8_STAGE(PG8_SB(1, 1), cB + hstep + kstep, voffB);
        PG8_WAIT_V(6); PG8_BAR;
    } else {
        PG8_STAGE(PG8_SB(0, 0), cB, voffB); PG8_STAGE(PG8_SA(0, 0), cA, voffA); PG8_STAGE(PG8_SB(0, 1), cB + hstep, voffB); PG8_STAGE(PG8_SA(0, 1), cA + hstep, voffA);
        if (wr == 1) PG8_BAR;
        PG8_WAIT_V(4); PG8_BAR;
        PG8_STAGE(PG8_SB(1, 0), cB + kstep, voffB); PG8_STAGE(PG8_SA(1, 0), cA + kstep, voffA); PG8_STAGE(PG8_SB(1, 1), cB + hstep + kstep, voffB);
        PG8_WAIT_V(6); PG8_BAR;
    }
    for (;;) {
        const bool has_next = S.next(ui + 1, nxt);
        const char* nA = has_next ? (const char*)g.A + (size_t)nxt.pm * tstep : cA; const char* nB = has_next ? (const char*)g.Bt + (size_t)nxt.pn * tstep : cB;
        for (int t = 0; t < nt; t += 2) {
            const bool last = (t == nt - 2);
            const char* a1 = cA + (size_t)(t + 1) * kstep;
            const char* a2 = last ? nA : cA + (size_t)(t + 2) * kstep; const char* b2 = last ? nB : cB + (size_t)(t + 2) * kstep;
            const char* a3 = a2 + kstep; const char* b3 = b2 + kstep;
            if (last && has_next) S.a_ready(nxt);
            if constexpr (SP2) {
#if PG8_DPOS == 0
            PG8_LDB(B0, 0, 0); PG8_LDB(B1, 0, 1); PG8_SCHED; PG8_LDA(At, 0, 0); PG8_STAGE(PG8_SA(1, 1), a1 + hstep, voffA);
            PG8_WAIT_V(8); PG8_WAIT_L(0); PG8_BAR; PG8_MMA(0, 0, At, B0); PG8_MMA(0, 1, At, B1); PG8_BAR; PG8_SCHED;
#elif PG8_DPOS == 1
            PG8_LDB(B0, 0, 0); PG8_LDB(B1, 0, 1); PG8_SCHED; PG8_LDA(At, 0, 0);
            PG8_WAIT_V(6); PG8_WAIT_L(0); PG8_BAR; PG8_SCHED; PG8_STAGE(PG8_SA(1, 1), a1 + hstep, voffA); PG8_SCHED; PG8_MMA(0, 0, At, B0); PG8_MMA(0, 1, At, B1); PG8_BAR; PG8_SCHED;
#else
            PG8_LDB(B0, 0, 0); PG8_LDB(B1, 0, 1); PG8_SCHED; PG8_LDA(At, 0, 0);
            PG8_WAIT_V(6); PG8_WAIT_L(0); PG8_BAR; PG8_MMA(0, 0, At, B0); PG8_SCHED; PG8_STAGE(PG8_SA(1, 1), a1 + hstep, voffA); PG8_SCHED; PG8_MMA(0, 1, At, B1); PG8_BAR; PG8_SCHED;
#endif
#if PG8_DPOS == 0
            PG8_LDA(At, 0, 1); PG8_STAGE3(PG8_SB(0, 0), b2, voffB, PG8_SB(0, 1), b2 + hstep, voffB, PG8_SA(0, 0), a2, voffA);
            PG8_WAIT_V(8); PG8_WAIT_L(0); PG8_BAR; PG8_MMA(1, 0, At, B0); PG8_MMA(1, 1, At, B1); PG8_BAR; PG8_SCHED;
#elif PG8_DPOS == 1
            PG8_LDA(At, 0, 1);
            PG8_WAIT_V(2); PG8_WAIT_L(0); PG8_BAR; PG8_SCHED; PG8_STAGE3(PG8_SB(0, 0), b2, voffB, PG8_SB(0, 1), b2 + hstep, voffB, PG8_SA(0, 0), a2, voffA); PG8_SCHED; PG8_MMA(1, 0, At, B0); PG8_MMA(1, 1, At, B1); PG8_BAR; PG8_SCHED;
#else
            PG8_LDA(At, 0, 1);
            PG8_WAIT_V(2); PG8_WAIT_L(0); PG8_BAR; PG8_MMA(1, 0, At, B0); PG8_SCHED; PG8_STAGE3(PG8_SB(0, 0), b2, voffB, PG8_SB(0, 1), b2 + hstep, voffB, PG8_SA(0, 0), a2, voffA); PG8_SCHED; PG8_MMA(1, 1, At, B1); PG8_BAR; PG8_SCHED;
#endif
#if PG8_DPOS == 0
            PG8_LDB(B0, 1, 0); PG8_LDB(B1, 1, 1); PG8_SCHED; PG8_LDA(At, 1, 0); PG8_STAGE(PG8_SA(0, 1), a2 + hstep, voffA);
            PG8_WAIT_V(8); PG8_WAIT_L(0); PG8_BAR; PG8_MMA(0, 0, At, B0); PG8_MMA(0, 1, At, B1); PG8_BAR; PG8_SCHED;
#elif PG8_DPOS == 1
            PG8_LDB(B0, 1, 0); PG8_LDB(B1, 1, 1); PG8_SCHED; PG8_LDA(At, 1, 0);
            PG8_WAIT_V(6); PG8_WAIT_L(0); PG8_BAR; PG8_SCHED; PG8_STAGE(PG8_SA(0, 1), a2 + hstep, voffA); PG8_SCHED; PG8_MMA(0, 0, At, B0); PG8_MMA(0, 1, At, B1); PG8_BAR; PG8_SCHED;
#else
            PG8_LDB(B0, 1, 0); PG8_LDB(B1, 1, 1); PG8_SCHED; PG8_LDA(At, 1, 0);
            PG8_WAIT_V(6); PG8_WAIT_L(0); PG8_BAR; PG8_MMA(0, 0, At, B0); PG8_SCHED; PG8_STAGE(PG8_SA(0, 1), a2 + hstep, voffA); PG8_SCHED; PG8_MMA(0, 1, At, B1); PG8_BAR; PG8_SCHED;
#endif
#if PG8_DPOS == 0
            PG8_LDA(At, 1, 1); PG8_STAGE3(PG8_SB(1, 0), b3, voffB, PG8_SB(1, 1), b3 + hstep, voffB, PG8_SA(1, 0), a3, voffA);
            PG8_WAIT_V(8); PG8_WAIT_L(0); PG8_BAR; PG8_MMA(1, 0, At, B0); PG8_MMA(1, 1, At, B1); PG8_BAR; PG8_SCHED;
#elif PG8_DPOS == 1
            PG8_LDA(At, 1, 1);
            PG8_WAIT_V(2); PG8_WAIT_L(0); PG8_BAR; PG8_SCHED; PG8_STAGE3(PG8_SB(1, 0), b3, voffB, PG8_SB(1, 1), b3 + hstep, voffB, PG8_SA(1, 0), a3, voffA); PG8_SCHED; PG8_MMA(1, 0, At, B0); PG8_MMA(1, 1, At, B1); PG8_BAR; PG8_SCHED;
#else
            PG8_LDA(At, 1, 1);
            PG8_WAIT_V(2); PG8_WAIT_L(0); PG8_BAR; PG8_MMA(1, 0, At, B0); PG8_SCHED; PG8_STAGE3(PG8_SB(1, 0), b3, voffB, PG8_SB(1, 1), b3 + hstep, voffB, PG8_SA(1, 0), a3, voffA); PG8_SCHED; PG8_MMA(1, 1, At, B1); PG8_BAR; PG8_SCHED;
#endif
            } else {
            PG8_LDB(B0, 0, 0); PG8_SCHED; PG8_LDA(At, 0, 0); PG8_STAGE(PG8_SA(1, 1), a1 + hstep, voffA);
            PG8_WAIT_L(8); PG8_BAR; PG8_WAIT_L(0); PG8_MMA(0, 0, At, B0); PG8_BAR; PG8_SCHED;
            PG8_LDB(B1, 0, 1); PG8_STAGE(PG8_SB(0, 0), b2, voffB);
            PG8_BAR; PG8_WAIT_L(0); PG8_MMA(0, 1, At, B1); PG8_BAR;
            PG8_LDA(At, 0, 1); PG8_STAGE(PG8_SA(0, 0), a2, voffA);
            PG8_BAR; PG8_WAIT_L(0); PG8_MMA(1, 0, At, B0); PG8_BAR; PG8_SCHED;
            PG8_STAGE(PG8_SB(0, 1), b2 + hstep, voffB);
            PG8_WAIT_V(6); PG8_BAR; PG8_MMA(1, 1, At, B1); PG8_BAR;
            PG8_LDB(B0, 1, 0); PG8_SCHED; PG8_LDA(At, 1, 0); PG8_STAGE(PG8_SA(0, 1), a2 + hstep, voffA);
            PG8_WAIT_L(8); PG8_BAR; PG8_WAIT_L(0); PG8_MMA(0, 0, At, B0); PG8_BAR; PG8_SCHED;
            PG8_LDB(B1, 1, 1); PG8_STAGE(PG8_SB(1, 0), b3, voffB);
            PG8_BAR; PG8_WAIT_L(0); PG8_MMA(0, 1, At, B1); PG8_BAR;
            PG8_LDA(At, 1, 1); PG8_STAGE(PG8_SA(1, 0), a3, voffA);
            PG8_BAR; PG8_WAIT_L(0); PG8_MMA(1, 0, At, B0); PG8_BAR; PG8_SCHED;
            PG8_STAGE(PG8_SB(1, 1), b3 + hstep, voffB);
            PG8_WAIT_V(6); PG8_BAR; PG8_MMA(1, 1, At, B1); PG8_BAR;
            }
        }
        if constexpr (ALIGN_EPI) { if (wr == 0) PG8_BAR; }
        if constexpr (!Epi::AFTER_DRAIN) { E(acc, cur, wr, wc, fr, fq); S.done(cur); }
        if (!has_next) break;
#pragma unroll
        for (int a = 0; a < 2; ++a)
#pragma unroll
            for (int b = 0; b < 2; ++b)
#pragma unroll
                for (int m = 0; m < 4; ++m)
#pragma unroll
                    for (int n = 0; n < 2; ++n) { double z0_, z1_; asm volatile("v_mov_b64 %0, 0\n\tv_mov_b64 %1, 0" : "=v"(z0_), "=v"(z1_)); const f64x2z zz_ = {z0_, z1_}; acc[a][b][m][n] = __builtin_bit_cast(f32x4, zz_); }
        cur = nxt; cA = nA; cB = nB; ++ui;
        if constexpr (ALIGN_EPI) { if (wr == 1) PG8_BAR; }
    }
    PG8_WAIT_V(0);
    if constexpr (!ALIGN_EPI) { if (wr == 0) PG8_BAR; }
    PG8_BAR;
    if constexpr (Epi::AFTER_DRAIN) { E.fused(acc, cur, wr, wc, fr, fq, lds, wid, lane); S.done(cur); }
#undef PG8_SA
#undef PG8_SB
#undef PG8_STAGE
#undef PG8_STAGE3
#undef PG8_LDA
#undef PG8_LDB
#undef PG8_MMA
#undef PG8_WAIT_V
#undef PG8_WAIT_L
#undef PG8_BAR
#undef PG8_SCHED
}
}

#include <type_traits>
namespace att {
typedef short bf16x8 __attribute__((ext_vector_type(8)));
typedef short s16x4 __attribute__((ext_vector_type(4)));
typedef float f32x16 __attribute__((ext_vector_type(16)));
typedef unsigned u32x4 __attribute__((ext_vector_type(4)));
typedef unsigned short bf16_t;
#define ATT_LAS __attribute__((address_space(3)))
#define ATT_SBAR() __builtin_amdgcn_sched_barrier(0)
constexpr int KN_OFF = 0, KN_SLOT = 16384, KR_OFF = 49152, KR_SLOT = 8192, V_OFF = 73728, V_SLOT = 16384, WSC_OFF = V_OFF + 4 * V_SLOT, BT_OFF = KR_OFF, ATT_LDS_BYTES = WSC_OFF + 8 * 256;
constexpr int BT_STRIDE = 384, BT_ZERO = 191;
__host__ __device__ __forceinline__ int crow(int r, int hi) { return (r & 3) + 8 * (r >> 2) + 4 * hi; }
__device__ __forceinline__ unsigned cvtpk(float lo, float hi) { unsigned r; asm volatile("v_cvt_pk_bf16_f32 %0, %1, %2" : "=v"(r) : "v"(lo), "v"(hi)); return r; }
__host__ __device__ __forceinline__ int kn_byte(int R, int c) { return R * 256 + ((c ^ (R & 15)) << 4); }
__host__ __device__ __forceinline__ int kr_byte(int R, int c) { return R * 128 + ((c ^ ((R >> 1) & 7)) << 4); }
__host__ __device__ __forceinline__ int v_st(int k, int c) { const int kk = (k & ~0xC) | ((k & 4) << 1) | ((k & 8) >> 1); return ((kk >> 3) * 4 + (c >> 5)) * 512 + ((kk & 7) * 32 + (c & 31)) * 2; }
__host__ __device__ __forceinline__ int v_rd_base(int lane) { return ((lane & 3) << 3) | (((lane >> 2) & 3) << 6) | (((lane >> 4) & 1) << 5) | (((lane >> 5) & 1) << 8); }
__host__ __device__ constexpr int v_rd_off(int d0, int ks, int half) { return d0 * 512 + ks * 4096 + half * 2048; }
__host__ __device__ __forceinline__ void kn_inv(int b, int& R, int& c) { R = b >> 8; c = ((b >> 4) & 15) ^ (R & 15); }
__host__ __device__ __forceinline__ void kr_inv(int b, int& R, int& c) { R = b >> 7; c = ((b >> 4) & 7) ^ ((R >> 1) & 7); }
__host__ __device__ __forceinline__ void v_inv(int b, int& k, int& col) { const int s = b >> 9, w = b & 511, kk = ((s >> 2) << 3) | (w >> 6); k = (kk & ~0xC) | ((kk & 4) << 1) | ((kk & 8) >> 1); col = (s & 3) * 32 + ((w & 63) >> 1); }

__device__ __forceinline__ void glds16(const void* gsrc, unsigned lds_dst) { unsigned keep;
    asm volatile("s_mov_b32 %0, m0\n\ts_mov_b32 m0, %2\n\ts_nop 0\n\tglobal_load_lds_dwordx4 %1, off\n\ts_mov_b32 m0, %0" : "=&s"(keep) : "v"(gsrc), "s"(lds_dst) : "memory"); }
__device__ __forceinline__ void glds16x5(unsigned ok0, unsigned ok1, unsigned orr, unsigned ov0, unsigned ov1, const void* kb, const void* rb, const void* vb, unsigned dk, unsigned dr, unsigned dv) { unsigned keep;
    asm volatile("s_mov_b32 %0, m0\n\ts_mov_b32 m0, %9\n\ts_nop 0\n\tglobal_load_lds_dwordx4 %1, %6\n\ts_add_u32 m0, m0, 0x2000\n\ts_nop 0\n\tglobal_load_lds_dwordx4 %2, %6\n\t"
                 "s_mov_b32 m0, %10\n\ts_nop 0\n\tglobal_load_lds_dwordx4 %3, %7\n\ts_mov_b32 m0, %11\n\ts_nop 0\n\tglobal_load_lds_dwordx4 %4, %8\n\ts_add_u32 m0, m0, 0x2000\n\ts_nop 0\n\tglobal_load_lds_dwordx4 %5, %8\n\ts_mov_b32 m0, %0"
                 : "=&s"(keep) : "v"(ok0), "v"(ok1), "v"(orr), "v"(ov0), "v"(ov1), "s"(kb), "s"(rb), "s"(vb), "s"(dk), "s"(dr), "s"(dv) : "memory", "scc"); }
template <int OFF> __device__ __forceinline__ s16x4 tr_read(int vb) { s16x4 r; asm volatile("ds_read_b64_tr_b16 %0, %1 offset:%2" : "=&v"(r) : "v"(vb), "i"(OFF) : "memory"); return r; }
struct VFrag { s16x4 l0, h0, l1, h1, l2, h2, l3, h3; };
template <int D0> __device__ __forceinline__ void v_load(VFrag& f, int vb) {
    f.l0 = tr_read<v_rd_off(D0, 0, 0)>(vb); f.h0 = tr_read<v_rd_off(D0, 0, 1)>(vb); f.l1 = tr_read<v_rd_off(D0, 1, 0)>(vb); f.h1 = tr_read<v_rd_off(D0, 1, 1)>(vb);
    f.l2 = tr_read<v_rd_off(D0, 2, 0)>(vb); f.h2 = tr_read<v_rd_off(D0, 2, 1)>(vb); f.l3 = tr_read<v_rd_off(D0, 3, 0)>(vb); f.h3 = tr_read<v_rd_off(D0, 3, 1)>(vb);
}
__device__ __forceinline__ void pv_mma(f32x16& od, const VFrag& f, bf16x8 pa0, bf16x8 pa1, bf16x8 pa2, bf16x8 pa3) {
#define ATT_PK(L, H) (bf16x8){L[0], L[1], L[2], L[3], H[0], H[1], H[2], H[3]}
    od = __builtin_amdgcn_mfma_f32_32x32x16_bf16(pa0, ATT_PK(f.l0, f.h0), od, 0, 0, 0);
    od = __builtin_amdgcn_mfma_f32_32x32x16_bf16(pa1, ATT_PK(f.l1, f.h1), od, 0, 0, 0);
    od = __builtin_amdgcn_mfma_f32_32x32x16_bf16(pa2, ATT_PK(f.l2, f.h2), od, 0, 0, 0);
    od = __builtin_amdgcn_mfma_f32_32x32x16_bf16(pa3, ATT_PK(f.l3, f.h3), od, 0, 0, 0);
#undef ATT_PK
}
__device__ __forceinline__ void pv_all(f32x16* o, int vb, bf16x8 pa0, bf16x8 pa1, bf16x8 pa2, bf16x8 pa3) {
    VFrag fa, fb;
    v_load<0>(fa, vb); v_load<1>(fb, vb);
    asm volatile("s_waitcnt lgkmcnt(8)" ::: "memory"); ATT_SBAR(); pv_mma(o[0], fa, pa0, pa1, pa2, pa3); ATT_SBAR();
    v_load<2>(fa, vb);
    asm volatile("s_waitcnt lgkmcnt(8)" ::: "memory"); ATT_SBAR(); pv_mma(o[1], fb, pa0, pa1, pa2, pa3); ATT_SBAR();
    v_load<3>(fb, vb);
    asm volatile("s_waitcnt lgkmcnt(8)" ::: "memory"); ATT_SBAR(); pv_mma(o[2], fa, pa0, pa1, pa2, pa3); ATT_SBAR();
    asm volatile("s_waitcnt lgkmcnt(0)" ::: "memory"); ATT_SBAR(); pv_mma(o[3], fb, pa0, pa1, pa2, pa3); ATT_SBAR();
}
#define ATT_WAIT_BAR(N) asm volatile("s_waitcnt vmcnt(%0) lgkmcnt(0)\n\ts_barrier" :: "n"(N) : "memory")

template <bool SWA>
__device__ __forceinline__ void attn_unit(const bf16_t* __restrict__ Qw, int ldq, const bf16_t* __restrict__ Kn, const bf16_t* __restrict__ Kr, const bf16_t* __restrict__ Vg, int ldk,
                                          bf16_t* __restrict__ Ow, int ldo, int NT, int qk_rel0  , float C, float sinkl,
                                          ATT_LAS unsigned char* shm, const ATT_LAS float* bt) {
    constexpr int NQ = SWA ? 8 : 12;
    constexpr int PIECES = SWA ? 4 : 5;
    int tid_ = threadIdx.x; asm volatile("" : "+v"(tid_));
    const int tid = tid_, lane = tid & 63, r32 = lane & 31, hi = lane >> 5; const int wid = __builtin_amdgcn_readfirstlane(tid >> 6);
    const unsigned lds0 = (unsigned)(size_t)shm;
    ATT_LAS float* wsf = (ATT_LAS float*)(shm + WSC_OFF) + wid * 64;
    const bf16_t* ksrc0; const bf16_t* ksrc1; const bf16_t* rsrc = nullptr; const bf16_t* vsrc0; const bf16_t* vsrc1;
    { int R, c; kn_inv(wid * 1024 + lane * 16, R, c); ksrc0 = Kn + (size_t)R * ldk + c * 8; kn_inv((wid + 8) * 1024 + lane * 16, R, c); ksrc1 = Kn + (size_t)R * ldk + c * 8;
      if (!SWA) { kr_inv(wid * 1024 + lane * 16, R, c); rsrc = Kr + (size_t)R * 64 + c * 8; }
      int k, col; v_inv(wid * 1024 + lane * 16, k, col); vsrc0 = Vg + (size_t)k * ldk + col; v_inv((wid + 8) * 1024 + lane * 16, k, col); vsrc1 = Vg + (size_t)k * ldk + col; }
    const size_t tstep = (size_t)64 * ldk;
    const unsigned dk0 = lds0 + KN_OFF + wid * 1024, dk1 = dk0 + 8192, dr = lds0 + KR_OFF + wid * 1024, dv0 = lds0 + V_OFF + wid * 1024, dv1 = dv0 + 8192;
#define ATT_ISSUE(t, s, sv) do { const size_t to_ = (size_t)(t) * tstep; const unsigned s_ = (unsigned)(s), sv_ = (unsigned)(sv); \
        glds16(ksrc0 + to_, (unsigned)__builtin_amdgcn_readfirstlane(dk0 + s_ * KN_SLOT)); glds16(ksrc1 + to_, (unsigned)__builtin_amdgcn_readfirstlane(dk1 + s_ * KN_SLOT)); \
        if (!SWA) glds16(rsrc + (size_t)(t) * 64 * 64, (unsigned)__builtin_amdgcn_readfirstlane(dr + s_ * KR_SLOT)); \
        glds16(vsrc0 + to_, (unsigned)__builtin_amdgcn_readfirstlane(dv0 + sv_ * V_SLOT)); glds16(vsrc1 + to_, (unsigned)__builtin_amdgcn_readfirstlane(dv1 + sv_ * V_SLOT)); } while (0)
    ATT_ISSUE(0, 0, 0); if (NT > 1) ATT_ISSUE(1, 1, 1);
    bf16x8 qr[NQ];
#pragma unroll
    for (int d0 = 0; d0 < NQ; ++d0) qr[d0] = *(const bf16x8*)(Qw + (size_t)r32 * ldq + d0 * 16 + hi * 8);
#pragma unroll
    for (int d0 = 0; d0 < NQ; ++d0) asm volatile("" : "+v"(qr[d0]));
    constexpr float THR = 8.f;
    float m_reg = SWA ? sinkl : 0.f, l_reg = SWA ? 1.f : 0.f;
    f32x16 negm;
#pragma unroll
    for (int r = 0; r < 16; ++r) negm[r] = 0.f;
    f32x16 o[4];
#pragma unroll
    for (int d = 0; d < 4; ++d)
#pragma unroll
        for (int r = 0; r < 16; ++r) o[d][r] = 0.f;
    const ATT_LAS unsigned char* kn0 = shm + KN_OFF; const ATT_LAS unsigned char* kr0 = shm + KR_OFF;
    const int vb0 = (int)(lds0 + V_OFF) + v_rd_base(lane);
    int s_cur = 0, s_n2 = 2, v_cur = 0, v_n2 = 2;
    ATT_WAIT_BAR(0);
    if (wid >= 4) asm volatile("s_barrier" ::: "memory");
    for (int j = 0; j < NT; ++j) {
        if (j + 2 < NT) ATT_ISSUE(j + 2, s_n2, v_n2);
        ATT_SBAR();
        f32x16 p0, p1;
        { const ATT_LAS unsigned char* kb = kn0 + s_cur * KN_SLOT; const ATT_LAS unsigned char* rb = kr0 + s_cur * KR_SLOT;
#define ATT_KF(d0_, half_) ((d0_) < 8 ? *(const ATT_LAS bf16x8*)(kb + kn_byte((half_) * 32 + r32, (d0_) * 2 + hi)) : *(const ATT_LAS bf16x8*)(rb + kr_byte((half_) * 32 + r32, ((d0_) - 8) * 2 + hi)))
          bf16x8 fa[NQ + 2], fb[NQ + 2];
          fa[0] = ATT_KF(0, 0); fb[0] = ATT_KF(0, 1); fa[1] = ATT_KF(1, 0); fb[1] = ATT_KF(1, 1);
#pragma unroll
          for (int d0 = 0; d0 < NQ; ++d0) {
              if (d0 + 2 < NQ) { fa[d0 + 2] = ATT_KF(d0 + 2, 0); fb[d0 + 2] = ATT_KF(d0 + 2, 1); }
              ATT_SBAR();
              if (d0 == 0) { p0 = __builtin_amdgcn_mfma_f32_32x32x16_bf16(fa[0], qr[0], negm, 0, 0, 0); p1 = __builtin_amdgcn_mfma_f32_32x32x16_bf16(fb[0], qr[0], negm, 0, 0, 0); }
              else { p0 = __builtin_amdgcn_mfma_f32_32x32x16_bf16(fa[d0], qr[d0], p0, 0, 0, 0); p1 = __builtin_amdgcn_mfma_f32_32x32x16_bf16(fb[d0], qr[d0], p1, 0, 0, 0); }
              ATT_SBAR();
          }
#undef ATT_KF
        }
        ATT_SBAR();
        if (j + 2 < NT) { ATT_WAIT_BAR(PIECES); } else { ATT_WAIT_BAR(0); }
        ATT_SBAR();
        if constexpr (SWA) {
            const ATT_LAS float* btb = bt + (qk_rel0 + j * 64 - r32 + BT_ZERO + 4 * hi);
#pragma unroll
            for (int r = 0; r < 16; ++r) { const int cr = (r & 3) + 8 * (r >> 2);
                p0[r] = fmaf(p0[r], C, btb[cr]); p1[r] = fmaf(p1[r], C, btb[cr + 32]); }
            float pmax = p0[0];
#pragma unroll
            for (int r = 1; r < 16; ++r) pmax = fmaxf(pmax, p0[r]);
#pragma unroll
            for (int r = 0; r < 16; ++r) pmax = fmaxf(pmax, p1[r]);
            { auto rr = __builtin_amdgcn_permlane32_swap(__float_as_uint(pmax), __float_as_uint(pmax), false, false); pmax = fmaxf(__uint_as_float(rr[0]), __uint_as_float(rr[1])); }
            const float mn = fmaxf(m_reg, pmax), alpha = __builtin_amdgcn_exp2f(m_reg - mn); m_reg = mn;
            float ps = 0.f;
#pragma unroll
            for (int r = 0; r < 16; ++r) { p0[r] = __builtin_amdgcn_exp2f(p0[r] - mn); p1[r] = __builtin_amdgcn_exp2f(p1[r] - mn); ps += p0[r] + p1[r]; }
            { auto rr = __builtin_amdgcn_permlane32_swap(__float_as_uint(ps), __float_as_uint(ps), false, false); ps = __uint_as_float(rr[0]) + __uint_as_float(rr[1]); }
            l_reg = l_reg * alpha + ps;
            if (__any(alpha < 1.f)) { if (hi == 0) wsf[r32] = alpha; asm volatile("s_waitcnt lgkmcnt(0)" ::: "memory");
#pragma unroll
                for (int r = 0; r < 16; ++r) { const float a = wsf[crow(r, hi)];
#pragma unroll
                    for (int d = 0; d < 4; ++d) o[d][r] *= a; }
                asm volatile("s_waitcnt lgkmcnt(0)" ::: "memory"); }
        } else {
#define ATT_MX3(a, b, c) __builtin_fmaxf(__builtin_fmaxf((a), (b)), (c))
            float ma = ATT_MX3(p0[0], p0[1], p1[0]), mb = ATT_MX3(p0[2], p0[3], p1[1]); ma = ATT_MX3(ma, p1[2], p1[3]);
#pragma unroll
            for (int r = 4; r < 16; r += 4) { ma = ATT_MX3(ma, p0[r], p0[r + 1]); mb = ATT_MX3(mb, p0[r + 2], p0[r + 3]); ma = ATT_MX3(ma, p1[r], p1[r + 1]); mb = ATT_MX3(mb, p1[r + 2], p1[r + 3]); }
#undef ATT_MX3
            float pmax = __builtin_fmaxf(ma, mb);
            { auto rr = __builtin_amdgcn_permlane32_swap(__float_as_uint(pmax), __float_as_uint(pmax), false, false); pmax = __builtin_fmaxf(__uint_as_float(rr[0]), __uint_as_float(rr[1])); }
            if (j == 0 || __any(pmax > THR)) {
                const float dl = (j == 0) ? pmax : __builtin_fmaxf(pmax, 0.f); m_reg += dl;
#pragma unroll
                for (int r = 0; r < 16; ++r) { p0[r] -= dl; p1[r] -= dl; negm[r] = -m_reg; }
                const float f = __builtin_amdgcn_exp2f(-dl); l_reg *= f;
                if (j != 0) { if (hi == 0) wsf[r32] = f; asm volatile("s_waitcnt lgkmcnt(0)" ::: "memory");
#pragma unroll
                    for (int r = 0; r < 16; ++r) { const float a = wsf[crow(r, hi)];
#pragma unroll
                        for (int d = 0; d < 4; ++d) o[d][r] *= a; }
                    asm volatile("s_waitcnt lgkmcnt(0)" ::: "memory"); }
            }
            float ps0 = 0.f, ps1 = 0.f;
#pragma unroll
            for (int r = 0; r < 16; ++r) { p0[r] = __builtin_amdgcn_exp2f(p0[r]); p1[r] = __builtin_amdgcn_exp2f(p1[r]); ps0 += p0[r]; ps1 += p1[r]; }
            float ps = ps0 + ps1;
            { auto rr = __builtin_amdgcn_permlane32_swap(__float_as_uint(ps), __float_as_uint(ps), false, false); ps = __uint_as_float(rr[0]) + __uint_as_float(rr[1]); }
            l_reg += ps;
        }
        bf16x8 pa0, pa1, pa2, pa3;
#define ATT_PK4(P, BASE, OUT) do { unsigned a0 = cvtpk(P[BASE + 0], P[BASE + 1]), a1 = cvtpk(P[BASE + 2], P[BASE + 3]);   \
        unsigned b0_ = cvtpk(P[BASE + 4], P[BASE + 5]), b1_ = cvtpk(P[BASE + 6], P[BASE + 7]);                              \
        auto r0 = __builtin_amdgcn_permlane32_swap(a0, b0_, false, false); auto r1 = __builtin_amdgcn_permlane32_swap(a1, b1_, false, false); \
        u32x4 w = {r0[0], r1[0], r0[1], r1[1]}; OUT = __builtin_bit_cast(bf16x8, w); } while (0)
        ATT_PK4(p0, 0, pa0); ATT_PK4(p0, 8, pa1); ATT_PK4(p1, 0, pa2); ATT_PK4(p1, 8, pa3);
#undef ATT_PK4
        ATT_SBAR();
        { const int vb = vb0 + v_cur * V_SLOT;
          pv_all(o, vb, pa0, pa1, pa2, pa3); }
        ATT_SBAR();
        asm volatile("s_waitcnt lgkmcnt(0)\n\ts_barrier" ::: "memory");
        ATT_SBAR();
        s_cur = (s_cur == 2) ? 0 : s_cur + 1; s_n2 = (s_n2 == 2) ? 0 : s_n2 + 1; v_cur = (v_cur + 1) & 3; v_n2 = (v_n2 + 1) & 3;
    }
    if (wid < 4) asm volatile("s_barrier" ::: "memory");
    if (hi == 0) wsf[32 + r32] = l_reg; asm volatile("s_waitcnt lgkmcnt(0)" ::: "memory");
#pragma unroll
    for (int r = 0; r < 16; ++r) { const int orow = crow(r, hi); const float rl = __builtin_amdgcn_rcpf(wsf[32 + orow]);
#pragma unroll
        for (int d = 0; d < 4; ++d) { const unsigned w = cvtpk(o[d][r] * rl, 0.f); Ow[(size_t)orow * ldo + d * 32 + r32] = (bf16_t)(w & 0xffffu); } }
    asm volatile("s_waitcnt lgkmcnt(0)" ::: "memory");
#undef ATT_ISSUE
}

__host__ __device__ __forceinline__ int v16_byte(int key, int col) { return (((key >> 3) * 8 + (col >> 4)) << 8) + (key & 7) * 32 + (col & 15) * 2; }
__host__ __device__ __forceinline__ void v16_inv(int b, int& key, int& col) { const int s = b >> 8, w = b & 255; key = (s >> 3) * 8 + (w >> 5); col = (s & 7) * 16 + ((w & 31) >> 1); }
__host__ __device__ __forceinline__ int v16_rd_base(int lane) { const int g = lane >> 4, q = (lane & 15) >> 2, p = lane & 3; return (g >> 1) * 2048 + (4 * (g & 1) + q) * 32 + 8 * p; }
__host__ __device__ constexpr int v16_rd_off(int t, int h, int dg) { return (4 * t + 2 * h) * 2048 + dg * 256; }
typedef float f32x4a __attribute__((ext_vector_type(4)));
__device__ __forceinline__ float xmax16(float v) { auto r = __builtin_amdgcn_permlane16_swap(__float_as_uint(v), __float_as_uint(v), false, false); return __builtin_fmaxf(__uint_as_float(r[0]), __uint_as_float(r[1])); }
__device__ __forceinline__ float xmax32(float v) { auto r = __builtin_amdgcn_permlane32_swap(__float_as_uint(v), __float_as_uint(v), false, false); return __builtin_fmaxf(__uint_as_float(r[0]), __uint_as_float(r[1])); }
__device__ __forceinline__ float xsum16(float v) { auto r = __builtin_amdgcn_permlane16_swap(__float_as_uint(v), __float_as_uint(v), false, false); return __uint_as_float(r[0]) + __uint_as_float(r[1]); }
__device__ __forceinline__ float xsum32(float v) { auto r = __builtin_amdgcn_permlane32_swap(__float_as_uint(v), __float_as_uint(v), false, false); return __uint_as_float(r[0]) + __uint_as_float(r[1]); }
template <int OFF> __device__ __forceinline__ s16x4 tr_read16(int vb) { s16x4 r; asm volatile("ds_read_b64_tr_b16 %0, %1 offset:%2" : "=&v"(r) : "v"(vb), "i"(OFF) : "memory"); return r; }

template <int T> __device__ __forceinline__ void pv_half16(f32x4a (&o)[2][8], f32x4a (&ol)[2], bf16x8 onesb, int vb, bf16x8 p0, bf16x8 p1) {
#define ATT_VRD(dg_, lo_, hi_) do { lo_ = tr_read16<v16_rd_off(T, 0, (dg_))>(vb); hi_ = tr_read16<v16_rd_off(T, 1, (dg_))>(vb); } while (0)
#define ATT_PV(dg_, lo_, hi_) do { const bf16x8 b__ = (bf16x8){lo_[0], lo_[1], lo_[2], lo_[3], hi_[0], hi_[1], hi_[2], hi_[3]}; \
        o[0][dg_] = __builtin_amdgcn_mfma_f32_16x16x32_bf16(p0, b__, o[0][dg_], 0, 0, 0); o[1][dg_] = __builtin_amdgcn_mfma_f32_16x16x32_bf16(p1, b__, o[1][dg_], 0, 0, 0); } while (0)
    s16x4 l0, h0, l1, h1, l2, h2, l3, h3;
    ATT_VRD(0, l0, h0); ATT_VRD(1, l1, h1); ATT_VRD(2, l2, h2); ATT_VRD(3, l3, h3);
    asm volatile("s_waitcnt lgkmcnt(6)" ::: "memory"); ATT_SBAR(); ATT_PV(0, l0, h0); ATT_SBAR(); ATT_VRD(4, l0, h0);
    asm volatile("s_waitcnt lgkmcnt(6)" ::: "memory"); ATT_SBAR(); ATT_PV(1, l1, h1); ATT_SBAR(); ATT_VRD(5, l1, h1);
    asm volatile("s_waitcnt lgkmcnt(6)" ::: "memory"); ATT_SBAR(); ATT_PV(2, l2, h2); ATT_SBAR(); ATT_VRD(6, l2, h2);
    asm volatile("s_waitcnt lgkmcnt(6)" ::: "memory"); ATT_SBAR(); ATT_PV(3, l3, h3); ATT_SBAR(); ATT_VRD(7, l3, h3);
    asm volatile("s_waitcnt lgkmcnt(6)" ::: "memory"); ATT_SBAR(); ATT_PV(4, l0, h0); ATT_SBAR();
    asm volatile("s_waitcnt lgkmcnt(4)" ::: "memory"); ATT_SBAR(); ATT_PV(5, l1, h1); ATT_SBAR();
    asm volatile("s_waitcnt lgkmcnt(2)" ::: "memory"); ATT_SBAR(); ATT_PV(6, l2, h2); ATT_SBAR();
    asm volatile("s_waitcnt lgkmcnt(0)" ::: "memory"); ATT_SBAR(); ATT_PV(7, l3, h3);
    ol[0] = __builtin_amdgcn_mfma_f32_16x16x32_bf16(p0, onesb, ol[0], 0, 0, 0); ol[1] = __builtin_amdgcn_mfma_f32_16x16x32_bf16(p1, onesb, ol[1], 0, 0, 0);
    ATT_SBAR();
#undef ATT_PV
#undef ATT_VRD
}
__device__ __forceinline__ float att_max3(float a, float b, float c) { float r; asm("v_max3_f32 %0, %1, %2, %3" : "=v"(r) : "v"(a), "v"(b), "v"(c)); return r; }
__device__ __forceinline__ float att_max2(float a, float b) { float r; asm("v_max_f32_e32 %0, %1, %2" : "=v"(r) : "v"(a), "v"(b)); return r; }
__device__ __forceinline__ void attn_mla16(const bf16_t* __restrict__ Qw, int ldq, const bf16_t* __restrict__ Kn, const bf16_t* __restrict__ Kr, const bf16_t* __restrict__ Vg, int ldk,
                                           bf16_t* __restrict__ Ow, int ldo, int NT, ATT_LAS unsigned char* shm) {
    constexpr int PIECES = 5;
    int tid_ = threadIdx.x; asm volatile("" : "+v"(tid_));
    const int tid = tid_, lane = tid & 63, qi = lane & 15, g = lane >> 4; const int wid = __builtin_amdgcn_readfirstlane(tid >> 6);
    const unsigned lds0 = (unsigned)(size_t)shm;
    ATT_LAS float* wsf = (ATT_LAS float*)(shm + WSC_OFF) + wid * 64;
    unsigned ok0, ok1, orr, ov0, ov1;
    { int R, c; kn_inv(wid * 1024 + lane * 16, R, c); ok0 = (unsigned)(R * ldk + c * 8) * 2u; kn_inv((wid + 8) * 1024 + lane * 16, R, c); ok1 = (unsigned)(R * ldk + c * 8) * 2u;
      kr_inv(wid * 1024 + lane * 16, R, c); orr = (unsigned)(R * 64 + c * 8) * 2u;
      int k, col; v16_inv(wid * 1024 + lane * 16, k, col); ov0 = (unsigned)(k * ldk + col) * 2u; v16_inv((wid + 8) * 1024 + lane * 16, k, col); ov1 = (unsigned)(k * ldk + col) * 2u; }
    const unsigned tstepB = 128u * (unsigned)ldk;
    const char* kp = (const char*)Kn; const char* rp = (const char*)Kr; const char* vp = (const char*)Vg;
    const unsigned dk0 = lds0 + KN_OFF + wid * 1024, dr = lds0 + KR_OFF + wid * 1024, dv0 = lds0 + V_OFF + wid * 1024;
#define ATT_ISSUE16(s, sv) do { const unsigned s_ = (unsigned)(s), sv_ = (unsigned)(sv); \
        glds16x5(ok0, ok1, orr, ov0, ov1, kp, rp, vp, (unsigned)__builtin_amdgcn_readfirstlane(dk0 + s_ * KN_SLOT), (unsigned)__builtin_amdgcn_readfirstlane(dr + s_ * KR_SLOT), (unsigned)__builtin_amdgcn_readfirstlane(dv0 + sv_ * V_SLOT)); \
        kp += tstepB; rp += 64 * 64 * 2; vp += tstepB; } while (0)
    const bool lead = wid < 4;
    ATT_ISSUE16(0, 0); if (NT > 1) ATT_ISSUE16(1, 1); if (!lead && NT > 2) ATT_ISSUE16(2, 2);
    bf16x8 qf[2][6];
#pragma unroll
    for (int qg = 0; qg < 2; ++qg)
#pragma unroll
        for (int s = 0; s < 6; ++s) qf[qg][s] = *(const bf16x8*)(Qw + (size_t)(16 * qg + qi) * ldq + 32 * s + 8 * g);
#pragma unroll
    for (int qg = 0; qg < 2; ++qg)
#pragma unroll
        for (int s = 0; s < 6; ++s) asm volatile("" : "+v"(qf[qg][s]));
    constexpr float THR = 8.f;
    float m_reg[2] = {0.f, 0.f};
    f32x4a ol[2]; ol[0] = (f32x4a){0.f, 0.f, 0.f, 0.f}; ol[1] = ol[0];
    const short one_ = qi == 0 ? (short)0x3F80 : (short)0; const bf16x8 onesb = (bf16x8){one_, one_, one_, one_, one_, one_, one_, one_};
    f32x4a negm[2]; negm[0] = (f32x4a){0.f, 0.f, 0.f, 0.f}; negm[1] = negm[0]; asm volatile("" : "+v"(negm[0]), "+v"(negm[1]));
    f32x4a o[2][8];
#pragma unroll
    for (int qg = 0; qg < 2; ++qg)
#pragma unroll
        for (int dg = 0; dg < 8; ++dg) o[qg][dg] = (f32x4a){0.f, 0.f, 0.f, 0.f};
    const ATT_LAS unsigned char* kn0 = shm + KN_OFF; const ATT_LAS unsigned char* kr0 = shm + KR_OFF;
    const int vb0 = (int)(lds0 + V_OFF) + v16_rd_base(lane);
    int v_cur = 0, v_n2 = 2;
    bf16x8 pq1[2]; pq1[0] = (bf16x8){0, 0, 0, 0, 0, 0, 0, 0}; pq1[1] = pq1[0];
    ATT_WAIT_BAR(0);
    if (wid >= 4) asm volatile("s_barrier" ::: "memory");
    auto tile = [&](auto ks_, const int j) __attribute__((always_inline)) {
        constexpr int KS = decltype(ks_)::value;
        ATT_SBAR();
        if (j > 0) pv_half16<1>(o, ol, onesb, vb0 + ((v_cur + 3) & 3) * V_SLOT, pq1[0], pq1[1]);
        ATT_SBAR();
        f32x4a c[4][2];
        { const ATT_LAS unsigned char* kb = kn0 + KS * KN_SLOT; const ATT_LAS unsigned char* rb = kr0 + KS * KR_SLOT;
#define ATT_KF16(i_) (((i_) >> 2) < 4 ? *(const ATT_LAS bf16x8*)(kb + kn_byte(16 * ((i_) & 3) + qi, 4 * ((i_) >> 2) + g)) : *(const ATT_LAS bf16x8*)(rb + kr_byte(16 * ((i_) & 3) + qi, 4 * (((i_) >> 2) - 4) + g)))
          bf16x8 kf[24 + 4];
          kf[0] = ATT_KF16(0); kf[1] = ATT_KF16(1); kf[2] = ATT_KF16(2); kf[3] = ATT_KF16(3);
#pragma unroll
          for (int i = 0; i < 24; ++i) { const int s = i >> 2, kg = i & 3;
              if (i + 4 < 24) kf[i + 4] = ATT_KF16(i + 4);
              ATT_SBAR();
              if (s == 0) { c[kg][0] = __builtin_amdgcn_mfma_f32_16x16x32_bf16(kf[i], qf[0][0], negm[0], 0, 0, 0); c[kg][1] = __builtin_amdgcn_mfma_f32_16x16x32_bf16(kf[i], qf[1][0], negm[1], 0, 0, 0); }
              else { c[kg][0] = __builtin_amdgcn_mfma_f32_16x16x32_bf16(kf[i], qf[0][s], c[kg][0], 0, 0, 0); c[kg][1] = __builtin_amdgcn_mfma_f32_16x16x32_bf16(kf[i], qf[1][s], c[kg][1], 0, 0, 0); }
              ATT_SBAR();
          }
#undef ATT_KF16
        }
        ATT_SBAR();
        if (lead) asm volatile("s_waitcnt lgkmcnt(0)\n\ts_barrier" ::: "memory"); else if (j + 2 < NT) { ATT_WAIT_BAR(PIECES); } else { ATT_WAIT_BAR(0); }
        ATT_SBAR();
        if (lead) { if (j + 2 < NT) ATT_ISSUE16((KS + 2) % 3, v_n2); } else { if (j + 3 < NT) ATT_ISSUE16(KS, (v_cur + 3) & 3); }
        ATT_SBAR();
        asm volatile("s_nop 7\n\ts_nop 7" ::: "memory");
        float mx[2], mxx;
        { float a_, b_;
          asm volatile("v_max3_f32 %0, %2, %3, %4\n\tv_max3_f32 %1, %5, %6, %7\n\tv_max3_f32 %0, %0, %8, %9\n\tv_max3_f32 %1, %1, %10, %11\n\tv_max3_f32 %0, %0, %12, %13\n\tv_max3_f32 %1, %1, %14, %15\n\t"
                       "v_max3_f32 %0, %0, %16, %17\n\tv_max_f32_e32 %0, %0, %1"
                       : "=&v"(a_), "=&v"(b_)
                       : "v"(c[0][0][0]), "v"(c[0][0][1]), "v"(c[0][0][2]), "v"(c[0][0][3]), "v"(c[1][0][0]), "v"(c[1][0][1]), "v"(c[1][0][2]), "v"(c[1][0][3]),
                         "v"(c[2][0][0]), "v"(c[2][0][1]), "v"(c[2][0][2]), "v"(c[2][0][3]), "v"(c[3][0][0]), "v"(c[3][0][1]), "v"(c[3][0][2]), "v"(c[3][0][3]));
          mx[0] = a_; }
        { float a_, b_, m_;
          asm volatile("v_max3_f32 %0, %3, %4, %5\n\tv_max3_f32 %1, %6, %7, %8\n\tv_max3_f32 %0, %0, %9, %10\n\tv_max3_f32 %1, %1, %11, %12\n\tv_max3_f32 %0, %0, %13, %14\n\tv_max3_f32 %1, %1, %15, %16\n\t"
                       "v_max3_f32 %0, %0, %17, %18\n\tv_max_f32_e32 %0, %0, %1\n\tv_max_f32_e32 %2, %0, %19"
                       : "=&v"(a_), "=&v"(b_), "=&v"(m_)
                       : "v"(c[0][1][0]), "v"(c[0][1][1]), "v"(c[0][1][2]), "v"(c[0][1][3]), "v"(c[1][1][0]), "v"(c[1][1][1]), "v"(c[1][1][2]), "v"(c[1][1][3]),
                         "v"(c[2][1][0]), "v"(c[2][1][1]), "v"(c[2][1][2]), "v"(c[2][1][3]), "v"(c[3][1][0]), "v"(c[3][1][1]), "v"(c[3][1][2]), "v"(c[3][1][3]), "v"(mx[0]));
          mx[1] = a_; mxx = m_; }
        if (j == 0 || __any(mxx > THR)) {
#pragma unroll
            for (int qg = 0; qg < 2; ++qg) {
                const float rmx = xmax32(xmax16(mx[qg]));
                const float dl = (j == 0) ? rmx : __builtin_fmaxf(rmx, 0.f); m_reg[qg] += dl;
#pragma unroll
                for (int kg = 0; kg < 4; ++kg) c[kg][qg] = c[kg][qg] - dl;
                negm[qg] = (f32x4a){-m_reg[qg], -m_reg[qg], -m_reg[qg], -m_reg[qg]}; asm volatile("" : "+v"(negm[qg]));
                const float f = __builtin_amdgcn_exp2f(-dl);
                if (j != 0 && g == 0) wsf[16 * qg + qi] = f; }
            if (j != 0) { asm volatile("s_waitcnt lgkmcnt(0)" ::: "memory");
#pragma unroll
                for (int qg = 0; qg < 2; ++qg) { const f32x4a a = *(const ATT_LAS f32x4a*)(wsf + 16 * qg + 4 * g);
#pragma unroll
                    for (int dg = 0; dg < 8; ++dg) o[qg][dg] = o[qg][dg] * a;
                    ol[qg] = ol[qg] * a; }
                asm volatile("s_waitcnt lgkmcnt(0)" ::: "memory"); }
        }
        bf16x8 pa[2][2];
        { unsigned wq[16];
#define ATT_CREF(f_) c[((f_) >> 2) & 3][(f_) >> 4][(f_) & 3]
#define ATT_EX(f_) asm volatile("v_exp_f32_e32 %0, %0" : "+v"(ATT_CREF(f_)))
#define ATT_CV(k_) asm volatile("v_cvt_pk_bf16_f32 %0, %1, %2" : "=v"(wq[k_]) : "v"(ATT_CREF(2 * (k_))), "v"(ATT_CREF(2 * (k_) + 1)))
#define ATT_E8(b_) ATT_EX((b_)); ATT_EX((b_) + 1); ATT_EX((b_) + 2); ATT_EX((b_) + 3); ATT_EX((b_) + 4); ATT_EX((b_) + 5); ATT_EX((b_) + 6); ATT_EX((b_) + 7)
#define ATT_C8(b_) ATT_CV((b_)); ATT_CV((b_) + 1); ATT_CV((b_) + 2); ATT_CV((b_) + 3); ATT_CV((b_) + 4); ATT_CV((b_) + 5); ATT_CV((b_) + 6); ATT_CV((b_) + 7)
          ATT_E8(0); ATT_E8(8); ATT_C8(0); ATT_E8(16); ATT_E8(24); ATT_C8(8);
#undef ATT_C8
#undef ATT_E8
#define ATT_STEP(k_) (void)0
#undef ATT_STEP
#undef ATT_CV
#undef ATT_EX
#undef ATT_CREF
#pragma unroll
          for (int qg = 0; qg < 2; ++qg)
#pragma unroll
              for (int t = 0; t < 2; ++t) { u32x4 w = {wq[8 * qg + 4 * t], wq[8 * qg + 4 * t + 1], wq[8 * qg + 4 * t + 2], wq[8 * qg + 4 * t + 3]}; pa[qg][t] = __builtin_bit_cast(bf16x8, w); } }
        ATT_SBAR();
        pv_half16<0>(o, ol, onesb, vb0 + v_cur * V_SLOT, pa[0][0], pa[1][0]);
        pq1[0] = pa[0][1]; pq1[1] = pa[1][1];
        ATT_SBAR();
        if (!lead) asm volatile("s_waitcnt lgkmcnt(0)\n\ts_barrier" ::: "memory"); else if (j + 2 < NT) { ATT_WAIT_BAR(PIECES); } else { ATT_WAIT_BAR(0); }
        ATT_SBAR();
        v_cur = (v_cur + 1) & 3; v_n2 = (v_n2 + 1) & 3;
    };
    { int j = 0;
      for (; j + 3 <= NT; j += 3) { tile(std::integral_constant<int, 0>{}, j); tile(std::integral_constant<int, 1>{}, j + 1); tile(std::integral_constant<int, 2>{}, j + 2); }
      if (j < NT) { tile(std::integral_constant<int, 0>{}, j); ++j; if (j < NT) tile(std::integral_constant<int, 1>{}, j); } }
    if (wid < 4) asm volatile("s_barrier" ::: "memory");
    pv_half16<1>(o, ol, onesb, vb0 + ((v_cur + 3) & 3) * V_SLOT, pq1[0], pq1[1]);
    asm volatile("s_waitcnt lgkmcnt(0)\n\ts_barrier" ::: "memory");
    if (qi == 0) { *(ATT_LAS f32x4a*)(wsf + 32 + 4 * g) = ol[0]; *(ATT_LAS f32x4a*)(wsf + 48 + 4 * g) = ol[1]; }
    asm volatile("s_waitcnt lgkmcnt(0)" ::: "memory");
#pragma unroll
    for (int qg = 0; qg < 2; ++qg) { const f32x4a lv = *(const ATT_LAS f32x4a*)(wsf + 32 + 16 * qg + 4 * g);
#pragma unroll
        for (int r = 0; r < 4; ++r) { const float rl = __builtin_amdgcn_rcpf(lv[r]);
#pragma unroll
            for (int dg = 0; dg < 8; ++dg) { const unsigned w = cvtpk(o[qg][dg][r] * rl, 0.f); Ow[(size_t)(16 * qg + 4 * g + r) * ldo + 16 * dg + qi] = (bf16_t)(w & 0xffffu); } } }
    asm volatile("s_waitcnt lgkmcnt(0)" ::: "memory");
#undef ATT_ISSUE16
}
#undef ATT_WAIT_BAR
#undef ATT_SBAR
}
#define GAS __attribute__((address_space(1)))
#define LAS __attribute__((address_space(3)))
typedef unsigned short bf16;
typedef unsigned v4u __attribute__((ext_vector_type(4)));
typedef float f32x4 __attribute__((ext_vector_type(4)));
typedef short bf16x8 __attribute__((ext_vector_type(8)));
typedef GAS unsigned gu32;
typedef GAS unsigned long long gu64;
#define RLX_AGENT __ATOMIC_RELAXED, __HIP_MEMORY_SCOPE_AGENT
#define LDS_WAIT() asm volatile("s_waitcnt lgkmcnt(0)" ::: "memory")
#define VM_WAIT() asm volatile("s_waitcnt vmcnt(0)" ::: "memory")
__device__ __forceinline__ unsigned long long rt() { return __builtin_amdgcn_s_memrealtime(); }
__device__ __forceinline__ unsigned f2bf(float f) { unsigned u = __builtin_bit_cast(unsigned, f); return (u + 0x7fffu + ((u >> 16) & 1u)) >> 16; }
__device__ __forceinline__ unsigned pk2(float lo, float hi) { return f2bf(lo) | (f2bf(hi) << 16); }

#define XB_TMO      128
#define XB_XCNT(j)  (256  + 64 * (j))
#define XB_XSUB(j)  (1280 + 64 * (j))
#define XB_XGEN(j)  (2304 + 64 * (j))
#define XB_TOP      3328
#define XB_TOPGEN   3392
#define XCD_BAR_WORDS 3456
#define XB_SPIN_CAP (1u << 18)

__device__ __forceinline__ unsigned xb_ld(unsigned* p)              { return __hip_atomic_load(p, __ATOMIC_RELAXED, __HIP_MEMORY_SCOPE_AGENT); }
__device__ __forceinline__ unsigned xb_add(unsigned* p, unsigned v) { return __hip_atomic_fetch_add(p, v, __ATOMIC_RELAXED, __HIP_MEMORY_SCOPE_AGENT); }
__device__ __forceinline__ unsigned xb_xcc_id() { return (unsigned)__builtin_amdgcn_s_getreg((3 << 11) | 20) & 0xFu; }
#define XB_SPIN(cond, bar) do { unsigned _sp = 0; while (cond) { __builtin_amdgcn_s_sleep(1); \
    if ((++_sp & 255u) == 0u) { if (xb_ld(&(bar)[XB_TMO])) break; if (_sp > XB_SPIN_CAP) { atomicAdd(&(bar)[XB_TMO], 1u); break; } } } } while (0)

struct XcdBarrier {
    unsigned* bar; unsigned x;
    volatile LAS unsigned* st;
};

__device__ __forceinline__ XcdBarrier xcd_barrier_post(unsigned* bar, volatile LAS unsigned* st) {
    XcdBarrier b; b.bar = bar; b.x = xb_xcc_id(); b.st = st;
    if (threadIdx.x == 0) (void)xb_add(&bar[XB_XCNT(b.x)], 1u);
    return b;
}
__device__ __forceinline__ void xcd_barrier_complete(unsigned* bar, unsigned x, unsigned& nloc, unsigned& nx) {
    const unsigned G = gridDim.x * gridDim.y * gridDim.z;
    unsigned sum, cnt, mine, sp = 0u;
    for (;;) {
        sum = 0u; cnt = 0u; mine = 0u;
#pragma unroll
        for (unsigned j = 0; j < 16; ++j) { const unsigned c = xb_ld(&bar[XB_XCNT(j)]); sum += c; cnt += (c > 0u) ? 1u : 0u; mine = (j == x) ? c : mine; }
        if (sum == G) break;
        __builtin_amdgcn_s_sleep(1);
        if ((++sp & 255u) == 0u) { if (xb_ld(&bar[XB_TMO])) break; if (sp > XB_SPIN_CAP) { atomicAdd(&bar[XB_TMO], 1u); break; } }
    }
    nloc = mine > 0u ? mine : 1u; nx = cnt > 0u ? cnt : 1u;
}

__device__ __forceinline__ void xcd_barrier(const XcdBarrier& b) {
    asm volatile("s_waitcnt vmcnt(0)" ::: "memory");
    __syncthreads();
    if (threadIdx.x == 0) {
        unsigned* bar = b.bar;
        __builtin_amdgcn_s_waitcnt(0);
        unsigned nloc = b.st[0], nx = b.st[1];
        if (nloc == 0u) { xcd_barrier_complete(bar, b.x, nloc, nx); b.st[0] = nloc; b.st[1] = nx; }
        const unsigned old = xb_add(&bar[XB_XSUB(b.x)], 1u);
        const unsigned gen = old / nloc;
        if (old + 1u == (gen + 1u) * nloc) {
            __builtin_amdgcn_fence(__ATOMIC_RELEASE, "agent");
            asm volatile("s_waitcnt vmcnt(0)" ::: "memory");
            const unsigned og = xb_add(&bar[XB_TOP], 1u);
            const unsigned tg = og / nx;
            if (og + 1u == (tg + 1u) * nx) xb_add(&bar[XB_TOPGEN], 1u);
            else XB_SPIN(xb_ld(&bar[XB_TOPGEN]) == tg, bar);
            __builtin_amdgcn_fence(__ATOMIC_ACQUIRE, "agent");
            xb_add(&bar[XB_XGEN(b.x)], 1u);
            asm volatile("s_waitcnt vmcnt(0)" ::: "memory");
        } else {
            XB_SPIN(xb_ld(&bar[XB_XGEN(b.x)]) == gen, bar);
            __builtin_amdgcn_fence(__ATOMIC_ACQUIRE, "agent");
            asm volatile("s_waitcnt vmcnt(0)" ::: "memory");
        }
    }
    __syncthreads();
}

constexpr int NWAVES = 8;
constexpr int T = 24576, TP = 16384, DM = 2048, DFF = 8192, PLE = 256, DEPTH = 4;
constexpr int LATN = 1280;
constexpr float EPS = 1e-6f;
constexpr int MCH = 8192, NCH = 3;
constexpr size_t MiB = 1u << 20;
constexpr size_t WS_CTL = 0, CTL_ZERO_BYTES = 1 * MiB;
constexpr size_t WS_ROT = 1 * MiB;
constexpr size_t WS_BT = 5 * MiB;
constexpr size_t WS_STAT = 6 * MiB;
constexpr size_t SS_XIN = WS_STAT, SS_X2 = WS_STAT + 128 * 1024, SS_E = WS_STAT + 256 * 1024, PS_Q = WS_STAT + 1 * MiB, PS_KV = WS_STAT + 2 * MiB, PS_H = WS_STAT + 3 * MiB, PS_E = WS_STAT + 6 * MiB, PS_X = WS_STAT + 9 * MiB;
constexpr size_t WS_W = 18 * MiB;
constexpr size_t W_MLA = 20 * MiB, W_SWA = 20 * MiB, W_LAYER = 73 * MiB;
constexpr size_t WO_WD = 0, WO_WUQ = 5 * MiB, WO_WUKV = 8 * MiB, WO_WOM = 12 * MiB;
constexpr size_t WO_WQKV = 0, WO_WOS = 12 * MiB;
constexpr size_t WO_UP = 0, WO_DN = 32 * MiB, WO_PU = 64 * MiB, WO_G = 65 * MiB;
constexpr size_t WS_WMLA = WS_W, WS_WSWA = WS_WMLA + 2 * W_MLA, WS_WLAY = WS_WSWA + 2 * W_SWA, WS_WEND = WS_WLAY + 4 * W_LAYER;
constexpr size_t WS_PB = WS_WEND;
constexpr size_t WS_XB = WS_PB + 12 * MiB;
constexpr size_t WS_H = WS_XB + 96 * MiB;
constexpr size_t WS_CQ = WS_H, WS_CKV = WS_H + 24 * MiB;
constexpr size_t WS_R = WS_H + 96 * MiB;
constexpr size_t WS_E = WS_R, WS_HID = WS_R + 96 * MiB;
constexpr size_t WS_Q = WS_R, WS_KV = WS_R + 144 * MiB, WS_KR = WS_KV + 192 * MiB;
constexpr size_t WS_QKV = WS_R;
constexpr size_t WS_XB1_UNUSED = WS_R + 144 * MiB;
constexpr size_t WS_END = WS_KR + 3 * MiB;
static_assert(PS_X + (size_t)T * 32 * 4 <= WS_W && WS_HID + 128 * MiB <= WS_END && WS_END <= 1000 * MiB, "d_ws map");
constexpr int CW_BAR = 4096;
constexpr int RING_OFF = 0, RING_BYTES = 131072;
constexpr int LDSCTL_OFF = 143360, MISC_OFF = LDSCTL_OFF + 320;
constexpr int LDS_BYTES = 147456;
static_assert(MISC_OFF + 128 <= LDS_BYTES && att::ATT_LDS_BYTES <= LDSCTL_OFF && RING_BYTES <= LDSCTL_OFF, "LDS map");

__device__ __forceinline__ float wave_sum(float v) {
#pragma unroll
    for (int o = 1; o < 64; o <<= 1) v += __shfl_xor(v, o);
    return v;
}
__device__ __forceinline__ float sq4(f32x4 v) { return (v.x * v.x + v.y * v.y) + (v.z * v.z + v.w * v.w); }
typedef unsigned u32x2 __attribute__((ext_vector_type(2)));
typedef unsigned u32x4 __attribute__((ext_vector_type(4)));
__device__ __forceinline__ u32x2 pk4(f32x4 v) { u32x2 r; r.x = pg8::cvt_pk_bf16(v.x, v.y); r.y = pg8::cvt_pk_bf16(v.z, v.w); return r; }
__device__ __forceinline__ f32x4 unpk4(u32x2 w) { f32x4 e; e.x = __uint_as_float(w.x << 16); e.y = __uint_as_float(w.x & 0xffff0000u); e.z = __uint_as_float(w.y << 16); e.w = __uint_as_float(w.y & 0xffff0000u); return e; }

__device__ __forceinline__ int cmap(int mode, int n) {
    if (mode == 1) { if (n < 1024) return n; if (n >= 1088) return -1; const int r = n - 1024; return 1024 + (r >> 1) + 32 * (r & 1); }
    if (mode == 2) { const int h = n / 192, r = n % 192; if (r < 128) return n; const int q = r - 128; return h * 192 + 128 + (q >> 1) + 32 * (q & 1); }
    return n;
}
__device__ __forceinline__ void p0_transpose_item(const float* W, int K, int Nsrc, int Ndst, bf16* WT, int mode, const float* gain, LAS float* scr, int item, int lane) {
    const int nblk = Ndst / 32, kb = item / nblk, nb = item % nblk, k0 = 64 * kb, n0 = 32 * nb;
    const int sc = cmap(mode, n0 + (lane & 31));
#pragma unroll 8
    for (int i = 0; i < 32; ++i) { const int kk = 2 * i + (lane >> 5); scr[kk * 33 + (lane & 31)] = sc >= 0 ? W[(size_t)(k0 + kk) * Nsrc + sc] * (gain ? gain[k0 + kk] : 1.f) : 0.f; }
    LDS_WAIT(); asm volatile("" ::: "memory");
    const int c = lane & 7;
#pragma unroll
    for (int j = 0; j < 4; ++j) { const int n = (lane >> 3) + 8 * j; const LAS float* s = scr + (8 * c) * 33 + n;
        v4u o; o.x = pk2(s[0 * 33], s[1 * 33]); o.y = pk2(s[2 * 33], s[3 * 33]); o.z = pk2(s[4 * 33], s[5 * 33]); o.w = pk2(s[6 * 33], s[7 * 33]);
        *(GAS v4u*)(WT + (size_t)(n0 + n) * K + k0 + 8 * c) = o; }
    LDS_WAIT(); asm volatile("" ::: "memory");
}
__device__ __forceinline__ void p0_fast_item(const float* W, int K, int N, bf16* WT, const float* gain, LAS unsigned char* scr, int item, int lane) {
    const int nblk = N / 64, kb = item / nblk, nb = item % nblk, k0 = 64 * kb, n0 = 64 * nb, q = lane & 15, g = lane >> 4;
    f32x4 a[8], b[8];
    const float* src = W + (size_t)(k0 + 2 * g) * N + n0 + 4 * q;
#pragma unroll
    for (int i = 0; i < 8; ++i) { a[i] = *(const f32x4*)(src + (size_t)(8 * i) * N); b[i] = *(const f32x4*)(src + (size_t)(8 * i + 1) * N); }
    if (gain) {
#pragma unroll
        for (int i = 0; i < 8; ++i) { const float ga = gain[k0 + 8 * i + 2 * g], gb = gain[k0 + 8 * i + 2 * g + 1]; a[i] = a[i] * ga; b[i] = b[i] * gb; } }
#pragma unroll
    for (int i = 0; i < 8; ++i)
#pragma unroll
        for (int e = 0; e < 4; ++e) *(LAS unsigned*)(scr + (4 * q + e) * 128 + ((i ^ (q & 7)) << 4) + 4 * g) = pg8::cvt_pk_bf16(a[i][e], b[i][e]);
    LDS_WAIT(); asm volatile("" ::: "memory");
    const int c = lane & 7;
#pragma unroll
    for (int j = 0; j < 8; ++j) { const int n = (lane >> 3) + 8 * j; const v4u v = *(const LAS v4u*)(scr + n * 128 + ((c ^ ((n >> 2) & 7)) << 4));
        *(GAS v4u*)(WT + (size_t)(n0 + n) * K + k0 + 8 * c) = v; }
    LDS_WAIT(); asm volatile("" ::: "memory");
}

template <int R> __device__ __forceinline__ void thin_c_rows(int m0, int stride, int lane, const bf16* XB1, const float* g1, bf16* XB, const bf16* H,
                                                             const float* psh, float* ssx2, const float* pp, const float* psm, bf16* PB) {
    u32x4 hw[R][4], xw[R][4]; float ph[R]; f32x4 pv_[R];
#pragma unroll
    for (int rr = 0; rr < R; ++rr) { const int m = m0 + rr * stride; const bf16* hr = H + (size_t)m * DM; const bf16* xr = XB1 + (size_t)m * DM;
#pragma unroll
        for (int q = 0; q < 4; ++q) { hw[rr][q] = *(const u32x4*)(hr + 512 * q + 8 * lane); xw[rr][q] = *(const u32x4*)(xr + 512 * q + 8 * lane); }
        ph[rr] = lane < 32 ? psh[(size_t)m * 32 + lane] : 0.f;
        const float* pr = m < TP ? pp + (size_t)m * PLE : psm + (size_t)(m - TP) * PLE; pv_[rr] = *(const f32x4*)(pr + 4 * lane); }
#pragma unroll
    for (int rr = 0; rr < R; ++rr) { const int m = m0 + rr * stride;
        const float rh = __builtin_amdgcn_rsqf(wave_sum(ph[rr]) * (1.0f / DM) + EPS); float sx = 0.f;
        f32x4 v[4][2];
#pragma unroll
        for (int q = 0; q < 4; ++q) {
            v[q][0] = unpk4((u32x2){xw[rr][q].x, xw[rr][q].y}) + unpk4((u32x2){hw[rr][q].x, hw[rr][q].y}) * rh * *(const f32x4*)(g1 + 512 * q + 8 * lane);
            v[q][1] = unpk4((u32x2){xw[rr][q].z, xw[rr][q].w}) + unpk4((u32x2){hw[rr][q].z, hw[rr][q].w}) * rh * *(const f32x4*)(g1 + 512 * q + 8 * lane + 4);
            sx += sq4(v[q][0]) + sq4(v[q][1]); }
        sx = wave_sum(sx); if (lane == 0) ssx2[m] = sx;
        { const float rx = __builtin_amdgcn_rsqf(sx * (1.0f / DM) + EPS);
#pragma unroll
          for (int q = 0; q < 4; ++q) { const u32x2 lo = pk4(v[q][0] * rx), hi = pk4(v[q][1] * rx); *(u32x4*)(XB + (size_t)m * DM + 512 * q + 8 * lane) = (u32x4){lo.x, lo.y, hi.x, hi.y}; } }
        *(u32x2*)(PB + (size_t)m * PLE + 4 * lane) = pk4(pv_[rr]); }
}
template <int R> __device__ __forceinline__ void thin_d_rows(int m0, int stride, int lane, const float* g3, bf16* XB, const bf16* H, const float* psh, const float* pse, float* sse, const float* ssx2) {
    u32x4 xw[R][4], hw[R][4]; float ph[R], pe[R], sx2[R];
#pragma unroll
    for (int rr = 0; rr < R; ++rr) { const int m = m0 + rr * stride; const bf16* hr = H + (size_t)m * DM; const bf16* xr = XB + (size_t)m * DM;
#pragma unroll
        for (int q = 0; q < 4; ++q) { hw[rr][q] = *(const u32x4*)(hr + 512 * q + 8 * lane); xw[rr][q] = *(const u32x4*)(xr + 512 * q + 8 * lane); }
        ph[rr] = lane < 32 ? psh[(size_t)m * 32 + lane] : 0.f; pe[rr] = lane < 32 ? pse[(size_t)m * 32 + lane] : 0.f; sx2[rr] = ssx2[m]; }
#pragma unroll
    for (int rr = 0; rr < R; ++rr) { const int m = m0 + rr * stride; bf16* xr = XB + (size_t)m * DM;
        const float rh = __builtin_amdgcn_rsqf(wave_sum(ph[rr]) * (1.0f / DM) + EPS);
        { const float se = wave_sum(pe[rr]); if (lane == 0) sse[m] = se; }
        const float ux = __builtin_sqrtf(sx2[rr] * (1.0f / DM) + EPS);
#pragma unroll
        for (int q = 0; q < 4; ++q) {
            const u32x2 lo = pk4(unpk4((u32x2){xw[rr][q].x, xw[rr][q].y}) * ux + unpk4((u32x2){hw[rr][q].x, hw[rr][q].y}) * rh * *(const f32x4*)(g3 + 512 * q + 8 * lane));
            const u32x2 hi = pk4(unpk4((u32x2){xw[rr][q].z, xw[rr][q].w}) * ux + unpk4((u32x2){hw[rr][q].z, hw[rr][q].w}) * rh * *(const f32x4*)(g3 + 512 * q + 8 * lane + 4));
            *(u32x4*)(xr + 512 * q + 8 * lane) = (u32x4){lo.x, lo.y, hi.x, hi.y}; } }
}

struct Args { const float* in[20]; float* out; unsigned char* ws; };
#define ZERO() ({ int z__; asm volatile("s_mov_b32 %0, 0" : "=s"(z__)); z__; })
#define WSP(T_, off) ((T_*)(args.ws + (size_t)(off) + (size_t)ZERO()))
#define INP(k) (args.in[(k) + ZERO()])
__global__ void __launch_bounds__(NWAVES * 64, 2) trunk_fwd(Args args) {
    extern __shared__ __attribute__((aligned(16))) unsigned char lds_raw[];
    LAS unsigned char* lds = (LAS unsigned char*)lds_raw;
    volatile LAS unsigned* MISC = (volatile LAS unsigned*)(lds + MISC_OFF);
    const int tid = threadIdx.x, lane0 = tid & 63, wave = __builtin_amdgcn_readfirstlane(tid >> 6);
#define LANE_DECL() int lane = lane0; asm volatile("" : "+v"(lane)); int gwl = gw; asm volatile("" : "+s"(gwl))
    const int G = gridDim.x; const int bx = blockIdx.x; const int vcu = (G % 8 == 0) ? (bx % 8) * (G / 8) + bx / 8 : bx;
    for (int u = tid; u < (LDS_BYTES - LDSCTL_OFF) / 4; u += NWAVES * 64) ((LAS unsigned*)(lds + LDSCTL_OFF))[u] = 0u;
    __syncthreads();
    XcdBarrier bar = xcd_barrier_post((unsigned*)(args.ws + WS_CTL) + CW_BAR, MISC + 8);
#define GRID_BAR() xcd_barrier(bar)
    const int gw = vcu * NWAVES + wave, NGW = G * NWAVES;
    constexpr float QSCALE = 0.07216878364870322f * 1.4426950408889634f;

    {
        LANE_DECL(); LAS unsigned char* scr8 = lds + RING_OFF + wave * 16384; LAS float* scr = (LAS float*)scr8;
        unsigned char* ws = args.ws;
        int rot_ = 0;
#define CVT(Wsrc, K_, Nsrc_, Ndst_, dst_, mode_, gain_) do { const int nit_ = ((K_) / 64) * ((Ndst_) / 32); \
            for (int it_ = (gwl + NGW - rot_) % NGW; it_ < nit_; it_ += NGW) p0_transpose_item((Wsrc), (K_), (Nsrc_), (Ndst_), (dst_), (mode_), (gain_), scr, it_, lane); rot_ = (rot_ + nit_) % NGW; } while (0)
#define CVTF(Wsrc, K_, N_, dst_, gain_) do { const int nit_ = ((K_) / 64) * ((N_) / 64); \
            for (int it_ = (gwl + NGW - rot_) % NGW; it_ < nit_; it_ += NGW) p0_fast_item((Wsrc), (K_), (N_), (dst_), (gain_), scr8, it_, lane); rot_ = (rot_ + nit_) % NGW; } while (0)
        const float* gains = args.in[4];
        for (int j = 0; j < 2; ++j) {
            unsigned char* wm = ws + WS_WMLA + j * W_MLA; unsigned char* wsw = ws + WS_WSWA + j * W_SWA;
            CVT(args.in[5] + (size_t)j * DM * 1088, DM, 1088, LATN, (bf16*)(wm + WO_WD), 1, gains + (size_t)(2 * j * 4 + 0) * DM);
            CVT(args.in[8] + (size_t)j * 512 * 3072, 512, 3072, 3072, (bf16*)(wm + WO_WUQ), 2, args.in[6] + j * 512);
            CVTF(args.in[9] + (size_t)j * 512 * 4096, 512, 4096, (bf16*)(wm + WO_WUKV), args.in[7] + j * 512);
            CVTF(args.in[10] + (size_t)j * DM * DM, DM, DM, (bf16*)(wm + WO_WOM), (const float*)nullptr);
            CVTF(args.in[11] + (size_t)j * DM * 3072, DM, 3072, (bf16*)(wsw + WO_WQKV), gains + (size_t)((2 * j + 1) * 4 + 0) * DM);
            CVTF(args.in[13] + (size_t)j * DM * DM, DM, DM, (bf16*)(wsw + WO_WOS), (const float*)nullptr);
        }
        for (int L = 0; L < DEPTH; ++L) {
            unsigned char* wl = ws + WS_WLAY + L * W_LAYER;
            CVTF(args.in[15] + (size_t)L * DM * DFF, DM, DFF, (bf16*)(wl + WO_UP), gains + (size_t)(L * 4 + 2) * DM);
            CVTF(args.in[16] + (size_t)L * DFF * DM, DFF, DM, (bf16*)(wl + WO_DN), (const float*)nullptr);
            CVTF(args.in[17] + (size_t)L * PLE * DM, PLE, DM, (bf16*)(wl + WO_PU), (const float*)nullptr);
            CVTF(args.in[18] + (size_t)L * DM * DM, DM, DM, (bf16*)(wl + WO_G), (const float*)nullptr);
        }
#undef CVT
#undef CVTF
        float* rot = (float*)(ws + WS_ROT);
        for (int i = vcu * (NWAVES * 64) + tid; i < 16384 * 32; i += G * NWAVES * 64) {
            const int pos = i >> 5, d = i & 31; double inv = 1.0; for (int k = 0; k < d; ++k) inv *= 0.74989420933245582730;
            const double turns = (double)pos * inv * 0.15915494309189533577; const float fr = (float)(turns - __builtin_rint(turns));
            rot[2 * i] = __builtin_amdgcn_cosf(fr); rot[2 * i + 1] = __builtin_amdgcn_sinf(fr);
        }
        float* btg = (float*)(ws + WS_BT);
        for (int i = vcu * (NWAVES * 64) + tid; i < 16 * att::BT_STRIDE; i += G * NWAVES * 64) {
            const int h = i / att::BT_STRIDE, idx = i % att::BT_STRIDE, rel = idx - att::BT_ZERO, n = rel < 0 ? -rel : rel;
            int b = n < 8 ? n : 8 + (n >= 12) + (n >= 16) + (n >= 23) + (n >= 32) + (n >= 46) + (n >= 64) + (n >= 91); if (b > 15) b = 15; if (rel > 0) b += 16;
            btg[i] = n <= 128 ? args.in[14][b * 16 + h] * 1.4426950408889634f : -1e30f;
        }
    }
    { LANE_DECL(); const float* xin0 = INP(0); const float* xin1 = INP(1); bf16* XB = (bf16*)(args.out + ZERO()); float* ssx = WSP(float, SS_XIN);
      for (int m = gwl; m < T; m += NGW) {
        const float* xr = m < TP ? xin0 + (size_t)m * DM : xin1 + (size_t)(m - TP) * DM;
        f32x4 v[8]; float ss = 0.f;
#pragma unroll
        for (int q = 0; q < 8; ++q) { v[q] = *(const f32x4*)(xr + 256 * q + 4 * lane); ss += sq4(v[q]); }
        ss = wave_sum(ss);
#pragma unroll
        for (int q = 0; q < 8; ++q) *(u32x2*)(XB + (size_t)m * DM + 256 * q + 4 * lane) = pk4(v[q]);
        if (lane == 0) ssx[m] = ss;
      } }
    GRID_BAR();
    for (int L = 0; L < DEPTH; ++L) {
        const int j = L >> 1; const bool mla = (L & 1) == 0;
        if (mla) {
#ifndef DBG_NO_GEMM
            { pg8::Gemm g{(const bf16*)(args.out + ZERO()), WSP(bf16, WS_WMLA + j * W_MLA + WO_WD), T, LATN, DM}; pg8::StaticOrder S; S.init(T, LATN, G, bx + ZERO());
              pg8::EpiLat E{WSP(bf16, WS_CQ), WSP(bf16, WS_CKV), WSP(bf16, WS_KR), WSP(float, SS_XIN), WSP(float, PS_Q), WSP(float, PS_KV), WSP(float, WS_ROT)};
              pg8::gemm_phase<pg8::EpiLat, pg8::StaticOrder, true, true>(lds + RING_OFF, g, S, E);
            }
#endif
            GRID_BAR();
#ifndef DBG_NO_GEMM
            { pg8::Gemm g{WSP(bf16, WS_CQ), WSP(bf16, WS_WMLA + j * W_MLA + WO_WUQ), T, 3072, 512}; pg8::StaticOrder S; S.init(T, 3072, G, bx + ZERO()); pg8::EpiQRope E{WSP(bf16, WS_Q), 3072, WSP(float, WS_ROT), QSCALE, WSP(float, PS_Q)};
              pg8::gemm_phase<pg8::EpiQRope, pg8::StaticOrder, true, true>(lds + RING_OFF, g, S, E);
            }
            { pg8::Gemm g{WSP(bf16, WS_CKV), WSP(bf16, WS_WMLA + j * W_MLA + WO_WUKV), T, 4096, 512}; pg8::StaticOrder S; S.init(T, 4096, G, bx + ZERO());
              pg8::EpiBf16<0, 8, false> E{WSP(bf16, WS_KV), 4096, WSP(float, PS_KV), 1.0f / 512.0f, nullptr, 0};
              pg8::gemm_phase<pg8::EpiBf16<0, 8, false>, pg8::StaticOrder, true, true>(lds + RING_OFF, g, S, E);
            }
#endif
            GRID_BAR();
#ifndef DBG_NO_MLA
            { const bf16* QB = WSP(bf16, WS_Q); const bf16* KVB = WSP(bf16, WS_KV); const bf16* KRB = WSP(bf16, WS_KR); bf16* OB = WSP(bf16, WS_XB);
              for (int u = vcu; u < 1536; u += G) {
                int s0, S_, h, qb;
                if (u < 1024) { s0 = 0; S_ = TP; h = u >> 6; qb = u & 63; } else { const int v = u - 1024; s0 = TP + (v >> 8) * 4096; S_ = 4096; h = (v & 255) >> 4; qb = v & 15; }
                const int q0 = s0 + qb * 256 + wave * 32;
                att::attn_mla16(QB + (size_t)q0 * 3072 + h * 192, 3072, KVB + (size_t)s0 * 4096 + h * 256, KRB + (size_t)s0 * 64, KVB + (size_t)s0 * 4096 + h * 256 + 128, 4096,
                                OB + (size_t)q0 * DM + h * 128, DM, S_ / 64, lds + RING_OFF);
              } }
#endif
        } else {
#ifndef DBG_NO_GEMM
            { pg8::Gemm g{(const bf16*)(args.out + ZERO()), WSP(bf16, WS_WSWA + j * W_SWA + WO_WQKV), T, 3072, DM}; pg8::StaticOrder S; S.init(T, 3072, G, bx + ZERO());
              pg8::EpiBf16<0, 1, false> E{WSP(bf16, WS_QKV), 3072, WSP(float, SS_XIN), 1.0f / 2048.0f, nullptr, 0};
              pg8::gemm_phase<pg8::EpiBf16<0, 1, false>, pg8::StaticOrder, true, true>(lds + RING_OFF, g, S, E);
            }
#endif
            GRID_BAR();
#ifndef DBG_NO_SWA
            { LAS float* btl = (LAS float*)(lds + RING_OFF + att::BT_OFF); const float* btg = WSP(float, WS_BT);
              int tl = tid; asm volatile("" : "+v"(tl));
              for (int i = tl; i < 16 * att::BT_STRIDE; i += NWAVES * 64) btl[i] = btg[i];
              __syncthreads();
              const float* sink = INP(12) + j * 16; const bf16* QKV = WSP(bf16, WS_QKV); bf16* OB = WSP(bf16, WS_XB);
              for (int u = vcu; u < 1536; u += G) {
                  const int kvh = u / 384, rb = u % 384, q0 = rb * 64; int s0, S_;
                  if (q0 < TP) { s0 = 0; S_ = TP; } else { s0 = TP + ((q0 - TP) >> 12) * 4096; S_ = 4096; }
                  const int lo = max(q0 - 128, s0), hi_ = min(q0 + 192, s0 + S_), NT = (hi_ - lo) >> 6;
                  const int hq = kvh * 4 + (wave & 3), qw = q0 + 32 * (wave >> 2);
                  att::attn_unit<true>(QKV + (size_t)qw * 3072 + hq * 128, 3072, QKV + (size_t)lo * 3072 + 2048 + kvh * 128, nullptr, QKV + (size_t)lo * 3072 + 2560 + kvh * 128, 3072,
                                       OB + (size_t)qw * DM + hq * 128, DM, NT, lo - qw, 0.08838834764831845f * 1.4426950408889634f, sink[hq] * 1.4426950408889634f, lds + RING_OFF, btl + hq * att::BT_STRIDE);
              } }
#endif
        }
        GRID_BAR();
#ifndef DBG_NO_GEMM
        { const bf16* wo = mla ? WSP(bf16, WS_WMLA + j * W_MLA + WO_WOM) : WSP(bf16, WS_WSWA + j * W_SWA + WO_WOS);
          pg8::Gemm g{WSP(bf16, WS_XB), wo, T, DM, DM}; pg8::StaticOrder S; S.init(T, DM, G, bx + ZERO()); pg8::EpiBf16<0, 0, true> E{WSP(bf16, WS_H), DM, nullptr, 0.f, WSP(float, PS_H), 0};
          pg8::gemm_phase<pg8::EpiBf16<0, 0, true>, pg8::StaticOrder, true, true>(lds + RING_OFF, g, S, E);
        }
#endif
        GRID_BAR();
        { LANE_DECL(); const float* xin0 = INP(0); const float* xin1 = INP(1); const bf16* XB1 = (const bf16*)(args.out + ZERO()); const float* g1 = INP(4) + (size_t)(L * 4 + 1) * DM;
          bf16* XB = WSP(bf16, WS_XB); const bf16* H = WSP(bf16, WS_H); const float* psh = WSP(float, PS_H); float* ssx2 = WSP(float, SS_X2);
          const float* pp = INP(2) + (size_t)L * TP * PLE; const float* psm = INP(3) + (size_t)L * (T - TP) * PLE; bf16* PB = WSP(bf16, WS_PB);
          constexpr int RC = 2; int m0 = gwl;
          for (; m0 + (RC - 1) * NGW < T; m0 += RC * NGW) thin_c_rows<RC>(m0, NGW, lane, XB1, g1, XB, H, psh, ssx2, pp, psm, PB);
          for (; m0 < T; m0 += NGW) thin_c_rows<1>(m0, NGW, lane, XB1, g1, XB, H, psh, ssx2, pp, psm, PB);
        }
        GRID_BAR();
        for (int c = 0; c < NCH; ++c) {
#ifndef DBG_NO_GEMM
            { pg8::Gemm g{WSP(bf16, WS_XB) + (size_t)c * MCH * DM, WSP(bf16, WS_WLAY + L * W_LAYER + WO_UP), MCH, DFF, DM}; pg8::StaticOrder S; S.init(MCH, DFF, G, bx + ZERO());
              pg8::EpiBf16<1, 0, false> E{WSP(bf16, WS_HID), DFF, nullptr, 0.f, nullptr, c * MCH};
              pg8::gemm_phase<pg8::EpiBf16<1, 0, false>, pg8::StaticOrder, true, true>(lds + RING_OFF, g, S, E);
            }
#endif
            GRID_BAR();
#ifndef DBG_NO_GEMM
            { pg8::Gemm g{WSP(bf16, WS_HID), WSP(bf16, WS_WLAY + L * W_LAYER + WO_DN), MCH, DM, DFF}; pg8::StaticOrder S; S.init(MCH, DM, G, bx + ZERO());
              pg8::EpiBf16<0, 0, true> E{WSP(bf16, WS_H) + (size_t)c * MCH * DM, DM, nullptr, 0.f, WSP(float, PS_H), c * MCH};
              pg8::gemm_phase<pg8::EpiBf16<0, 0, true>, pg8::StaticOrder, true, true>(lds + RING_OFF, g, S, E);
            }
            if (c == 0) {
              pg8::Gemm g{WSP(bf16, WS_PB), WSP(bf16, WS_WLAY + L * W_LAYER + WO_PU), T, DM, PLE + ZERO()}; pg8::StaticOrder S; S.init(T, DM, G, bx + ZERO());
              pg8::EpiBf16<0, 0, true> E{WSP(bf16, WS_E), DM, nullptr, 0.f, WSP(float, PS_E), 0};
              pg8::gemm_phase<pg8::EpiBf16<0, 0, true>, pg8::StaticOrder, true, true>(lds + RING_OFF, g, S, E);
            }
#endif
            GRID_BAR();
        }
        { LANE_DECL(); const float* g3 = INP(4) + (size_t)(L * 4 + 3) * DM; bf16* XB = WSP(bf16, WS_XB); const bf16* H = WSP(bf16, WS_H); const float* psh = WSP(float, PS_H); const float* pse = WSP(float, PS_E); float* sse = WSP(float, SS_E); const float* ssx2 = WSP(float, SS_X2);
          constexpr int RD = 4; int m0 = gwl;
          for (; m0 + (RD - 1) * NGW < T; m0 += RD * NGW) thin_d_rows<RD>(m0, NGW, lane, g3, XB, H, psh, pse, sse, ssx2);
          for (; m0 < T; m0 += NGW) thin_d_rows<1>(m0, NGW, lane, g3, XB, H, psh, pse, sse, ssx2);
        }
        GRID_BAR();
#ifndef DBG_NO_GEMM
        { pg8::Gemm g{WSP(bf16, WS_XB), WSP(bf16, WS_WLAY + L * W_LAYER + WO_G), T, DM, DM}; pg8::StaticOrder S; S.init(T, DM, G, bx + ZERO());
          pg8::EpiGate E{WSP(bf16, WS_XB), WSP(bf16, WS_E), (L + 1 < DEPTH) ? (bf16*)(args.out + ZERO()) : (bf16*)nullptr, args.out + ZERO(), DM, WSP(float, SS_E), INP(19) + (size_t)L * DM, WSP(float, PS_X)};
          pg8::gemm_phase<pg8::EpiGate, pg8::StaticOrder, true, true>(lds + RING_OFF, g, S, E);
        }
#endif
        if (L + 1 < DEPTH) {
            GRID_BAR();
            { LANE_DECL(); const float* psx = WSP(float, PS_X); float* ssx = WSP(float, SS_XIN);
              for (int m = gwl; m < T; m += NGW) { const float s = wave_sum(lane < 32 ? psx[(size_t)m * 32 + lane] : 0.f); if (lane == 0) ssx[m] = s; } }
            GRID_BAR();
        }
    }
#undef GRID_BAR
}

extern "C" void kernel_launch(void* const* d_in, const int* in_sizes, int n_in, void* d_out, int out_size, void* d_ws, size_t ws_size, hipStream_t stream) {
    static int grid = 0;
    if (grid == 0) {
        if (n_in != 20 || out_size != T * DM || ws_size < WS_END) { fprintf(stderr, "kernel_launch: unexpected shapes: n_in %d out %d ws %zu (need %zu)\n", n_in, out_size, ws_size, (size_t)WS_END); grid = -1; return; }
        int dev = 0, cus = 0, per_cu = 0;
        if (hipGetDevice(&dev) != hipSuccess || hipDeviceGetAttribute(&cus, hipDeviceAttributeMultiprocessorCount, dev) != hipSuccess) { grid = -1; return; }
        if (hipFuncSetAttribute((const void*)trunk_fwd, hipFuncAttributeMaxDynamicSharedMemorySize, LDS_BYTES) != hipSuccess) { fprintf(stderr, "kernel_launch: hipFuncSetAttribute failed\n"); grid = -1; return; }
        if (hipOccupancyMaxActiveBlocksPerMultiprocessor(&per_cu, (const void*)trunk_fwd, NWAVES * 64, LDS_BYTES) != hipSuccess || per_cu < 1) fprintf(stderr, "kernel_launch: occupancy query reports %d\n", per_cu);
        (void)hipGetLastError();
        grid = cus;
    }
    if (grid < 0) return;
    if (hipMemsetAsync((char*)d_ws + WS_CTL, 0, CTL_ZERO_BYTES, stream) != hipSuccess) return;
    Args a{};
    for (int i = 0; i < 20; ++i) a.in[i] = (const float*)d_in[i];
    a.out = (float*)d_out; a.ws = (unsigned char*)d_ws;
    hipLaunchKernelGGL(trunk_fwd, dim3(grid), dim3(NWAVES * 64), LDS_BYTES, stream, a);
    const hipError_t le = hipPeekAtLastError();
    if (le != hipSuccess) fprintf(stderr, "kernel_launch: launch failed: %s\n", hipGetErrorName(le));
}
```

```cpp
#include <hip/hip_runtime.h>
#include <cstdio>
#include <cstdint>
namespace pg8 {
#define PG8_LAS __attribute__((address_space(3)))
typedef unsigned short bf16_t;
typedef short bf16x8 __attribute__((ext_vector_type(8)));
typedef float f32x4 __attribute__((ext_vector_type(4)));
typedef unsigned u32x4 __attribute__((ext_vector_type(4)));
constexpr int BM = 256, BK = 64, HALF = 128, HTB = HALF * BK * 2  , STAGE_BYTES = 8 * HTB, NXCD = 8, WGM = 8;

__host__ __device__ __forceinline__ int lds_byte(int r, int c) { const int st = (r >> 4) * 2 + (c >> 5), rr = r & 15, cc = c & 31, ob = rr * 64 + cc * 2; return st * 1024 + (ob ^ (((ob >> 9) & 1) << 5)); }
__host__ __device__ __forceinline__ void stage_rc(int b, int& R, int& C) { const int st = b / 1024, sb = b % 1024, swz = sb ^ (((sb >> 9) & 1) << 5); R = (st >> 1) * 16 + swz / 64; C = (st & 1) * 32 + (swz % 64) / 2; }
__host__ __device__ __forceinline__ int perm32(int rho) { const int n = rho >> 4, i = rho & 15; return 8 * (i >> 2) + 4 * n + (i & 3); }

struct Unit { int pm, pn; };
struct Gemm { const bf16_t* A; const bf16_t* Bt; int M, N, K; };

struct StaticOrder {
    int nM, nN, nwg, G, c;
    __host__ __device__ void init(int M, int N, int G_, int c_) { nM = M / BM; nN = N / BM; nwg = nM * nN; G = G_; c = c_; }
    __host__ __device__ bool next(int i, Unit& u) const {
        const int L = i * G + c; if (L >= nwg) return false;
        int wgid = L; { const int q = nwg / NXCD, r = nwg % NXCD, xcd = wgid % NXCD, off = wgid / NXCD; wgid = (xcd < r ? xcd * (q + 1) : r * (q + 1) + (xcd - r) * q) + off; }
        const int nig = WGM * nN; int gid, rem;
        if ((nig & (nig - 1)) == 0) { gid = wgid >> __builtin_ctz(nig); rem = wgid & (nig - 1); } else { gid = wgid / nig; rem = wgid % nig; }
        const int fm = gid * WGM, gsz = (nM - fm) < WGM ? (nM - fm) : WGM;
        constexpr int WGM_SH = 3; static_assert((1 << WGM_SH) == WGM, "WGM must be 1 << WGM_SH");
        if (gsz == WGM) { u.pm = fm + (rem & (WGM - 1)); u.pn = rem >> WGM_SH; } else { u.pm = fm + (rem % gsz); u.pn = rem / gsz; }
        return true;
    }
    __device__ __forceinline__ void a_ready(const Unit&) const {}
    __device__ __forceinline__ void done(const Unit&) const {}
};

__device__ __forceinline__ unsigned cvt_pk_bf16(float lo, float hi) { unsigned r; asm volatile("v_cvt_pk_bf16_f32 %0, %1, %2" : "=v"(r) : "v"(lo), "v"(hi)); return r; }
typedef float f32x2 __attribute__((ext_vector_type(2)));

constexpr float RMS_EPS = 1e-6f;
template <int NP> __device__ __forceinline__ float row_rs(const float* ss, int row, float inv_d) {
    float s;
    if (NP == 1) s = ss[row];
    else { const f32x4 a = *(const f32x4*)(ss + (size_t)row * 8), b = *(const f32x4*)(ss + (size_t)row * 8 + 4); s = ((a[0] + a[1]) + (a[2] + a[3])) + ((b[0] + b[1]) + (b[2] + b[3])); }
    return __builtin_amdgcn_rsqf(s * inv_d + RMS_EPS);
}
__device__ __forceinline__ void stat_put(float* ps, int row, int ns, int slot, float part, int fq) {
    part += __shfl_xor(part, 16); part += __shfl_xor(part, 32);
    if (fq == 0) ps[(size_t)row * ns + slot] = part;
}
__device__ __forceinline__ float sq4v(f32x4 v) { return (v[0] * v[0] + v[1] * v[1]) + (v[2] * v[2] + v[3] * v[3]); }

template <int ACT  , int RS  , bool STAT  > struct EpiBf16 {
    static constexpr bool PERM = true, AFTER_DRAIN = false;
    bf16_t* O; int ldc; const float* ss_in; float inv_d; float* ss_out; int row_off;
    __device__ __forceinline__ void operator()(const f32x4 (&acc)[2][2][4][2], const Unit& u, int wr, int wc, int fr, int fq) const {
        const int row0 = u.pm * BM + wr * 64 + fr, col0 = u.pn * BM + wc * 32 + 8 * fq;
#pragma unroll
        for (int ai = 0; ai < 2; ++ai)
#pragma unroll
            for (int m = 0; m < 4; ++m) { const int row = row0 + ai * HALF + m * 16; bf16_t* rowp = O + (size_t)row * ldc + col0;
                float rs = 1.f; if (RS) { rs = row_rs<(RS ? RS : 1)>(ss_in, row_off + row, inv_d); if (ACT == 1) rs = rs * rs; }
                float part = 0.f;
#pragma unroll
                for (int bj = 0; bj < 2; ++bj) { f32x4 v0 = acc[ai][bj][m][0], v1 = acc[ai][bj][m][1];
                    if (ACT == 1) {
#pragma unroll
                        for (int e = 0; e < 4; ++e) { const float a = fmaxf(v0[e], 0.f), b = fmaxf(v1[e], 0.f); v0[e] = a * a; v1[e] = b * b; } }
                    if (RS) { v0 = v0 * rs; v1 = v1 * rs; }
                    if (STAT) part += sq4v(v0) + sq4v(v1);
                    u32x4 w; w.x = cvt_pk_bf16(v0[0], v0[1]); w.y = cvt_pk_bf16(v0[2], v0[3]); w.z = cvt_pk_bf16(v1[0], v1[1]); w.w = cvt_pk_bf16(v1[2], v1[3]);
                    *(u32x4*)(rowp + bj * HALF) = w; }
                if (STAT) stat_put(ss_out, row_off + row, 32, u.pn * 4 + wc, part, fq); }
    }
};
struct EpiLat {
    static constexpr bool PERM = true, AFTER_DRAIN = false;
    bf16_t* CQ; bf16_t* CKV; bf16_t* KR; const float* ss_in; float* ssq; float* sskv; const float* rot;
    __device__ __forceinline__ void operator()(const f32x4 (&acc)[2][2][4][2], const Unit& u, int wr, int wc, int fr, int fq) const {
        const int row0 = u.pm * BM + wr * 64 + fr, col0 = u.pn * BM + wc * 32 + 8 * fq;
        if (u.pn < 4) { float* ssd = u.pn < 2 ? ssq : sskv; bf16_t* C = (u.pn < 2 ? CQ : CKV) + (u.pn & 1) * BM + wc * 32 + 8 * fq;
#pragma unroll
            for (int ai = 0; ai < 2; ++ai)
#pragma unroll
                for (int m = 0; m < 4; ++m) { const int row = row0 + ai * HALF + m * 16; const float rs = row_rs<1>(ss_in, row, 1.0f / 2048.0f); float part = 0.f;
#pragma unroll
                    for (int bj = 0; bj < 2; ++bj) { const f32x4 v0 = acc[ai][bj][m][0] * rs, v1 = acc[ai][bj][m][1] * rs; part += sq4v(v0) + sq4v(v1);
                        u32x4 w; w.x = cvt_pk_bf16(v0[0], v0[1]); w.y = cvt_pk_bf16(v0[2], v0[3]); w.z = cvt_pk_bf16(v1[0], v1[1]); w.w = cvt_pk_bf16(v1[2], v1[3]);
                        *(u32x4*)(C + (size_t)row * 512 + bj * HALF) = w; }
                    stat_put(ssd, row, 8, (u.pn & 1) * 4 + wc, part, fq); }
        } else if (wc < 2) { const int d0 = 16 * wc + 4 * fq;
#pragma unroll
            for (int ai = 0; ai < 2; ++ai)
#pragma unroll
                for (int m = 0; m < 4; ++m) { const int row = row0 + ai * HALF + m * 16; const float rs = row_rs<1>(ss_in, row, 1.0f / 2048.0f); const int pos = row < 16384 ? row : ((row - 16384) & 4095);
                    const f32x4 v0 = acc[ai][0][m][0] * rs, v1 = acc[ai][0][m][1] * rs;
                    const f32x4 cs0 = *(const f32x4*)(rot + ((size_t)pos * 32 + d0) * 2), cs1 = *(const f32x4*)(rot + ((size_t)pos * 32 + d0 + 2) * 2);
                    u32x4 w; w.x = cvt_pk_bf16(v0[0] * cs0[0] - v0[1] * cs0[1], v0[1] * cs0[0] + v0[0] * cs0[1]); w.y = cvt_pk_bf16(v0[2] * cs0[2] - v0[3] * cs0[3], v0[3] * cs0[2] + v0[2] * cs0[3]);
                    w.z = cvt_pk_bf16(v1[0] * cs1[0] - v1[1] * cs1[1], v1[1] * cs1[0] + v1[0] * cs1[1]); w.w = cvt_pk_bf16(v1[2] * cs1[2] - v1[3] * cs1[3], v1[3] * cs1[2] + v1[2] * cs1[3]);
                    *(u32x4*)(KR + (size_t)row * 64 + 32 * wc + 8 * fq) = w; }
        }
    }
};
struct EpiQRope {
    static constexpr bool PERM = true, AFTER_DRAIN = false;
    bf16_t* O; int ldc; const float* rot; float scale; const float* ss_in;
    __device__ __forceinline__ void operator()(const f32x4 (&acc)[2][2][4][2], const Unit& u, int wr, int wc, int fr, int fq) const {
        const int row0 = u.pm * BM + wr * 64 + fr, col0 = u.pn * BM + wc * 32 + 8 * fq;
#pragma unroll
        for (int ai = 0; ai < 2; ++ai)
#pragma unroll
            for (int m = 0; m < 4; ++m) { const int row = row0 + ai * HALF + m * 16; const float rs = row_rs<8>(ss_in, row, 1.0f / 512.0f) * scale; const int pos = row < 16384 ? row : ((row - 16384) & 4095);
#pragma unroll
                for (int bj = 0; bj < 2; ++bj) {
                    const int sb = u.pn * BM + bj * HALF + wc * 32, hr = sb % 192; const bool rope = hr >= 128; const int d0 = ((hr - 128) >> 1) + 4 * fq;
                    f32x4 v0 = acc[ai][bj][m][0] * rs, v1 = acc[ai][bj][m][1] * rs;
                    if (rope) {
                        const f32x4 cs0 = *(const f32x4*)(rot + ((size_t)pos * 32 + d0) * 2), cs1 = *(const f32x4*)(rot + ((size_t)pos * 32 + d0 + 2) * 2);
                        f32x4 o0, o1;
                        o0[0] = v0[0] * cs0[0] - v0[1] * cs0[1]; o0[1] = v0[1] * cs0[0] + v0[0] * cs0[1];
                        o0[2] = v0[2] * cs0[2] - v0[3] * cs0[3]; o0[3] = v0[3] * cs0[2] + v0[2] * cs0[3];
                        o1[0] = v1[0] * cs1[0] - v1[1] * cs1[1]; o1[1] = v1[1] * cs1[0] + v1[0] * cs1[1];
                        o1[2] = v1[2] * cs1[2] - v1[3] * cs1[3]; o1[3] = v1[3] * cs1[2] + v1[2] * cs1[3];
                        v0 = o0; v1 = o1; }
                    u32x4 w; w.x = cvt_pk_bf16(v0[0], v0[1]); w.y = cvt_pk_bf16(v0[2], v0[3]); w.z = cvt_pk_bf16(v1[0], v1[1]); w.w = cvt_pk_bf16(v1[2], v1[3]);
                    *(u32x4*)(O + (size_t)row * ldc + col0 + bj * HALF) = w; } }
    }
};
struct EpiGate {
    static constexpr bool PERM = true, AFTER_DRAIN = false;
    const bf16_t* XBin; const bf16_t* E; bf16_t* XBout; float* OUT; int ldc; const float* sse; const float* pn; float* ss_out;
    __device__ __forceinline__ void operator()(const f32x4 (&acc)[2][2][4][2], const Unit& u, int wr, int wc, int fr, int fq) const {
        const int row0 = u.pm * BM + wr * 64 + fr, col0 = u.pn * BM + wc * 32 + 8 * fq;
        f32x4 g[2][2];
#pragma unroll
        for (int bj = 0; bj < 2; ++bj)
#pragma unroll
            for (int n = 0; n < 2; ++n) g[bj][n] = *(const f32x4*)(pn + col0 + bj * HALF + 4 * n);
#pragma unroll
        for (int am = 0; am < 4; ++am) { const int ai = am >> 1, m0 = (am & 1) * 2;
            u32x4 xw[4][2], ew[4][2]; float re[4];
#pragma unroll
            for (int m = m0; m < m0 + 2; ++m) { const int row = row0 + ai * HALF + m * 16; const size_t off = (size_t)row * ldc + col0; re[m] = sse[row];
#pragma unroll
                for (int bj = 0; bj < 2; ++bj) { xw[m][bj] = *(const u32x4*)(XBin + off + bj * HALF); ew[m][bj] = *(const u32x4*)(E + off + bj * HALF); } }
#pragma unroll
            for (int m = m0; m < m0 + 2; ++m) { const int row = row0 + ai * HALF + m * 16; const size_t off = (size_t)row * ldc + col0; const float rs = __builtin_amdgcn_rsqf(re[m] * (1.0f / 2048.0f) + RMS_EPS); float part = 0.f;
#pragma unroll
                for (int bj = 0; bj < 2; ++bj) { f32x4 r[2];
#pragma unroll
                    for (int n = 0; n < 2; ++n) { const unsigned x0 = n ? xw[m][bj].z : xw[m][bj].x, x1 = n ? xw[m][bj].w : xw[m][bj].y, e0 = n ? ew[m][bj].z : ew[m][bj].x, e1 = n ? ew[m][bj].w : ew[m][bj].y;
                        f32x4 x; x[0] = __uint_as_float(x0 << 16); x[1] = __uint_as_float(x0 & 0xffff0000u); x[2] = __uint_as_float(x1 << 16); x[3] = __uint_as_float(x1 & 0xffff0000u);
                        f32x4 ev; ev[0] = __uint_as_float(e0 << 16); ev[1] = __uint_as_float(e0 & 0xffff0000u); ev[2] = __uint_as_float(e1 << 16); ev[3] = __uint_as_float(e1 & 0xffff0000u);
                        ev = ev * g[bj][n] * rs; const f32x4 a = acc[ai][bj][m][n];
#pragma unroll
                        for (int k = 0; k < 4; ++k) { const float sg = __builtin_amdgcn_rcpf(1.0f + __builtin_amdgcn_exp2f(-1.4426950408889634f * a[k])); r[n][k] = x[k] + ev[k] * sg; } }
                    if (XBout) { part += sq4v(r[0]) + sq4v(r[1]); u32x4 w; w.x = cvt_pk_bf16(r[0][0], r[0][1]); w.y = cvt_pk_bf16(r[0][2], r[0][3]); w.z = cvt_pk_bf16(r[1][0], r[1][1]); w.w = cvt_pk_bf16(r[1][2], r[1][3]);
                        *(u32x4*)(XBout + off + bj * HALF) = w; }
                    else { *(f32x4*)(OUT + off + bj * HALF) = r[0]; *(f32x4*)(OUT + off + bj * HALF + 4) = r[1]; } }
                if (XBout) stat_put(ss_out, row, 32, u.pn * 4 + wc, part, fq); }
            asm volatile("" ::: "memory"); }
    }
};
__device__ __forceinline__ void pg8_dma2(unsigned v0, unsigned v1, const void* base, unsigned dst) { unsigned keep;
    asm volatile("s_mov_b32 %0, m0\n\ts_mov_b32 m0, %4\n\ts_nop 0\n\tglobal_load_lds_dwordx4 %1, %3\n\ts_add_u32 m0, m0, 0x2000\n\ts_nop 0\n\tglobal_load_lds_dwordx4 %2, %3\n\ts_mov_b32 m0, %0"
                 : "=&s"(keep) : "v"(v0), "v"(v1), "s"(base), "s"(dst) : "memory", "scc"); }
__device__ __forceinline__ void pg8_dma6(unsigned v0, unsigned v1, unsigned v2, unsigned v3, unsigned v4, unsigned v5, const void* b0, const void* b1, const void* b2, unsigned d0, unsigned d1, unsigned d2) { unsigned keep;
    asm volatile("s_mov_b32 %0, m0\n\ts_mov_b32 m0, %10\n\ts_nop 0\n\tglobal_load_lds_dwordx4 %1, %7\n\ts_add_u32 m0, m0, 0x2000\n\ts_nop 0\n\tglobal_load_lds_dwordx4 %2, %7\n\t"
                 "s_mov_b32 m0, %11\n\ts_nop 0\n\tglobal_load_lds_dwordx4 %3, %8\n\ts_add_u32 m0, m0, 0x2000\n\ts_nop 0\n\tglobal_load_lds_dwordx4 %4, %8\n\t"
                 "s_mov_b32 m0, %12\n\ts_nop 0\n\tglobal_load_lds_dwordx4 %5, %9\n\ts_add_u32 m0, m0, 0x2000\n\ts_nop 0\n\tglobal_load_lds_dwordx4 %6, %9\n\ts_mov_b32 m0, %0"
                 : "=&s"(keep) : "v"(v0), "v"(v1), "v"(v2), "v"(v3), "v"(v4), "v"(v5), "s"(b0), "s"(b1), "s"(b2), "s"(d0), "s"(d1), "s"(d2) : "memory", "scc"); }
#ifndef PG8_DPOS
#define PG8_DPOS 0
#endif
template <class Epi, class Sched, bool ALIGN_EPI = false, bool SP2 = false>
__device__ __forceinline__ void gemm_phase(PG8_LAS unsigned char* lds, const Gemm g, const Sched& S, const Epi& E) {
    int tid_ = threadIdx.x; asm volatile("" : "+v"(tid_));
    const int tid = tid_, wid = __builtin_amdgcn_readfirstlane(tid >> 6), lane = tid & 63, wr = wid >> 2, wc = wid & 3, fr = lane & 15, fq = lane >> 4;
    const int K = g.K, nt = K / BK;
    unsigned voffA[2], voffB[2];
#pragma unroll
    for (int i = 0; i < 2; ++i) { int R, C; stage_rc(tid * 16 + i * 8192, R, C); const int Rb = Epi::PERM ? ((R & ~31) + perm32(R & 31)) : R;
        voffA[i] = (unsigned)(R * K + C) * 2u; voffB[i] = (unsigned)(Rb * K + C) * 2u; }
    const size_t kstep = (size_t)(BK * 2);
    const size_t hstep = (size_t)HALF * K * 2;
    const size_t tstep = 2 * hstep;
    const unsigned ldsw = (unsigned)wid * 1024u;
    const unsigned ldsb = (unsigned)__builtin_amdgcn_readfirstlane((int)((unsigned)(size_t)lds + ldsw));
    const int aoff = lds_byte(wr * 64 + fr, fq * 8), boff = lds_byte(wc * 32 + fr, fq * 8);
#define PG8_SA(b, h) (((b) * 2 + (h)) * HTB)
#define PG8_SB(b, h) ((4 + (b) * 2 + (h)) * HTB)
#define PG8_STAGE(bufoff, gbase, voff) pg8_dma2((voff)[0], (voff)[1], (gbase), ldsb + (unsigned)(bufoff))
#define PG8_STAGE3(o0, g0, v0, o1, g1, v1, o2, g2, v2) pg8_dma6((v0)[0], (v0)[1], (v1)[0], (v1)[1], (v2)[0], (v2)[1], (g0), (g1), (g2), ldsb + (unsigned)(o0), ldsb + (unsigned)(o1), ldsb + (unsigned)(o2))
#define PG8_LDA(dst, b, h) do { _Pragma("unroll") for (int m = 0; m < 4; ++m) _Pragma("unroll") for (int k = 0; k < 2; ++k) dst[m][k] = *(const PG8_LAS bf16x8*)(lds + PG8_SA(b, h) + aoff + m * 2048 + k * 1024); } while (0)
#define PG8_LDB(dst, b, h) do { _Pragma("unroll") for (int n = 0; n < 2; ++n) _Pragma("unroll") for (int k = 0; k < 2; ++k) dst[n][k] = *(const PG8_LAS bf16x8*)(lds + PG8_SB(b, h) + boff + n * 2048 + k * 1024); } while (0)
#define PG8_MMA(ai, bj, At, Bt) do { __builtin_amdgcn_s_setprio(1); _Pragma("unroll") for (int m = 0; m < 4; ++m) _Pragma("unroll") for (int n = 0; n < 2; ++n) _Pragma("unroll") for (int k = 0; k < 2; ++k) \
        acc[ai][bj][m][n] = __builtin_amdgcn_mfma_f32_16x16x32_bf16(Bt[n][k], At[m][k], acc[ai][bj][m][n], 0, 0, 0); __builtin_amdgcn_s_setprio(0); } while (0)
#define PG8_WAIT_V(n) asm volatile("s_waitcnt vmcnt(" #n ")" ::: "memory")
#define PG8_WAIT_L(n) asm volatile("s_waitcnt lgkmcnt(" #n ")" ::: "memory")
#define PG8_BAR __builtin_amdgcn_s_barrier()
#define PG8_SCHED __builtin_amdgcn_sched_barrier(0)
    Unit cur, nxt; int ui = 0;
    if (!S.next(0, cur)) return;
    typedef double f64x2z __attribute__((ext_vector_type(2)));
    f32x4 acc[2][2][4][2];
#pragma unroll
    for (int a = 0; a < 2; ++a)
#pragma unroll
        for (int b = 0; b < 2; ++b)
#pragma unroll
            for (int m = 0; m < 4; ++m)
#pragma unroll
                for (int n = 0; n < 2; ++n) { double z0_, z1_; asm volatile("v_mov_b64 %0, 0\n\tv_mov_b64 %1, 0" : "=v"(z0_), "=v"(z1_)); const f64x2z zz_ = {z0_, z1_}; acc[a][b][m][n] = __builtin_bit_cast(f32x4, zz_); }
    bf16x8 At[4][2], B0[2][2], B1[2][2];
    const char* cA = (const char*)g.A + (size_t)cur.pm * tstep; const char* cB = (const char*)g.Bt + (size_t)cur.pn * tstep;
    S.a_ready(cur);
    if constexpr (SP2) {
        PG8_STAGE(PG8_SB(0, 0), cB, voffB); PG8_STAGE(PG8_SB(0, 1), cB + hstep, voffB); PG8_STAGE(PG8_SA(0, 0), cA, voffA); PG8_STAGE(PG8_SA(0, 1), cA + hstep, voffA);
        if (wr == 1) PG8_BAR;
        PG8_WAIT_V(2); PG8_BAR;
        PG8_STAGE(PG8_SB(1, 0), cB + kstep, voffB); PG8_STAGE(PG8_SA(1, 0), cA + kstep, voffA); PG8_STAGE(PG8_SB(1, 1), cB + hstep + kstep, voffB);
        PG8_WAIT_V(6); PG8_BAR;
    } else {
        PG8_STAGE(PG8_SB(0, 0), cB, voffB); PG8_STAGE(PG8_SA(0, 0), cA, voffA); PG8_STAGE(PG8_SB(0, 1), cB + hstep, voffB); PG8_STAGE(PG8_SA(0, 1), cA + hstep, voffA);
        if (wr == 1) PG8_BAR;
        PG8_WAIT_V(4); PG8_BAR;
        PG8_STAGE(PG8_SB(1, 0), cB + kstep, voffB); PG8_STAGE(PG8_SA(1, 0), cA + kstep, voffA); PG8_STAGE(PG8_SB(1, 1), cB + hstep + kstep, voffB);
        PG8_WAIT_V(6); PG8_BAR;
    }
    for (;;) {
        const bool has_next = S.next(ui + 1, nxt);
        const char* nA = has_next ? (const char*)g.A + (size_t)nxt.pm * tstep : cA; const char* nB = has_next ? (const char*)g.Bt + (size_t)nxt.pn * tstep : cB;
        for (int t = 0; t < nt; t += 2) {
            const bool last = (t == nt - 2);
            const char* a1 = cA + (size_t)(t + 1) * kstep;
            const char* a2 = last ? nA : cA + (size_t)(t + 2) * kstep; const char* b2 = last ? nB : cB + (size_t)(t + 2) * kstep;
            const char* a3 = a2 + kstep; const char* b3 = b2 + kstep;
            if (last && has_next) S.a_ready(nxt);
            if constexpr (SP2) {
#if PG8_DPOS == 0
            PG8_LDB(B0, 0, 0); PG8_LDB(B1, 0, 1); PG8_SCHED; PG8_LDA(At, 0, 0); PG8_STAGE(PG8_SA(1, 1), a1 + hstep, voffA);
            PG8_WAIT_V(8); PG8_WAIT_L(0); PG8_BAR; PG8_MMA(0, 0, At, B0); PG8_MMA(0, 1, At, B1); PG8_BAR; PG8_SCHED;
#elif PG8_DPOS == 1
            PG8_LDB(B0, 0, 0); PG8_LDB(B1, 0, 1); PG8_SCHED; PG8_LDA(At, 0, 0);
            PG8_WAIT_V(6); PG8_WAIT_L(0); PG8_BAR; PG8_SCHED; PG8_STAGE(PG8_SA(1, 1), a1 + hstep, voffA); PG8_SCHED; PG8_MMA(0, 0, At, B0); PG8_MMA(0, 1, At, B1); PG8_BAR; PG8_SCHED;
#else
            PG8_LDB(B0, 0, 0); PG8_LDB(B1, 0, 1); PG8_SCHED; PG8_LDA(At, 0, 0);
            PG8_WAIT_V(6); PG8_WAIT_L(0); PG8_BAR; PG8_MMA(0, 0, At, B0); PG8_SCHED; PG8_STAGE(PG8_SA(1, 1), a1 + hstep, voffA); PG8_SCHED; PG8_MMA(0, 1, At, B1); PG8_BAR; PG8_SCHED;
#endif
#if PG8_DPOS == 0
            PG8_LDA(At, 0, 1); PG8_STAGE3(PG8_SB(0, 0), b2, voffB, PG8_SB(0, 1), b2 + hstep, voffB, PG8_SA(0, 0), a2, voffA);
            PG8_WAIT_V(8); PG8_WAIT_L(0); PG8_BAR; PG8_MMA(1, 0, At, B0); PG8_MMA(1, 1, At, B1); PG8_BAR; PG8_SCHED;
#elif PG8_DPOS == 1
            PG8_LDA(At, 0, 1);
            PG8_WAIT_V(2); PG8_WAIT_L(0); PG8_BAR; PG8_SCHED; PG8_STAGE3(PG8_SB(0, 0), b2, voffB, PG8_SB(0, 1), b2 + hstep, voffB, PG8_SA(0, 0), a2, voffA); PG8_SCHED; PG8_MMA(1, 0, At, B0); PG8_MMA(1, 1, At, B1); PG8_BAR; PG8_SCHED;
#else
            PG8_LDA(At, 0, 1);
            PG8_WAIT_V(2); PG8_WAIT_L(0); PG8_BAR; PG8_MMA(1, 0, At, B0); PG8_SCHED; PG8_STAGE3(PG8_SB(0, 0), b2, voffB, PG8_SB(0, 1), b2 + hstep, voffB, PG8_SA(0, 0), a2, voffA); PG8_SCHED; PG8_MMA(1, 1, At, B1); PG8_BAR; PG8_SCHED;
#endif
#if PG8_DPOS == 0
            PG8_LDB(B0, 1, 0); PG8_LDB(B1, 1, 1); PG8_SCHED; PG8_LDA(At, 1, 0); PG8_STAGE(PG8_SA(0, 1), a2 + hstep, voffA);
            PG8_WAIT_V(8); PG8_WAIT_L(0); PG8_BAR; PG8_MMA(0, 0, At, B0); PG8_MMA(0, 1, At, B1); PG8_BAR; PG8_SCHED;
#elif PG8_DPOS == 1
            PG8_LDB(B0, 1, 0); PG8_LDB(B1, 1, 1); PG8_SCHED; PG8_LDA(At, 1, 0);
            PG8_WAIT_V(6); PG8_WAIT_L(0); PG8_BAR; PG8_SCHED; PG8_STAGE(PG8_SA(0, 1), a2 + hstep, voffA); PG8_SCHED; PG8_MMA(0, 0, At, B0); PG8_MMA(0, 1, At, B1); PG8_BAR; PG8_SCHED;
#else
            PG8_LDB(B0, 1, 0); PG8_LDB(B1, 1, 1); PG8_SCHED; PG8_LDA(At, 1, 0);
            PG8_WAIT_V(6); PG8_WAIT_L(0); PG8_BAR; PG8_MMA(0, 0, At, B0); PG8_SCHED; PG8_STAGE(PG8_SA(0, 1), a2 + hstep, voffA); PG8_SCHED; PG8_MMA(0, 1, At, B1); PG8_BAR; PG8_SCHED;
#endif
#if PG8_DPOS == 0
            PG8_LDA(At, 1, 1); PG8_STAGE3(PG8_SB(1, 0), b3, voffB, PG8_SB(1, 1), b3 + hstep, voffB, PG8_SA(1, 0), a3, voffA);
            PG8_WAIT_V(8); PG8_WAIT_L(0); PG8_BAR; PG8_MMA(1, 0, At, B0); PG8_MMA(1, 1, At, B1); PG8_BAR; PG8_SCHED;
#elif PG8_DPOS == 1
            PG8_LDA(At, 1, 1);
            PG8_WAIT_V(2); PG8_WAIT_L(0); PG8_BAR; PG8_SCHED; PG8_STAGE3(PG8_SB(1, 0), b3, voffB, PG8_SB(1, 1), b3 + hstep, voffB, PG8_SA(1, 0), a3, voffA); PG8_SCHED; PG8_MMA(1, 0, At, B0); PG8_MMA(1, 1, At, B1); PG8_BAR; PG8_SCHED;
#else
            PG8_LDA(At, 1, 1);
            PG8_WAIT_V(2); PG8_WAIT_L(0); PG8_BAR; PG8_MMA(1, 0, At, B0); PG8_SCHED; PG8_STAGE3(PG8_SB(1, 0), b3, voffB, PG8_SB(1, 1), b3 + hstep, voffB, PG8_SA(1, 0), a3, voffA); PG8_SCHED; PG8_MMA(1, 1, At, B1); PG8_BAR; PG8_SCHED;
#endif
            } else {
            PG8_LDB(B0, 0, 0); PG8_SCHED; PG8_LDA(At, 0, 0); PG8_STAGE(PG8_SA(1, 1), a1 + hstep, voffA);
            PG8_WAIT_L(8); PG8_BAR; PG8_WAIT_L(0); PG8_MMA(0, 0, At, B0); PG8_BAR; PG8_SCHED;
            PG8_LDB(B1, 0, 1); PG8_STAGE(PG8_SB(0, 0), b2, voffB);
            PG8_BAR; PG8_WAIT_L(0); PG8_MMA(0, 1, At, B1); PG8_BAR;
            PG8_LDA(At, 0, 1); PG8_STAGE(PG8_SA(0, 0), a2, voffA);
            PG8_BAR; PG8_WAIT_L(0); PG8_MMA(1, 0, At, B0); PG8_BAR; PG8_SCHED;
            PG8_STAGE(PG8_SB(0, 1), b2 + hstep, voffB);
            PG8_WAIT_V(6); PG8_BAR; PG8_MMA(1, 1, At, B1); PG8_BAR;
            PG8_LDB(B0, 1, 0); PG8_SCHED; PG8_LDA(At, 1, 0); PG8_STAGE(PG8_SA(0, 1), a2 + hstep, voffA);
            PG8_WAIT_L(8); PG8_BAR; PG8_WAIT_L(0); PG8_MMA(0, 0, At, B0); PG8_BAR; PG8_SCHED;
            PG8_LDB(B1, 1, 1); PG8_STAGE(PG8_SB(1, 0), b3, voffB);
            PG8_BAR; PG8_WAIT_L(0); PG8_MMA(0, 1, At, B1); PG8_BAR;
            PG8_LDA(At, 1, 1); PG8_STAGE(PG8_SA(1, 0), a3, voffA);
            PG8_BAR; PG8_WAIT_L(0); PG8_MMA(1, 0, At, B0); PG8_BAR; PG8_SCHED;
            PG8_STAGE(PG8_SB(1, 1), b3 + hstep, voffB);
            PG8_WAIT_V(6); PG8_BAR; PG8_MMA(1, 1, At, B1); PG8_BAR;
            }
        }
        if constexpr (ALIGN_EPI) { if (wr == 0) PG8_BAR; }
        if constexpr (!Epi::AFTER_DRAIN) { E(acc, cur, wr, wc, fr, fq); S.done(cur); }
        if (!has_next) break;
#pragma unroll
        for (int a = 0; a < 2; ++a)
#pragma unroll
            for (int b = 0; b < 2; ++b)
#pragma unroll
                for (int m = 0; m < 4; ++m)
#pragma unroll
                    for (int n = 0; n < 2; ++n) { double z0_, z1_; asm volatile("v_mov_b64 %0, 0\n\tv_mov_b64 %1, 0" : "=v"(z0_), "=v"(z1_)); const f64x2z zz_ = {z0_, z1_}; acc[a][b][m][n] = __builtin_bit_cast(f32x4, zz_); }
        cur = nxt; cA = nA; cB = nB; ++ui;
        if constexpr (ALIGN_EPI) { if (wr == 1) PG8_BAR; }
    }
    PG8_WAIT_V(0);
    if constexpr (!ALIGN_EPI) { if (wr == 0) PG8_BAR; }
    PG8_BAR;
    if constexpr (Epi::AFTER_DRAIN) { E.fused(acc, cur, wr, wc, fr, fq, lds, wid, lane); S.done(cur); }
#undef PG8_SA
#undef PG8_SB
#undef PG8_STAGE
#undef PG8_STAGE3
#undef PG8_LDA
#undef PG8_LDB
#undef PG8_MMA
#undef PG8_WAIT_V
#undef PG8_WAIT_L
#undef PG8_BAR
#undef PG8_SCHED
}
}

#include <type_traits>
namespace att {
typedef short bf16x8 __attribute__((ext_vector_type(8)));
typedef short s16x4 __attribute__((ext_vector_type(4)));
typedef float f32x16 __attribute__((ext_vector_type(16)));
typedef unsigned u32x4 __attribute__((ext_vector_type(4)));
typedef unsigned short bf16_t;
#define ATT_LAS __attribute__((address_space(3)))
#define ATT_SBAR() __builtin_amdgcn_sched_barrier(0)
constexpr int KN_OFF = 0, KN_SLOT = 16384, KR_OFF = 49152, KR_SLOT = 8192, V_OFF = 73728, V_SLOT = 16384, WSC_OFF = V_OFF + 4 * V_SLOT, BT_OFF = KR_OFF, ATT_LDS_BYTES = WSC_OFF + 8 * 256;
constexpr int BT_STRIDE = 384, BT_ZERO = 191;
__host__ __device__ __forceinline__ int crow(int r, int hi) { return (r & 3) + 8 * (r >> 2) + 4 * hi; }
__device__ __forceinline__ unsigned cvtpk(float lo, float hi) { unsigned r; asm volatile("v_cvt_pk_bf16_f32 %0, %1, %2" : "=v"(r) : "v"(lo), "v"(hi)); return r; }
__host__ __device__ __forceinline__ int kn_byte(int R, int c) { return R * 256 + ((c ^ (R & 15)) << 4); }
__host__ __device__ __forceinline__ int kr_byte(int R, int c) { return R * 128 + ((c ^ ((R >> 1) & 7)) << 4); }
__host__ __device__ __forceinline__ int v_st(int k, int c) { const int kk = (k & ~0xC) | ((k & 4) << 1) | ((k & 8) >> 1); return ((kk >> 3) * 4 + (c >> 5)) * 512 + ((kk & 7) * 32 + (c & 31)) * 2; }
__host__ __device__ __forceinline__ int v_rd_base(int lane) { return ((lane & 3) << 3) | (((lane >> 2) & 3) << 6) | (((lane >> 4) & 1) << 5) | (((lane >> 5) & 1) << 8); }
__host__ __device__ constexpr int v_rd_off(int d0, int ks, int half) { return d0 * 512 + ks * 4096 + half * 2048; }
__host__ __device__ __forceinline__ void kn_inv(int b, int& R, int& c) { R = b >> 8; c = ((b >> 4) & 15) ^ (R & 15); }
__host__ __device__ __forceinline__ void kr_inv(int b, int& R, int& c) { R = b >> 7; c = ((b >> 4) & 7) ^ ((R >> 1) & 7); }
__host__ __device__ __forceinline__ void v_inv(int b, int& k, int& col) { const int s = b >> 9, w = b & 511, kk = ((s >> 2) << 3) | (w >> 6); k = (kk & ~0xC) | ((kk & 4) << 1) | ((kk & 8) >> 1); col = (s & 3) * 32 + ((w & 63) >> 1); }

__device__ __forceinline__ void glds16(const void* gsrc, unsigned lds_dst) { unsigned keep;
    asm volatile("s_mov_b32 %0, m0\n\ts_mov_b32 m0, %2\n\ts_nop 0\n\tglobal_load_lds_dwordx4 %1, off\n\ts_mov_b32 m0, %0" : "=&s"(keep) : "v"(gsrc), "s"(lds_dst) : "memory"); }
__device__ __forceinline__ void glds16x5(unsigned ok0, unsigned ok1, unsigned orr, unsigned ov0, unsigned ov1, const void* kb, const void* rb, const void* vb, unsigned dk, unsigned dr, unsigned dv) { unsigned keep;
    asm volatile("s_mov_b32 %0, m0\n\ts_mov_b32 m0, %9\n\ts_nop 0\n\tglobal_load_lds_dwordx4 %1, %6\n\ts_add_u32 m0, m0, 0x2000\n\ts_nop 0\n\tglobal_load_lds_dwordx4 %2, %6\n\t"
                 "s_mov_b32 m0, %10\n\ts_nop 0\n\tglobal_load_lds_dwordx4 %3, %7\n\ts_mov_b32 m0, %11\n\ts_nop 0\n\tglobal_load_lds_dwordx4 %4, %8\n\ts_add_u32 m0, m0, 0x2000\n\ts_nop 0\n\tglobal_load_lds_dwordx4 %5, %8\n\ts_mov_b32 m0, %0"
                 : "=&s"(keep) : "v"(ok0), "v"(ok1), "v"(orr), "v"(ov0), "v"(ov1), "s"(kb), "s"(rb), "s"(vb), "s"(dk), "s"(dr), "s"(dv) : "memory", "scc"); }
template <int OFF> __device__ __forceinline__ s16x4 tr_read(int vb) { s16x4 r; asm volatile("ds_read_b64_tr_b16 %0, %1 offset:%2" : "=&v"(r) : "v"(vb), "i"(OFF) : "memory"); return r; }
struct VFrag { s16x4 l0, h0, l1, h1, l2, h2, l3, h3; };
template <int D0> __device__ __forceinline__ void v_load(VFrag& f, int vb) {
    f.l0 = tr_read<v_rd_off(D0, 0, 0)>(vb); f.h0 = tr_read<v_rd_off(D0, 0, 1)>(vb); f.l1 = tr_read<v_rd_off(D0, 1, 0)>(vb); f.h1 = tr_read<v_rd_off(D0, 1, 1)>(vb);
    f.l2 = tr_read<v_rd_off(D0, 2, 0)>(vb); f.h2 = tr_read<v_rd_off(D0, 2, 1)>(vb); f.l3 = tr_read<v_rd_off(D0, 3, 0)>(vb); f.h3 = tr_read<v_rd_off(D0, 3, 1)>(vb);
}
__device__ __forceinline__ void pv_mma(f32x16& od, const VFrag& f, bf16x8 pa0, bf16x8 pa1, bf16x8 pa2, bf16x8 pa3) {
#define ATT_PK(L, H) (bf16x8){L[0], L[1], L[2], L[3], H[0], H[1], H[2], H[3]}
    od = __builtin_amdgcn_mfma_f32_32x32x16_bf16(pa0, ATT_PK(f.l0, f.h0), od, 0, 0, 0);
    od = __builtin_amdgcn_mfma_f32_32x32x16_bf16(pa1, ATT_PK(f.l1, f.h1), od, 0, 0, 0);
    od = __builtin_amdgcn_mfma_f32_32x32x16_bf16(pa2, ATT_PK(f.l2, f.h2), od, 0, 0, 0);
    od = __builtin_amdgcn_mfma_f32_32x32x16_bf16(pa3, ATT_PK(f.l3, f.h3), od, 0, 0, 0);
#undef ATT_PK
}
__device__ __forceinline__ void pv_all(f32x16* o, int vb, bf16x8 pa0, bf16x8 pa1, bf16x8 pa2, bf16x8 pa3) {
    VFrag fa, fb;
    v_load<0>(fa, vb); v_load<1>(fb, vb);
    asm volatile("s_waitcnt lgkmcnt(8)" ::: "memory"); ATT_SBAR(); pv_mma(o[0], fa, pa0, pa1, pa2, pa3); ATT_SBAR();
    v_load<2>(fa, vb);
    asm volatile("s_waitcnt lgkmcnt(8)" ::: "memory"); ATT_SBAR(); pv_mma(o[1], fb, pa0, pa1, pa2, pa3); ATT_SBAR();
    v_load<3>(fb, vb);
    asm volatile("s_waitcnt lgkmcnt(8)" ::: "memory"); ATT_SBAR(); pv_mma(o[2], fa, pa0, pa1, pa2, pa3); ATT_SBAR();
    asm volatile("s_waitcnt lgkmcnt(0)" ::: "memory"); ATT_SBAR(); pv_mma(o[3], fb, pa0, pa1, pa2, pa3); ATT_SBAR();
}
#define ATT_WAIT_BAR(N) asm volatile("s_waitcnt vmcnt(%0) lgkmcnt(0)\n\ts_barrier" :: "n"(N) : "memory")

template <bool SWA>
__device__ __forceinline__ void attn_unit(const bf16_t* __restrict__ Qw, int ldq, const bf16_t* __restrict__ Kn, const bf16_t* __restrict__ Kr, const bf16_t* __restrict__ Vg, int ldk,
                                          bf16_t* __restrict__ Ow, int ldo, int NT, int qk_rel0  , float C, float sinkl,
                                          ATT_LAS unsigned char* shm, const ATT_LAS float* bt) {
    constexpr int NQ = SWA ? 8 : 12;
    constexpr int PIECES = SWA ? 4 : 5;
    int tid_ = threadIdx.x; asm volatile("" : "+v"(tid_));
    const int tid = tid_, lane = tid & 63, r32 = lane & 31, hi = lane >> 5; const int wid = __builtin_amdgcn_readfirstlane(tid >> 6);
    const unsigned lds0 = (unsigned)(size_t)shm;
    ATT_LAS float* wsf = (ATT_LAS float*)(shm + WSC_OFF) + wid * 64;
    const bf16_t* ksrc0; const bf16_t* ksrc1; const bf16_t* rsrc = nullptr; const bf16_t* vsrc0; const bf16_t* vsrc1;
    { int R, c; kn_inv(wid * 1024 + lane * 16, R, c); ksrc0 = Kn + (size_t)R * ldk + c * 8; kn_inv((wid + 8) * 1024 + lane * 16, R, c); ksrc1 = Kn + (size_t)R * ldk + c * 8;
      if (!SWA) { kr_inv(wid * 1024 + lane * 16, R, c); rsrc = Kr + (size_t)R * 64 + c * 8; }
      int k, col; v_inv(wid * 1024 + lane * 16, k, col); vsrc0 = Vg + (size_t)k * ldk + col; v_inv((wid + 8) * 1024 + lane * 16, k, col); vsrc1 = Vg + (size_t)k * ldk + col; }
    const size_t tstep = (size_t)64 * ldk;
    const unsigned dk0 = lds0 + KN_OFF + wid * 1024, dk1 = dk0 + 8192, dr = lds0 + KR_OFF + wid * 1024, dv0 = lds0 + V_OFF + wid * 1024, dv1 = dv0 + 8192;
#define ATT_ISSUE(t, s, sv) do { const size_t to_ = (size_t)(t) * tstep; const unsigned s_ = (unsigned)(s), sv_ = (unsigned)(sv); \
        glds16(ksrc0 + to_, (unsigned)__builtin_amdgcn_readfirstlane(dk0 + s_ * KN_SLOT)); glds16(ksrc1 + to_, (unsigned)__builtin_amdgcn_readfirstlane(dk1 + s_ * KN_SLOT)); \
        if (!SWA) glds16(rsrc + (size_t)(t) * 64 * 64, (unsigned)__builtin_amdgcn_readfirstlane(dr + s_ * KR_SLOT)); \
        glds16(vsrc0 + to_, (unsigned)__builtin_amdgcn_readfirstlane(dv0 + sv_ * V_SLOT)); glds16(vsrc1 + to_, (unsigned)__builtin_amdgcn_readfirstlane(dv1 + sv_ * V_SLOT)); } while (0)
    ATT_ISSUE(0, 0, 0); if (NT > 1) ATT_ISSUE(1, 1, 1);
    bf16x8 qr[NQ];
#pragma unroll
    for (int d0 = 0; d0 < NQ; ++d0) qr[d0] = *(const bf16x8*)(Qw + (size_t)r32 * ldq + d0 * 16 + hi * 8);
#pragma unroll
    for (int d0 = 0; d0 < NQ; ++d0) asm volatile("" : "+v"(qr[d0]));
    constexpr float THR = 8.f;
    float m_reg = SWA ? sinkl : 0.f, l_reg = SWA ? 1.f : 0.f;
    f32x16 negm;
#pragma unroll
    for (int r = 0; r < 16; ++r) negm[r] = 0.f;
    f32x16 o[4];
#pragma unroll
    for (int d = 0; d < 4; ++d)
#pragma unroll
        for (int r = 0; r < 16; ++r) o[d][r] = 0.f;
    const ATT_LAS unsigned char* kn0 = shm + KN_OFF; const ATT_LAS unsigned char* kr0 = shm + KR_OFF;
    const int vb0 = (int)(lds0 + V_OFF) + v_rd_base(lane);
    int s_cur = 0, s_n2 = 2, v_cur = 0, v_n2 = 2;
    ATT_WAIT_BAR(0);
    if (wid >= 4) asm volatile("s_barrier" ::: "memory");
    for (int j = 0; j < NT; ++j) {
        if (j + 2 < NT) ATT_ISSUE(j + 2, s_n2, v_n2);
        ATT_SBAR();
        f32x16 p0, p1;
        { const ATT_LAS unsigned char* kb = kn0 + s_cur * KN_SLOT; const ATT_LAS unsigned char* rb = kr0 + s_cur * KR_SLOT;
#define ATT_KF(d0_, half_) ((d0_) < 8 ? *(const ATT_LAS bf16x8*)(kb + kn_byte((half_) * 32 + r32, (d0_) * 2 + hi)) : *(const ATT_LAS bf16x8*)(rb + kr_byte((half_) * 32 + r32, ((d0_) - 8) * 2 + hi)))
          bf16x8 fa[NQ + 2], fb[NQ + 2];
          fa[0] = ATT_KF(0, 0); fb[0] = ATT_KF(0, 1); fa[1] = ATT_KF(1, 0); fb[1] = ATT_KF(1, 1);
#pragma unroll
          for (int d0 = 0; d0 < NQ; ++d0) {
              if (d0 + 2 < NQ) { fa[d0 + 2] = ATT_KF(d0 + 2, 0); fb[d0 + 2] = ATT_KF(d0 + 2, 1); }
              ATT_SBAR();
              if (d0 == 0) { p0 = __builtin_amdgcn_mfma_f32_32x32x16_bf16(fa[0], qr[0], negm, 0, 0, 0); p1 = __builtin_amdgcn_mfma_f32_32x32x16_bf16(fb[0], qr[0], negm, 0, 0, 0); }
              else { p0 = __builtin_amdgcn_mfma_f32_32x32x16_bf16(fa[d0], qr[d0], p0, 0, 0, 0); p1 = __builtin_amdgcn_mfma_f32_32x32x16_bf16(fb[d0], qr[d0], p1, 0, 0, 0); }
              ATT_SBAR();
          }
#undef ATT_KF
        }
        ATT_SBAR();
        if (j + 2 < NT) { ATT_WAIT_BAR(PIECES); } else { ATT_WAIT_BAR(0); }
        ATT_SBAR();
        if constexpr (SWA) {
            const ATT_LAS float* btb = bt + (qk_rel0 + j * 64 - r32 + BT_ZERO + 4 * hi);
#pragma unroll
            for (int r = 0; r < 16; ++r) { const int cr = (r & 3) + 8 * (r >> 2);
                p0[r] = fmaf(p0[r], C, btb[cr]); p1[r] = fmaf(p1[r], C, btb[cr + 32]); }
            float pmax = p0[0];
#pragma unroll
            for (int r = 1; r < 16; ++r) pmax = fmaxf(pmax, p0[r]);
#pragma unroll
            for (int r = 0; r < 16; ++r) pmax = fmaxf(pmax, p1[r]);
            { auto rr = __builtin_amdgcn_permlane32_swap(__float_as_uint(pmax), __float_as_uint(pmax), false, false); pmax = fmaxf(__uint_as_float(rr[0]), __uint_as_float(rr[1])); }
            const float mn = fmaxf(m_reg, pmax), alpha = __builtin_amdgcn_exp2f(m_reg - mn); m_reg = mn;
            float ps = 0.f;
#pragma unroll
            for (int r = 0; r < 16; ++r) { p0[r] = __builtin_amdgcn_exp2f(p0[r] - mn); p1[r] = __builtin_amdgcn_exp2f(p1[r] - mn); ps += p0[r] + p1[r]; }
            { auto rr = __builtin_amdgcn_permlane32_swap(__float_as_uint(ps), __float_as_uint(ps), false, false); ps = __uint_as_float(rr[0]) + __uint_as_float(rr[1]); }
            l_reg = l_reg * alpha + ps;
            if (__any(alpha < 1.f)) { if (hi == 0) wsf[r32] = alpha; asm volatile("s_waitcnt lgkmcnt(0)" ::: "memory");
#pragma unroll
                for (int r = 0; r < 16; ++r) { const float a = wsf[crow(r, hi)];
#pragma unroll
                    for (int d = 0; d < 4; ++d) o[d][r] *= a; }
                asm volatile("s_waitcnt lgkmcnt(0)" ::: "memory"); }
        } else {
#define ATT_MX3(a, b, c) __builtin_fmaxf(__builtin_fmaxf((a), (b)), (c))
            float ma = ATT_MX3(p0[0], p0[1], p1[0]), mb = ATT_MX3(p0[2], p0[3], p1[1]); ma = ATT_MX3(ma, p1[2], p1[3]);
#pragma unroll
            for (int r = 4; r < 16; r += 4) { ma = ATT_MX3(ma, p0[r], p0[r + 1]); mb = ATT_MX3(mb, p0[r + 2], p0[r + 3]); ma = ATT_MX3(ma, p1[r], p1[r + 1]); mb = ATT_MX3(mb, p1[r + 2], p1[r + 3]); }
#undef ATT_MX3
            float pmax = __builtin_fmaxf(ma, mb);
            { auto rr = __builtin_amdgcn_permlane32_swap(__float_as_uint(pmax), __float_as_uint(pmax), false, false); pmax = __builtin_fmaxf(__uint_as_float(rr[0]), __uint_as_float(rr[1])); }
            if (j == 0 || __any(pmax > THR)) {
                const float dl = (j == 0) ? pmax : __builtin_fmaxf(pmax, 0.f); m_reg += dl;
#pragma unroll
                for (int r = 0; r < 16; ++r) { p0[r] -= dl; p1[r] -= dl; negm[r] = -m_reg; }
                const float f = __builtin_amdgcn_exp2f(-dl); l_reg *= f;
                if (j != 0) { if (hi == 0) wsf[r32] = f; asm volatile("s_waitcnt lgkmcnt(0)" ::: "memory");
#pragma unroll
                    for (int r = 0; r < 16; ++r) { const float a = wsf[crow(r, hi)];
#pragma unroll
                        for (int d = 0; d < 4; ++d) o[d][r] *= a; }
                    asm volatile("s_waitcnt lgkmcnt(0)" ::: "memory"); }
            }
            float ps0 = 0.f, ps1 = 0.f;
#pragma unroll
            for (int r = 0; r < 16; ++r) { p0[r] = __builtin_amdgcn_exp2f(p0[r]); p1[r] = __builtin_amdgcn_exp2f(p1[r]); ps0 += p0[r]; ps1 += p1[r]; }
            float ps = ps0 + ps1;
            { auto rr = __builtin_amdgcn_permlane32_swap(__float_as_uint(ps), __float_as_uint(ps), false, false); ps = __uint_as_float(rr[0]) + __uint_as_float(rr[1]); }
            l_reg += ps;
        }
        bf16x8 pa0, pa1, pa2, pa3;
#define ATT_PK4(P, BASE, OUT) do { unsigned a0 = cvtpk(P[BASE + 0], P[BASE + 1]), a1 = cvtpk(P[BASE + 2], P[BASE + 3]);   \
        unsigned b0_ = cvtpk(P[BASE + 4], P[BASE + 5]), b1_ = cvtpk(P[BASE + 6], P[BASE + 7]);                              \
        auto r0 = __builtin_amdgcn_permlane32_swap(a0, b0_, false, false); auto r1 = __builtin_amdgcn_permlane32_swap(a1, b1_, false, false); \
        u32x4 w = {r0[0], r1[0], r0[1], r1[1]}; OUT = __builtin_bit_cast(bf16x8, w); } while (0)
        ATT_PK4(p0, 0, pa0); ATT_PK4(p0, 8, pa1); ATT_PK4(p1, 0, pa2); ATT_PK4(p1, 8, pa3);
#undef ATT_PK4
        ATT_SBAR();
        { const int vb = vb0 + v_cur * V_SLOT;
          pv_all(o, vb, pa0, pa1, pa2, pa3); }
        ATT_SBAR();
        asm volatile("s_waitcnt lgkmcnt(0)\n\ts_barrier" ::: "memory");
        ATT_SBAR();
        s_cur = (s_cur == 2) ? 0 : s_cur + 1; s_n2 = (s_n2 == 2) ? 0 : s_n2 + 1; v_cur = (v_cur + 1) & 3; v_n2 = (v_n2 + 1) & 3;
    }
    if (wid < 4) asm volatile("s_barrier" ::: "memory");
    if (hi == 0) wsf[32 + r32] = l_reg; asm volatile("s_waitcnt lgkmcnt(0)" ::: "memory");
#pragma unroll
    for (int r = 0; r < 16; ++r) { const int orow = crow(r, hi); const float rl = __builtin_amdgcn_rcpf(wsf[32 + orow]);
#pragma unroll
        for (int d = 0; d < 4; ++d) { const unsigned w = cvtpk(o[d][r] * rl, 0.f); Ow[(size_t)orow * ldo + d * 32 + r32] = (bf16_t)(w & 0xffffu); } }
    asm volatile("s_waitcnt lgkmcnt(0)" ::: "memory");
#undef ATT_ISSUE
}

__host__ __device__ __forceinline__ int v16_byte(int key, int col) { return (((key >> 3) * 8 + (col >> 4)) << 8) + (key & 7) * 32 + (col & 15) * 2; }
__host__ __device__ __forceinline__ void v16_inv(int b, int& key, int& col) { const int s = b >> 8, w = b & 255; key = (s >> 3) * 8 + (w >> 5); col = (s & 7) * 16 + ((w & 31) >> 1); }
__host__ __device__ __forceinline__ int v16_rd_base(int lane) { const int g = lane >> 4, q = (lane & 15) >> 2, p = lane & 3; return (g >> 1) * 2048 + (4 * (g & 1) + q) * 32 + 8 * p; }
__host__ __device__ constexpr int v16_rd_off(int t, int h, int dg) { return (4 * t + 2 * h) * 2048 + dg * 256; }
typedef float f32x4a __attribute__((ext_vector_type(4)));
__device__ __forceinline__ float xmax16(float v) { auto r = __builtin_amdgcn_permlane16_swap(__float_as_uint(v), __float_as_uint(v), false, false); return __builtin_fmaxf(__uint_as_float(r[0]), __uint_as_float(r[1])); }
__device__ __forceinline__ float xmax32(float v) { auto r = __builtin_amdgcn_permlane32_swap(__float_as_uint(v), __float_as_uint(v), false, false); return __builtin_fmaxf(__uint_as_float(r[0]), __uint_as_float(r[1])); }
__device__ __forceinline__ float xsum16(float v) { auto r = __builtin_amdgcn_permlane16_swap(__float_as_uint(v), __float_as_uint(v), false, false); return __uint_as_float(r[0]) + __uint_as_float(r[1]); }
__device__ __forceinline__ float xsum32(float v) { auto r = __builtin_amdgcn_permlane32_swap(__float_as_uint(v), __float_as_uint(v), false, false); return __uint_as_float(r[0]) + __uint_as_float(r[1]); }
template <int OFF> __device__ __forceinline__ s16x4 tr_read16(int vb) { s16x4 r; asm volatile("ds_read_b64_tr_b16 %0, %1 offset:%2" : "=&v"(r) : "v"(vb), "i"(OFF) : "memory"); return r; }

template <int T> __device__ __forceinline__ void pv_half16(f32x4a (&o)[2][8], f32x4a (&ol)[2], bf16x8 onesb, int vb, bf16x8 p0, bf16x8 p1) {
#define ATT_VRD(dg_, lo_, hi_) do { lo_ = tr_read16<v16_rd_off(T, 0, (dg_))>(vb); hi_ = tr_read16<v16_rd_off(T, 1, (dg_))>(vb); } while (0)
#define ATT_PV(dg_, lo_, hi_) do { const bf16x8 b__ = (bf16x8){lo_[0], lo_[1], lo_[2], lo_[3], hi_[0], hi_[1], hi_[2], hi_[3]}; \
        o[0][dg_] = __builtin_amdgcn_mfma_f32_16x16x32_bf16(p0, b__, o[0][dg_], 0, 0, 0); o[1][dg_] = __builtin_amdgcn_mfma_f32_16x16x32_bf16(p1, b__, o[1][dg_], 0, 0, 0); } while (0)
    s16x4 l0, h0, l1, h1, l2, h2, l3, h3;
    ATT_VRD(0, l0, h0); ATT_VRD(1, l1, h1); ATT_VRD(2, l2, h2); ATT_VRD(3, l3, h3);
    asm volatile("s_waitcnt lgkmcnt(6)" ::: "memory"); ATT_SBAR(); ATT_PV(0, l0, h0); ATT_SBAR(); ATT_VRD(4, l0, h0);
    asm volatile("s_waitcnt lgkmcnt(6)" ::: "memory"); ATT_SBAR(); ATT_PV(1, l1, h1); ATT_SBAR(); ATT_VRD(5, l1, h1);
    asm volatile("s_waitcnt lgkmcnt(6)" ::: "memory"); ATT_SBAR(); ATT_PV(2, l2, h2); ATT_SBAR(); ATT_VRD(6, l2, h2);
    asm volatile("s_waitcnt lgkmcnt(6)" ::: "memory"); ATT_SBAR(); ATT_PV(3, l3, h3); ATT_SBAR(); ATT_VRD(7, l3, h3);
    asm volatile("s_waitcnt lgkmcnt(6)" ::: "memory"); ATT_SBAR(); ATT_PV(4, l0, h0); ATT_SBAR();
    asm volatile("s_waitcnt lgkmcnt(4)" ::: "memory"); ATT_SBAR(); ATT_PV(5, l1, h1); ATT_SBAR();
    asm volatile("s_waitcnt lgkmcnt(2)" ::: "memory"); ATT_SBAR(); ATT_PV(6, l2, h2); ATT_SBAR();
    asm volatile("s_waitcnt lgkmcnt(0)" ::: "memory"); ATT_SBAR(); ATT_PV(7, l3, h3);
    ol[0] = __builtin_amdgcn_mfma_f32_16x16x32_bf16(p0, onesb, ol[0], 0, 0, 0); ol[1] = __builtin_amdgcn_mfma_f32_16x16x32_bf16(p1, onesb, ol[1], 0, 0, 0);
    ATT_SBAR();
#undef ATT_PV
#undef ATT_VRD
}
__device__ __forceinline__ float att_max3(float a, float b, float c) { float r; asm("v_max3_f32 %0, %1, %2, %3" : "=v"(r) : "v"(a), "v"(b), "v"(c)); return r; }
__device__ __forceinline__ float att_max2(float a, float b) { float r; asm("v_max_f32_e32 %0, %1, %2" : "=v"(r) : "v"(a), "v"(b)); return r; }
__device__ __forceinline__ void attn_mla16(const bf16_t* __restrict__ Qw, int ldq, const bf16_t* __restrict__ Kn, const bf16_t* __restrict__ Kr, const bf16_t* __restrict__ Vg, int ldk,
                                           bf16_t* __restrict__ Ow, int ldo, int NT, ATT_LAS unsigned char* shm) {
    constexpr int PIECES = 5;
    int tid_ = threadIdx.x; asm volatile("" : "+v"(tid_));
    const int tid = tid_, lane = tid & 63, qi = lane & 15, g = lane >> 4; const int wid = __builtin_amdgcn_readfirstlane(tid >> 6);
    const unsigned lds0 = (unsigned)(size_t)shm;
    ATT_LAS float* wsf = (ATT_LAS float*)(shm + WSC_OFF) + wid * 64;
    unsigned ok0, ok1, orr, ov0, ov1;
    { int R, c; kn_inv(wid * 1024 + lane * 16, R, c); ok0 = (unsigned)(R * ldk + c * 8) * 2u; kn_inv((wid + 8) * 1024 + lane * 16, R, c); ok1 = (unsigned)(R * ldk + c * 8) * 2u;
      kr_inv(wid * 1024 + lane * 16, R, c); orr = (unsigned)(R * 64 + c * 8) * 2u;
      int k, col; v16_inv(wid * 1024 + lane * 16, k, col); ov0 = (unsigned)(k * ldk + col) * 2u; v16_inv((wid + 8) * 1024 + lane * 16, k, col); ov1 = (unsigned)(k * ldk + col) * 2u; }
    const unsigned tstepB = 128u * (unsigned)ldk;
    const char* kp = (const char*)Kn; const char* rp = (const char*)Kr; const char* vp = (const char*)Vg;
    const unsigned dk0 = lds0 + KN_OFF + wid * 1024, dr = lds0 + KR_OFF + wid * 1024, dv0 = lds0 + V_OFF + wid * 1024;
#define ATT_ISSUE16(s, sv) do { const unsigned s_ = (unsigned)(s), sv_ = (unsigned)(sv); \
        glds16x5(ok0, ok1, orr, ov0, ov1, kp, rp, vp, (unsigned)__builtin_amdgcn_readfirstlane(dk0 + s_ * KN_SLOT), (unsigned)__builtin_amdgcn_readfirstlane(dr + s_ * KR_SLOT), (unsigned)__builtin_amdgcn_readfirstlane(dv0 + sv_ * V_SLOT)); \
        kp += tstepB; rp += 64 * 64 * 2; vp += tstepB; } while (0)
    const bool lead = wid < 4;
    ATT_ISSUE16(0, 0); if (NT > 1) ATT_ISSUE16(1, 1); if (!lead && NT > 2) ATT_ISSUE16(2, 2);
    bf16x8 qf[2][6];
#pragma unroll
    for (int qg = 0; qg < 2; ++qg)
#pragma unroll
        for (int s = 0; s < 6; ++s) qf[qg][s] = *(const bf16x8*)(Qw + (size_t)(16 * qg + qi) * ldq + 32 * s + 8 * g);
#pragma unroll
    for (int qg = 0; qg < 2; ++qg)
#pragma unroll
        for (int s = 0; s < 6; ++s) asm volatile("" : "+v"(qf[qg][s]));
    constexpr float THR = 8.f;
    float m_reg[2] = {0.f, 0.f};
    f32x4a ol[2]; ol[0] = (f32x4a){0.f, 0.f, 0.f, 0.f}; ol[1] = ol[0];
    const short one_ = qi == 0 ? (short)0x3F80 : (short)0; const bf16x8 onesb = (bf16x8){one_, one_, one_, one_, one_, one_, one_, one_};
    f32x4a negm[2]; negm[0] = (f32x4a){0.f, 0.f, 0.f, 0.f}; negm[1] = negm[0]; asm volatile("" : "+v"(negm[0]), "+v"(negm[1]));
    f32x4a o[2][8];
#pragma unroll
    for (int qg = 0; qg < 2; ++qg)
#pragma unroll
        for (int dg = 0; dg < 8; ++dg) o[qg][dg] = (f32x4a){0.f, 0.f, 0.f, 0.f};
    const ATT_LAS unsigned char* kn0 = shm + KN_OFF; const ATT_LAS unsigned char* kr0 = shm + KR_OFF;
    const int vb0 = (int)(lds0 + V_OFF) + v16_rd_base(lane);
    int v_cur = 0, v_n2 = 2;
    bf16x8 pq1[2]; pq1[0] = (bf16x8){0, 0, 0, 0, 0, 0, 0, 0}; pq1[1] = pq1[0];
    ATT_WAIT_BAR(0);
    if (wid >= 4) asm volatile("s_barrier" ::: "memory");
    auto tile = [&](auto ks_, const int j) __attribute__((always_inline)) {
        constexpr int KS = decltype(ks_)::value;
        ATT_SBAR();
        if (j > 0) pv_half16<1>(o, ol, onesb, vb0 + ((v_cur + 3) & 3) * V_SLOT, pq1[0], pq1[1]);
        ATT_SBAR();
        f32x4a c[4][2];
        { const ATT_LAS unsigned char* kb = kn0 + KS * KN_SLOT; const ATT_LAS unsigned char* rb = kr0 + KS * KR_SLOT;
#define ATT_KF16(i_) (((i_) >> 2) < 4 ? *(const ATT_LAS bf16x8*)(kb + kn_byte(16 * ((i_) & 3) + qi, 4 * ((i_) >> 2) + g)) : *(const ATT_LAS bf16x8*)(rb + kr_byte(16 * ((i_) & 3) + qi, 4 * (((i_) >> 2) - 4) + g)))
          bf16x8 kf[24 + 4];
          kf[0] = ATT_KF16(0); kf[1] = ATT_KF16(1); kf[2] = ATT_KF16(2); kf[3] = ATT_KF16(3);
#pragma unroll
          for (int i = 0; i < 24; ++i) { const int s = i >> 2, kg = i & 3;
              if (i + 4 < 24) kf[i + 4] = ATT_KF16(i + 4);
              ATT_SBAR();
              if (s == 0) { c[kg][0] = __builtin_amdgcn_mfma_f32_16x16x32_bf16(kf[i], qf[0][0], negm[0], 0, 0, 0); c[kg][1] = __builtin_amdgcn_mfma_f32_16x16x32_bf16(kf[i], qf[1][0], negm[1], 0, 0, 0); }
              else { c[kg][0] = __builtin_amdgcn_mfma_f32_16x16x32_bf16(kf[i], qf[0][s], c[kg][0], 0, 0, 0); c[kg][1] = __builtin_amdgcn_mfma_f32_16x16x32_bf16(kf[i], qf[1][s], c[kg][1], 0, 0, 0); }
              ATT_SBAR();
          }
#undef ATT_KF16
        }
        ATT_SBAR();
        if (lead) asm volatile("s_waitcnt lgkmcnt(0)\n\ts_barrier" ::: "memory"); else if (j + 2 < NT) { ATT_WAIT_BAR(PIECES); } else { ATT_WAIT_BAR(0); }
        ATT_SBAR();
        if (lead) { if (j + 2 < NT) ATT_ISSUE16((KS + 2) % 3, v_n2); } else { if (j + 3 < NT) ATT_ISSUE16(KS, (v_cur + 3) & 3); }
        ATT_SBAR();
        asm volatile("s_nop 7\n\ts_nop 7" ::: "memory");
        float mx[2], mxx;
        { float a_, b_;
          asm volatile("v_max3_f32 %0, %2, %3, %4\n\tv_max3_f32 %1, %5, %6, %7\n\tv_max3_f32 %0, %0, %8, %9\n\tv_max3_f32 %1, %1, %10, %11\n\tv_max3_f32 %0, %0, %12, %13\n\tv_max3_f32 %1, %1, %14, %15\n\t"
                       "v_max3_f32 %0, %0, %16, %17\n\tv_max_f32_e32 %0, %0, %1"
                       : "=&v"(a_), "=&v"(b_)
                       : "v"(c[0][0][0]), "v"(c[0][0][1]), "v"(c[0][0][2]), "v"(c[0][0][3]), "v"(c[1][0][0]), "v"(c[1][0][1]), "v"(c[1][0][2]), "v"(c[1][0][3]),
                         "v"(c[2][0][0]), "v"(c[2][0][1]), "v"(c[2][0][2]), "v"(c[2][0][3]), "v"(c[3][0][0]), "v"(c[3][0][1]), "v"(c[3][0][2]), "v"(c[3][0][3]));
          mx[0] = a_; }
        { float a_, b_, m_;
          asm volatile("v_max3_f32 %0, %3, %4, %5\n\tv_max3_f32 %1, %6, %7, %8\n\tv_max3_f32 %0, %0, %9, %10\n\tv_max3_f32 %1, %1, %11, %12\n\tv_max3_f32 %0, %0, %13, %14\n\tv_max3_f32 %1, %1, %15, %16\n\t"
                       "v_max3_f32 %0, %0, %17, %18\n\tv_max_f32_e32 %0, %0, %1\n\tv_max_f32_e32 %2, %0, %19"
                       : "=&v"(a_), "=&v"(b_), "=&v"(m_)
                       : "v"(c[0][1][0]), "v"(c[0][1][1]), "v"(c[0][1][2]), "v"(c[0][1][3]), "v"(c[1][1][0]), "v"(c[1][1][1]), "v"(c[1][1][2]), "v"(c[1][1][3]),
                         "v"(c[2][1][0]), "v"(c[2][1][1]), "v"(c[2][1][2]), "v"(c[2][1][3]), "v"(c[3][1][0]), "v"(c[3][1][1]), "v"(c[3][1][2]), "v"(c[3][1][3]), "v"(mx[0]));
          mx[1] = a_; mxx = m_; }
        if (j == 0 || __any(mxx > THR)) {
#pragma unroll
            for (int qg = 0; qg < 2; ++qg) {
                const float rmx = xmax32(xmax16(mx[qg]));
                const float dl = (j == 0) ? rmx : __builtin_fmaxf(rmx, 0.f); m_reg[qg] += dl;
#pragma unroll
                for (int kg = 0; kg < 4; ++kg) c[kg][qg] = c[kg][qg] - dl;
                negm[qg] = (f32x4a){-m_reg[qg], -m_reg[qg], -m_reg[qg], -m_reg[qg]}; asm volatile("" : "+v"(negm[qg]));
                const float f = __builtin_amdgcn_exp2f(-dl);
                if (j != 0 && g == 0) wsf[16 * qg + qi] = f; }
            if (j != 0) { asm volatile("s_waitcnt lgkmcnt(0)" ::: "memory");
#pragma unroll
                for (int qg = 0; qg < 2; ++qg) { const f32x4a a = *(const ATT_LAS f32x4a*)(wsf + 16 * qg + 4 * g);
#pragma unroll
                    for (int dg = 0; dg < 8; ++dg) o[qg][dg] = o[qg][dg] * a;
                    ol[qg] = ol[qg] * a; }
                asm volatile("s_waitcnt lgkmcnt(0)" ::: "memory"); }
        }
        bf16x8 pa[2][2];
        { unsigned wq[16];
#define ATT_CREF(f_) c[((f_) >> 2) & 3][(f_) >> 4][(f_) & 3]
#define ATT_EX(f_) asm volatile("v_exp_f32_e32 %0, %0" : "+v"(ATT_CREF(f_)))
#define ATT_CV(k_) asm volatile("v_cvt_pk_bf16_f32 %0, %1, %2" : "=v"(wq[k_]) : "v"(ATT_CREF(2 * (k_))), "v"(ATT_CREF(2 * (k_) + 1)))
#define ATT_E8(b_) ATT_EX((b_)); ATT_EX((b_) + 1); ATT_EX((b_) + 2); ATT_EX((b_) + 3); ATT_EX((b_) + 4); ATT_EX((b_) + 5); ATT_EX((b_) + 6); ATT_EX((b_) + 7)
#define ATT_C8(b_) ATT_CV((b_)); ATT_CV((b_) + 1); ATT_CV((b_) + 2); ATT_CV((b_) + 3); ATT_CV((b_) + 4); ATT_CV((b_) + 5); ATT_CV((b_) + 6); ATT_CV((b_) + 7)
          ATT_E8(0); ATT_E8(8); ATT_C8(0); ATT_E8(16); ATT_E8(24); ATT_C8(8);
#undef ATT_C8
#undef ATT_E8
#define ATT_STEP(k_) (void)0
#undef ATT_STEP
#undef ATT_CV
#undef ATT_EX
#undef ATT_CREF
#pragma unroll
          for (int qg = 0; qg < 2; ++qg)
#pragma unroll
              for (int t = 0; t < 2; ++t) { u32x4 w = {wq[8 * qg + 4 * t], wq[8 * qg + 4 * t + 1], wq[8 * qg + 4 * t + 2], wq[8 * qg + 4 * t + 3]}; pa[qg][t] = __builtin_bit_cast(bf16x8, w); } }
        ATT_SBAR();
        pv_half16<0>(o, ol, onesb, vb0 + v_cur * V_SLOT, pa[0][0], pa[1][0]);
        pq1[0] = pa[0][1]; pq1[1] = pa[1][1];
        ATT_SBAR();
        if (!lead) asm volatile("s_waitcnt lgkmcnt(0)\n\ts_barrier" ::: "memory"); else if (j + 2 < NT) { ATT_WAIT_BAR(PIECES); } else { ATT_WAIT_BAR(0); }
        ATT_SBAR();
        v_cur = (v_cur + 1) & 3; v_n2 = (v_n2 + 1) & 3;
    };
    { int j = 0;
      for (; j + 3 <= NT; j += 3) { tile(std::integral_constant<int, 0>{}, j); tile(std::integral_constant<int, 1>{}, j + 1); tile(std::integral_constant<int, 2>{}, j + 2); }
      if (j < NT) { tile(std::integral_constant<int, 0>{}, j); ++j; if (j < NT) tile(std::integral_constant<int, 1>{}, j); } }
    if (wid < 4) asm volatile("s_barrier" ::: "memory");
    pv_half16<1>(o, ol, onesb, vb0 + ((v_cur + 3) & 3) * V_SLOT, pq1[0], pq1[1]);
    asm volatile("s_waitcnt lgkmcnt(0)\n\ts_barrier" ::: "memory");
    if (qi == 0) { *(ATT_LAS f32x4a*)(wsf + 32 + 4 * g) = ol[0]; *(ATT_LAS f32x4a*)(wsf + 48 + 4 * g) = ol[1]; }
    asm volatile("s_waitcnt lgkmcnt(0)" ::: "memory");
#pragma unroll
    for (int qg = 0; qg < 2; ++qg) { const f32x4a lv = *(const ATT_LAS f32x4a*)(wsf + 32 + 16 * qg + 4 * g);
#pragma unroll
        for (int r = 0; r < 4; ++r) { const float rl = __builtin_amdgcn_rcpf(lv[r]);
#pragma unroll
            for (int dg = 0; dg < 8; ++dg) { const unsigned w = cvtpk(o[qg][dg][r] * rl, 0.f); Ow[(size_t)(16 * qg + 4 * g + r) * ldo + 16 * dg + qi] = (bf16_t)(w & 0xffffu); } } }
    asm volatile("s_waitcnt lgkmcnt(0)" ::: "memory");
#undef ATT_ISSUE16
}
#undef ATT_WAIT_BAR
#undef ATT_SBAR
}
#define GAS __attribute__((address_space(1)))
#define LAS __attribute__((address_space(3)))
typedef unsigned short bf16;
typedef unsigned v4u __attribute__((ext_vector_type(4)));
typedef float f32x4 __attribute__((ext_vector_type(4)));
typedef short bf16x8 __attribute__((ext_vector_type(8)));
typedef GAS unsigned gu32;
typedef GAS unsigned long long gu64;
#define RLX_AGENT __ATOMIC_RELAXED, __HIP_MEMORY_SCOPE_AGENT
#define LDS_WAIT() asm volatile("s_waitcnt lgkmcnt(0)" ::: "memory")
#define VM_WAIT() asm volatile("s_waitcnt vmcnt(0)" ::: "memory")
__device__ __forceinline__ unsigned long long rt() { return __builtin_amdgcn_s_memrealtime(); }
__device__ __forceinline__ unsigned f2bf(float f) { unsigned u = __builtin_bit_cast(unsigned, f); return (u + 0x7fffu + ((u >> 16) & 1u)) >> 16; }
__device__ __forceinline__ unsigned pk2(float lo, float hi) { return f2bf(lo) | (f2bf(hi) << 16); }

#define XB_TMO      128
#define XB_XCNT(j)  (256  + 64 * (j))
#define XB_XSUB(j)  (1280 + 64 * (j))
#define XB_XGEN(j)  (2304 + 64 * (j))
#define XB_TOP      3328
#define XB_TOPGEN   3392
#define XCD_BAR_WORDS 3456
#define XB_SPIN_CAP (1u << 18)

__device__ __forceinline__ unsigned xb_ld(unsigned* p)              { return __hip_atomic_load(p, __ATOMIC_RELAXED, __HIP_MEMORY_SCOPE_AGENT); }
__device__ __forceinline__ unsigned xb_add(unsigned* p, unsigned v) { return __hip_atomic_fetch_add(p, v, __ATOMIC_RELAXED, __HIP_MEMORY_SCOPE_AGENT); }
__device__ __forceinline__ unsigned xb_xcc_id() { return (unsigned)__builtin_amdgcn_s_getreg((3 << 11) | 20) & 0xFu; }
#define XB_SPIN(cond, bar) do { unsigned _sp = 0; while (cond) { __builtin_amdgcn_s_sleep(1); \
    if ((++_sp & 255u) == 0u) { if (xb_ld(&(bar)[XB_TMO])) break; if (_sp > XB_SPIN_CAP) { atomicAdd(&(bar)[XB_TMO], 1u); break; } } } } while (0)

struct XcdBarrier {
    unsigned* bar; unsigned x;
    volatile LAS unsigned* st;
};

__device__ __forceinline__ XcdBarrier xcd_barrier_post(unsigned* bar, volatile LAS unsigned* st) {
    XcdBarrier b; b.bar = bar; b.x = xb_xcc_id(); b.st = st;
    if (threadIdx.x == 0) (void)xb_add(&bar[XB_XCNT(b.x)], 1u);
    return b;
}
__device__ __forceinline__ void xcd_barrier_complete(unsigned* bar, unsigned x, unsigned& nloc, unsigned& nx) {
    const unsigned G = gridDim.x * gridDim.y * gridDim.z;
    unsigned sum, cnt, mine, sp = 0u;
    for (;;) {
        sum = 0u; cnt = 0u; mine = 0u;
#pragma unroll
        for (unsigned j = 0; j < 16; ++j) { const unsigned c = xb_ld(&bar[XB_XCNT(j)]); sum += c; cnt += (c > 0u) ? 1u : 0u; mine = (j == x) ? c : mine; }
        if (sum == G) break;
        __builtin_amdgcn_s_sleep(1);
        if ((++sp & 255u) == 0u) { if (xb_ld(&bar[XB_TMO])) break; if (sp > XB_SPIN_CAP) { atomicAdd(&bar[XB_TMO], 1u); break; } }
    }
    nloc = mine > 0u ? mine : 1u; nx = cnt > 0u ? cnt : 1u;
}

__device__ __forceinline__ void xcd_barrier(const XcdBarrier& b) {
    asm volatile("s_waitcnt vmcnt(0)" ::: "memory");
    __syncthreads();
    if (threadIdx.x == 0) {
        unsigned* bar = b.bar;
        __builtin_amdgcn_s_waitcnt(0);
        unsigned nloc = b.st[0], nx = b.st[1];
        if (nloc == 0u) { xcd_barrier_complete(bar, b.x, nloc, nx); b.st[0] = nloc; b.st[1] = nx; }
        const unsigned old = xb_add(&bar[XB_XSUB(b.x)], 1u);
        const unsigned gen = old / nloc;
        if (old + 1u == (gen + 1u) * nloc) {
            __builtin_amdgcn_fence(__ATOMIC_RELEASE, "agent");
            asm volatile("s_waitcnt vmcnt(0)" ::: "memory");
            const unsigned og = xb_add(&bar[XB_TOP], 1u);
            const unsigned tg = og / nx;
            if (og + 1u == (tg + 1u) * nx) xb_add(&bar[XB_TOPGEN], 1u);
            else XB_SPIN(xb_ld(&bar[XB_TOPGEN]) == tg, bar);
            __builtin_amdgcn_fence(__ATOMIC_ACQUIRE, "agent");
            xb_add(&bar[XB_XGEN(b.x)], 1u);
            asm volatile("s_waitcnt vmcnt(0)" ::: "memory");
        } else {
            XB_SPIN(xb_ld(&bar[XB_XGEN(b.x)]) == gen, bar);
            __builtin_amdgcn_fence(__ATOMIC_ACQUIRE, "agent");
            asm volatile("s_waitcnt vmcnt(0)" ::: "memory");
        }
    }
    __syncthreads();
}

constexpr int NWAVES = 8;
constexpr int T = 24576, TP = 16384, DM = 2048, DFF = 8192, PLE = 256, DEPTH = 4;
constexpr int LATN = 1280;
constexpr float EPS = 1e-6f;
constexpr int MCH = 8192, NCH = 3;
constexpr size_t MiB = 1u << 20;
constexpr size_t WS_CTL = 0, CTL_ZERO_BYTES = 1 * MiB;
constexpr size_t WS_ROT = 1 * MiB;
constexpr size_t WS_BT = 5 * MiB;
constexpr size_t WS_STAT = 6 * MiB;
constexpr size_t SS_XIN = WS_STAT, SS_X2 = WS_STAT + 128 * 1024, SS_E = WS_STAT + 256 * 1024, PS_Q = WS_STAT + 1 * MiB, PS_KV = WS_STAT + 2 * MiB, PS_H = WS_STAT + 3 * MiB, PS_E = WS_STAT + 6 * MiB, PS_X = WS_STAT + 9 * MiB;
constexpr size_t WS_W = 18 * MiB;
constexpr size_t W_MLA = 20 * MiB, W_SWA = 20 * MiB, W_LAYER = 73 * MiB;
constexpr size_t WO_WD = 0, WO_WUQ = 5 * MiB, WO_WUKV = 8 * MiB, WO_WOM = 12 * MiB;
constexpr size_t WO_WQKV = 0, WO_WOS = 12 * MiB;
constexpr size_t WO_UP = 0, WO_DN = 32 * MiB, WO_PU = 64 * MiB, WO_G = 65 * MiB;
constexpr size_t WS_WMLA = WS_W, WS_WSWA = WS_WMLA + 2 * W_MLA, WS_WLAY = WS_WSWA + 2 * W_SWA, WS_WEND = WS_WLAY + 4 * W_LAYER;
constexpr size_t WS_PB = WS_WEND;
constexpr size_t WS_XB = WS_PB + 12 * MiB;
constexpr size_t WS_H = WS_XB + 96 * MiB;
constexpr size_t WS_CQ = WS_H, WS_CKV = WS_H + 24 * MiB;
constexpr size_t WS_R = WS_H + 96 * MiB;
constexpr size_t WS_E = WS_R, WS_HID = WS_R + 96 * MiB;
constexpr size_t WS_Q = WS_R, WS_KV = WS_R + 144 * MiB, WS_KR = WS_KV + 192 * MiB;
constexpr size_t WS_QKV = WS_R;
constexpr size_t WS_XB1_UNUSED = WS_R + 144 * MiB;
constexpr size_t WS_END = WS_KR + 3 * MiB;
static_assert(PS_X + (size_t)T * 32 * 4 <= WS_W && WS_HID + 128 * MiB <= WS_END && WS_END <= 1000 * MiB, "d_ws map");
constexpr int CW_BAR = 4096;
constexpr int RING_OFF = 0, RING_BYTES = 131072;
constexpr int LDSCTL_OFF = 143360, MISC_OFF = LDSCTL_OFF + 320;
constexpr int LDS_BYTES = 147456;
static_assert(MISC_OFF + 128 <= LDS_BYTES && att::ATT_LDS_BYTES <= LDSCTL_OFF && RING_BYTES <= LDSCTL_OFF, "LDS map");

__device__ __forceinline__ float wave_sum(float v) {
#pragma unroll
    for (int o = 1; o < 64; o <<= 1) v += __shfl_xor(v, o);
    return v;
}
__device__ __forceinline__ float sq4(f32x4 v) { return (v.x * v.x + v.y * v.y) + (v.z * v.z + v.w * v.w); }
typedef unsigned u32x2 __attribute__((ext_vector_type(2)));
typedef unsigned u32x4 __attribute__((ext_vector_type(4)));
__device__ __forceinline__ u32x2 pk4(f32x4 v) { u32x2 r; r.x = pg8::cvt_pk_bf16(v.x, v.y); r.y = pg8::cvt_pk_bf16(v.z, v.w); return r; }
__device__ __forceinline__ f32x4 unpk4(u32x2 w) { f32x4 e; e.x = __uint_as_float(w.x << 16); e.y = __uint_as_float(w.x & 0xffff0000u); e.z = __uint_as_float(w.y << 16); e.w = __uint_as_float(w.y & 0xffff0000u); return e; }

__device__ __forceinline__ int cmap(int mode, int n) {
    if (mode == 1) { if (n < 1024) return n; if (n >= 1088) return -1; const int r = n - 1024; return 1024 + (r >> 1) + 32 * (r & 1); }
    if (mode == 2) { const int h = n / 192, r = n % 192; if (r < 128) return n; const int q = r - 128; return h * 192 + 128 + (q >> 1) + 32 * (q & 1); }
    return n;
}
__device__ __forceinline__ void p0_transpose_item(const float* W, int K, int Nsrc, int Ndst, bf16* WT, int mode, const float* gain, LAS float* scr, int item, int lane) {
    const int nblk = Ndst / 32, kb = item / nblk, nb = item % nblk, k0 = 64 * kb, n0 = 32 * nb;
    const int sc = cmap(mode, n0 + (lane & 31));
#pragma unroll 8
    for (int i = 0; i < 32; ++i) { const int kk = 2 * i + (lane >> 5); scr[kk * 33 + (lane & 31)] = sc >= 0 ? W[(size_t)(k0 + kk) * Nsrc + sc] * (gain ? gain[k0 + kk] : 1.f) : 0.f; }
    LDS_WAIT(); asm volatile("" ::: "memory");
    const int c = lane & 7;
#pragma unroll
    for (int j = 0; j < 4; ++j) { const int n = (lane >> 3) + 8 * j; const LAS float* s = scr + (8 * c) * 33 + n;
        v4u o; o.x = pk2(s[0 * 33], s[1 * 33]); o.y = pk2(s[2 * 33], s[3 * 33]); o.z = pk2(s[4 * 33], s[5 * 33]); o.w = pk2(s[6 * 33], s[7 * 33]);
        *(GAS v4u*)(WT + (size_t)(n0 + n) * K + k0 + 8 * c) = o; }
    LDS_WAIT(); asm volatile("" ::: "memory");
}
__device__ __forceinline__ void p0_fast_item(const float* W, int K, int N, bf16* WT, const float* gain, LAS unsigned char* scr, int item, int lane) {
    const int nblk = N / 64, kb = item / nblk, nb = item % nblk, k0 = 64 * kb, n0 = 64 * nb, q = lane & 15, g = lane >> 4;
    f32x4 a[8], b[8];
    const float* src = W + (size_t)(k0 + 2 * g) * N + n0 + 4 * q;
#pragma unroll
    for (int i = 0; i < 8; ++i) { a[i] = *(const f32x4*)(src + (size_t)(8 * i) * N); b[i] = *(const f32x4*)(src + (size_t)(8 * i + 1) * N); }
    if (gain) {
#pragma unroll
        for (int i = 0; i < 8; ++i) { const float ga = gain[k0 + 8 * i + 2 * g], gb = gain[k0 + 8 * i + 2 * g + 1]; a[i] = a[i] * ga; b[i] = b[i] * gb; } }
#pragma unroll
    for (int i = 0; i < 8; ++i)
#pragma unroll
        for (int e = 0; e < 4; ++e) *(LAS unsigned*)(scr + (4 * q + e) * 128 + ((i ^ (q & 7)) << 4) + 4 * g) = pg8::cvt_pk_bf16(a[i][e], b[i][e]);
    LDS_WAIT(); asm volatile("" ::: "memory");
    const int c = lane & 7;
#pragma unroll
    for (int j = 0; j < 8; ++j) { const int n = (lane >> 3) + 8 * j; const v4u v = *(const LAS v4u*)(scr + n * 128 + ((c ^ ((n >> 2) & 7)) << 4));
        *(GAS v4u*)(WT + (size_t)(n0 + n) * K + k0 + 8 * c) = v; }
    LDS_WAIT(); asm volatile("" ::: "memory");
}

template <int R> __device__ __forceinline__ void thin_c_rows(int m0, int stride, int lane, const bf16* XB1, const float* g1, bf16* XB, const bf16* H,
                                                             const float* psh, float* ssx2, const float* pp, const float* psm, bf16* PB) {
    u32x4 hw[R][4], xw[R][4]; float ph[R]; f32x4 pv_[R];
#pragma unroll
    for (int rr = 0; rr < R; ++rr) { const int m = m0 + rr * stride; const bf16* hr = H + (size_t)m * DM; const bf16* xr = XB1 + (size_t)m * DM;
#pragma unroll
        for (int q = 0; q < 4; ++q) { hw[rr][q] = *(const u32x4*)(hr + 512 * q + 8 * lane); xw[rr][q] = *(const u32x4*)(xr + 512 * q + 8 * lane); }
        ph[rr] = lane < 32 ? psh[(size_t)m * 32 + lane] : 0.f;
        const float* pr = m < TP ? pp + (size_t)m * PLE : psm + (size_t)(m - TP) * PLE; pv_[rr] = *(const f32x4*)(pr + 4 * lane); }
#pragma unroll
    for (int rr = 0; rr < R; ++rr) { const int m = m0 + rr * stride;
        const float rh = __builtin_amdgcn_rsqf(wave_sum(ph[rr]) * (1.0f / DM) + EPS); float sx = 0.f;
        f32x4 v[4][2];
#pragma unroll
        for (int q = 0; q < 4; ++q) {
            v[q][0] = unpk4((u32x2){xw[rr][q].x, xw[rr][q].y}) + unpk4((u32x2){hw[rr][q].x, hw[rr][q].y}) * rh * *(const f32x4*)(g1 + 512 * q + 8 * lane);
            v[q][1] = unpk4((u32x2){xw[rr][q].z, xw[rr][q].w}) + unpk4((u32x2){hw[rr][q].z, hw[rr][q].w}) * rh * *(const f32x4*)(g1 + 512 * q + 8 * lane + 4);
            sx += sq4(v[q][0]) + sq4(v[q][1]); }
        sx = wave_sum(sx); if (lane == 0) ssx2[m] = sx;
        { const float rx = __builtin_amdgcn_rsqf(sx * (1.0f / DM) + EPS);
#pragma unroll
          for (int q = 0; q < 4; ++q) { const u32x2 lo = pk4(v[q][0] * rx), hi = pk4(v[q][1] * rx); *(u32x4*)(XB + (size_t)m * DM + 512 * q + 8 * lane) = (u32x4){lo.x, lo.y, hi.x, hi.y}; } }
        *(u32x2*)(PB + (size_t)m * PLE + 4 * lane) = pk4(pv_[rr]); }
}
template <int R> __device__ __forceinline__ void thin_d_rows(int m0, int stride, int lane, const float* g3, bf16* XB, const bf16* H, const float* psh, const float* pse, float* sse, const float* ssx2) {
    u32x4 xw[R][4], hw[R][4]; float ph[R], pe[R], sx2[R];
#pragma unroll
    for (int rr = 0; rr < R; ++rr) { const int m = m0 + rr * stride; const bf16* hr = H + (size_t)m * DM; const bf16* xr = XB + (size_t)m * DM;
#pragma unroll
        for (int q = 0; q < 4; ++q) { hw[rr][q] = *(const u32x4*)(hr + 512 * q + 8 * lane); xw[rr][q] = *(const u32x4*)(xr + 512 * q + 8 * lane); }
        ph[rr] = lane < 32 ? psh[(size_t)m * 32 + lane] : 0.f; pe[rr] = lane < 32 ? pse[(size_t)m * 32 + lane] : 0.f; sx2[rr] = ssx2[m]; }
#pragma unroll
    for (int rr = 0; rr < R; ++rr) { const int m = m0 + rr * stride; bf16* xr = XB + (size_t)m * DM;
        const float rh = __builtin_amdgcn_rsqf(wave_sum(ph[rr]) * (1.0f / DM) + EPS);
        { const float se = wave_sum(pe[rr]); if (lane == 0) sse[m] = se; }
        const float ux = __builtin_sqrtf(sx2[rr] * (1.0f / DM) + EPS);
#pragma unroll
        for (int q = 0; q < 4; ++q) {
            const u32x2 lo = pk4(unpk4((u32x2){xw[rr][q].x, xw[rr][q].y}) * ux + unpk4((u32x2){hw[rr][q].x, hw[rr][q].y}) * rh * *(const f32x4*)(g3 + 512 * q + 8 * lane));
            const u32x2 hi = pk4(unpk4((u32x2){xw[rr][q].z, xw[rr][q].w}) * ux + unpk4((u32x2){hw[rr][q].z, hw[rr][q].w}) * rh * *(const f32x4*)(g3 + 512 * q + 8 * lane + 4));
            *(u32x4*)(xr + 512 * q + 8 * lane) = (u32x4){lo.x, lo.y, hi.x, hi.y}; } }
}

struct Args { const float* in[20]; float* out; unsigned char* ws; };
#define ZERO() ({ int z__; asm volatile("s_mov_b32 %0, 0" : "=s"(z__)); z__; })
#define WSP(T_, off) ((T_*)(args.ws + (size_t)(off) + (size_t)ZERO()))
#define INP(k) (args.in[(k) + ZERO()])
__global__ void __launch_bounds__(NWAVES * 64, 2) trunk_fwd(Args args) {
    extern __shared__ __attribute__((aligned(16))) unsigned char lds_raw[];
    LAS unsigned char* lds = (LAS unsigned char*)lds_raw;
    volatile LAS unsigned* MISC = (volatile LAS unsigned*)(lds + MISC_OFF);
    const int tid = threadIdx.x, lane0 = tid & 63, wave = __builtin_amdgcn_readfirstlane(tid >> 6);
#define LANE_DECL() int lane = lane0; asm volatile("" : "+v"(lane)); int gwl = gw; asm volatile("" : "+s"(gwl))
    const int G = gridDim.x; const int bx = blockIdx.x; const int vcu = (G % 8 == 0) ? (bx % 8) * (G / 8) + bx / 8 : bx;
    for (int u = tid; u < (LDS_BYTES - LDSCTL_OFF) / 4; u += NWAVES * 64) ((LAS unsigned*)(lds + LDSCTL_OFF))[u] = 0u;
    __syncthreads();
    XcdBarrier bar = xcd_barrier_post((unsigned*)(args.ws + WS_CTL) + CW_BAR, MISC + 8);
#define GRID_BAR() xcd_barrier(bar)
    const int gw = vcu * NWAVES + wave, NGW = G * NWAVES;
    constexpr float QSCALE = 0.07216878364870322f * 1.4426950408889634f;

    {
        LANE_DECL(); LAS unsigned char* scr8 = lds + RING_OFF + wave * 16384; LAS float* scr = (LAS float*)scr8;
        unsigned char* ws = args.ws;
        int rot_ = 0;
#define CVT(Wsrc, K_, Nsrc_, Ndst_, dst_, mode_, gain_) do { const int nit_ = ((K_) / 64) * ((Ndst_) / 32); \
            for (int it_ = (gwl + NGW - rot_) % NGW; it_ < nit_; it_ += NGW) p0_transpose_item((Wsrc), (K_), (Nsrc_), (Ndst_), (dst_), (mode_), (gain_), scr, it_, lane); rot_ = (rot_ + nit_) % NGW; } while (0)
#define CVTF(Wsrc, K_, N_, dst_, gain_) do { const int nit_ = ((K_) / 64) * ((N_) / 64); \
            for (int it_ = (gwl + NGW - rot_) % NGW; it_ < nit_; it_ += NGW) p0_fast_item((Wsrc), (K_), (N_), (dst_), (gain_), scr8, it_, lane); rot_ = (rot_ + nit_) % NGW; } while (0)
        const float* gains = args.in[4];
        for (int j = 0; j < 2; ++j) {
            unsigned char* wm = ws + WS_WMLA + j * W_MLA; unsigned char* wsw = ws + WS_WSWA + j * W_SWA;
            CVT(args.in[5] + (size_t)j * DM * 1088, DM, 1088, LATN, (bf16*)(wm + WO_WD), 1, gains + (size_t)(2 * j * 4 + 0) * DM);
            CVT(args.in[8] + (size_t)j * 512 * 3072, 512, 3072, 3072, (bf16*)(wm + WO_WUQ), 2, args.in[6] + j * 512);
            CVTF(args.in[9] + (size_t)j * 512 * 4096, 512, 4096, (bf16*)(wm + WO_WUKV), args.in[7] + j * 512);
            CVTF(args.in[10] + (size_t)j * DM * DM, DM, DM, (bf16*)(wm + WO_WOM), (const float*)nullptr);
            CVTF(args.in[11] + (size_t)j * DM * 3072, DM, 3072, (bf16*)(wsw + WO_WQKV), gains + (size_t)((2 * j + 1) * 4 + 0) * DM);
            CVTF(args.in[13] + (size_t)j * DM * DM, DM, DM, (bf16*)(wsw + WO_WOS), (const float*)nullptr);
        }
        for (int L = 0; L < DEPTH; ++L) {
            unsigned char* wl = ws + WS_WLAY + L * W_LAYER;
            CVTF(args.in[15] + (size_t)L * DM * DFF, DM, DFF, (bf16*)(wl + WO_UP), gains + (size_t)(L * 4 + 2) * DM);
            CVTF(args.in[16] + (size_t)L * DFF * DM, DFF, DM, (bf16*)(wl + WO_DN), (const float*)nullptr);
            CVTF(args.in[17] + (size_t)L * PLE * DM, PLE, DM, (bf16*)(wl + WO_PU), (const float*)nullptr);
            CVTF(args.in[18] + (size_t)L * DM * DM, DM, DM, (bf16*)(wl + WO_G), (const float*)nullptr);
        }
#undef CVT
#undef CVTF
        float* rot = (float*)(ws + WS_ROT);
        for (int i = vcu * (NWAVES * 64) + tid; i < 16384 * 32; i += G * NWAVES * 64) {
            const int pos = i >> 5, d = i & 31; double inv = 1.0; for (int k = 0; k < d; ++k) inv *= 0.74989420933245582730;
            const double turns = (double)pos * inv * 0.15915494309189533577; const float fr = (float)(turns - __builtin_rint(turns));
            rot[2 * i] = __builtin_amdgcn_cosf(fr); rot[2 * i + 1] = __builtin_amdgcn_sinf(fr);
        }
        float* btg = (float*)(ws + WS_BT);
        for (int i = vcu * (NWAVES * 64) + tid; i < 16 * att::BT_STRIDE; i += G * NWAVES * 64) {
            const int h = i / att::BT_STRIDE, idx = i % att::BT_STRIDE, rel = idx - att::BT_ZERO, n = rel < 0 ? -rel : rel;
            int b = n < 8 ? n : 8 + (n >= 12) + (n >= 16) + (n >= 23) + (n >= 32) + (n >= 46) + (n >= 64) + (n >= 91); if (b > 15) b = 15; if (rel > 0) b += 16;
            btg[i] = n <= 128 ? args.in[14][b * 16 + h] * 1.4426950408889634f : -1e30f;
        }
    }
    { LANE_DECL(); const float* xin0 = INP(0); const float* xin1 = INP(1); bf16* XB = (bf16*)(args.out + ZERO()); float* ssx = WSP(float, SS_XIN);
      for (int m = gwl; m < T; m += NGW) {
        const float* xr = m < TP ? xin0 + (size_t)m * DM : xin1 + (size_t)(m - TP) * DM;
        f32x4 v[8]; float ss = 0.f;
#pragma unroll
        for (int q = 0; q < 8; ++q) { v[q] = *(const f32x4*)(xr + 256 * q + 4 * lane); ss += sq4(v[q]); }
        ss = wave_sum(ss);
#pragma unroll
        for (int q = 0; q < 8; ++q) *(u32x2*)(XB + (size_t)m * DM + 256 * q + 4 * lane) = pk4(v[q]);
        if (lane == 0) ssx[m] = ss;
      } }
    GRID_BAR();
    for (int L = 0; L < DEPTH; ++L) {
        const int j = L >> 1; const bool mla = (L & 1) == 0;
        if (mla) {
#ifndef DBG_NO_GEMM
            { pg8::Gemm g{(const bf16*)(args.out + ZERO()), WSP(bf16, WS_WMLA + j * W_MLA + WO_WD), T, LATN, DM}; pg8::StaticOrder S; S.init(T, LATN, G, bx + ZERO());
              pg8::EpiLat E{WSP(bf16, WS_CQ), WSP(bf16, WS_CKV), WSP(bf16, WS_KR), WSP(float, SS_XIN), WSP(float, PS_Q), WSP(float, PS_KV), WSP(float, WS_ROT)};
              pg8::gemm_phase<pg8::EpiLat, pg8::StaticOrder, true, true>(lds + RING_OFF, g, S, E);
            }
#endif
            GRID_BAR();
#ifndef DBG_NO_GEMM
            { pg8::Gemm g{WSP(bf16, WS_CQ), WSP(bf16, WS_WMLA + j * W_MLA + WO_WUQ), T, 3072, 512}; pg8::StaticOrder S; S.init(T, 3072, G, bx + ZERO()); pg8::EpiQRope E{WSP(bf16, WS_Q), 3072, WSP(float, WS_ROT), QSCALE, WSP(float, PS_Q)};
              pg8::gemm_phase<pg8::EpiQRope, pg8::StaticOrder, true, true>(lds + RING_OFF, g, S, E);
            }
            { pg8::Gemm g{WSP(bf16, WS_CKV), WSP(bf16, WS_WMLA + j * W_MLA + WO_WUKV), T, 4096, 512}; pg8::StaticOrder S; S.init(T, 4096, G, bx + ZERO());
              pg8::EpiBf16<0, 8, false> E{WSP(bf16, WS_KV), 4096, WSP(float, PS_KV), 1.0f / 512.0f, nullptr, 0};
              pg8::gemm_phase<pg8::EpiBf16<0, 8, false>, pg8::StaticOrder, true, true>(lds + RING_OFF, g, S, E);
            }
#endif
            GRID_BAR();
#ifndef DBG_NO_MLA
            { const bf16* QB = WSP(bf16, WS_Q); const bf16* KVB = WSP(bf16, WS_KV); const bf16* KRB = WSP(bf16, WS_KR); bf16* OB = WSP(bf16, WS_XB);
              for (int u = vcu; u < 1536; u += G) {
                int s0, S_, h, qb;
                if (u < 1024) { s0 = 0; S_ = TP; h = u >> 6; qb = u & 63; } else { const int v = u - 1024; s0 = TP + (v >> 8) * 4096; S_ = 4096; h = (v & 255) >> 4; qb = v & 15; }
                const int q0 = s0 + qb * 256 + wave * 32;
                att::attn_mla16(QB + (size_t)q0 * 3072 + h * 192, 3072, KVB + (size_t)s0 * 4096 + h * 256, KRB + (size_t)s0 * 64, KVB + (size_t)s0 * 4096 + h * 256 + 128, 4096,
                                OB + (size_t)q0 * DM + h * 128, DM, S_ / 64, lds + RING_OFF);
              } }
#endif
        } else {
#ifndef DBG_NO_GEMM
            { pg8::Gemm g{(const bf16*)(args.out + ZERO()), WSP(bf16, WS_WSWA + j * W_SWA + WO_WQKV), T, 3072, DM}; pg8::StaticOrder S; S.init(T, 3072, G, bx + ZERO());
              pg8::EpiBf16<0, 1, false> E{WSP(bf16, WS_QKV), 3072, WSP(float, SS_XIN), 1.0f / 2048.0f, nullptr, 0};
              pg8::gemm_phase<pg8::EpiBf16<0, 1, false>, pg8::StaticOrder, true, true>(lds + RING_OFF, g, S, E);
            }
#endif
            GRID_BAR();
#ifndef DBG_NO_SWA
            { LAS float* btl = (LAS float*)(lds + RING_OFF + att::BT_OFF); const float* btg = WSP(float, WS_BT);
              int tl = tid; asm volatile("" : "+v"(tl));
              for (int i = tl; i < 16 * att::BT_STRIDE; i += NWAVES * 64) btl[i] = btg[i];
              __syncthreads();
              const float* sink = INP(12) + j * 16; const bf16* QKV = WSP(bf16, WS_QKV); bf16* OB = WSP(bf16, WS_XB);
              for (int u = vcu; u < 1536; u += G) {
                  const int kvh = u / 384, rb = u % 384, q0 = rb * 64; int s0, S_;
                  if (q0 < TP) { s0 = 0; S_ = TP; } else { s0 = TP + ((q0 - TP) >> 12) * 4096; S_ = 4096; }
                  const int lo = max(q0 - 128, s0), hi_ = min(q0 + 192, s0 + S_), NT = (hi_ - lo) >> 6;
                  const int hq = kvh * 4 + (wave & 3), qw = q0 + 32 * (wave >> 2);
                  att::attn_unit<true>(QKV + (size_t)qw * 3072 + hq * 128, 3072, QKV + (size_t)lo * 3072 + 2048 + kvh * 128, nullptr, QKV + (size_t)lo * 3072 + 2560 + kvh * 128, 3072,
                                       OB + (size_t)qw * DM + hq * 128, DM, NT, lo - qw, 0.08838834764831845f * 1.4426950408889634f, sink[hq] * 1.4426950408889634f, lds + RING_OFF, btl + hq * att::BT_STRIDE);
              } }
#endif
        }
        GRID_BAR();
#ifndef DBG_NO_GEMM
        { const bf16* wo = mla ? WSP(bf16, WS_WMLA + j * W_MLA + WO_WOM) : WSP(bf16, WS_WSWA + j * W_SWA + WO_WOS);
          pg8::Gemm g{WSP(bf16, WS_XB), wo, T, DM, DM}; pg8::StaticOrder S; S.init(T, DM, G, bx + ZERO()); pg8::EpiBf16<0, 0, true> E{WSP(bf16, WS_H), DM, nullptr, 0.f, WSP(float, PS_H), 0};
          pg8::gemm_phase<pg8::EpiBf16<0, 0, true>, pg8::StaticOrder, true, true>(lds + RING_OFF, g, S, E);
        }
#endif
        GRID_BAR();
        { LANE_DECL(); const float* xin0 = INP(0); const float* xin1 = INP(1); const bf16* XB1 = (const bf16*)(args.out + ZERO()); const float* g1 = INP(4) + (size_t)(L * 4 + 1) * DM;
          bf16* XB = WSP(bf16, WS_XB); const bf16* H = WSP(bf16, WS_H); const float* psh = WSP(float, PS_H); float* ssx2 = WSP(float, SS_X2);
          const float* pp = INP(2) + (size_t)L * TP * PLE; const float* psm = INP(3) + (size_t)L * (T - TP) * PLE; bf16* PB = WSP(bf16, WS_PB);
          constexpr int RC = 2; int m0 = gwl;
          for (; m0 + (RC - 1) * NGW < T; m0 += RC * NGW) thin_c_rows<RC>(m0, NGW, lane, XB1, g1, XB, H, psh, ssx2, pp, psm, PB);
          for (; m0 < T; m0 += NGW) thin_c_rows<1>(m0, NGW, lane, XB1, g1, XB, H, psh, ssx2, pp, psm, PB);
        }
        GRID_BAR();
        for (int c = 0; c < NCH; ++c) {
#ifndef DBG_NO_GEMM
            { pg8::Gemm g{WSP(bf16, WS_XB) + (size_t)c * MCH * DM, WSP(bf16, WS_WLAY + L * W_LAYER + WO_UP), MCH, DFF, DM}; pg8::StaticOrder S; S.init(MCH, DFF, G, bx + ZERO());
              pg8::EpiBf16<1, 0, false> E{WSP(bf16, WS_HID), DFF, nullptr, 0.f, nullptr, c * MCH};
              pg8::gemm_phase<pg8::EpiBf16<1, 0, false>, pg8::StaticOrder, true, true>(lds + RING_OFF, g, S, E);
            }
#endif
            GRID_BAR();
#ifndef DBG_NO_GEMM
            { pg8::Gemm g{WSP(bf16, WS_HID), WSP(bf16, WS_WLAY + L * W_LAYER + WO_DN), MCH, DM, DFF}; pg8::StaticOrder S; S.init(MCH, DM, G, bx + ZERO());
              pg8::EpiBf16<0, 0, true> E{WSP(bf16, WS_H) + (size_t)c * MCH * DM, DM, nullptr, 0.f, WSP(float, PS_H), c * MCH};
              pg8::gemm_phase<pg8::EpiBf16<0, 0, true>, pg8::StaticOrder, true, true>(lds + RING_OFF, g, S, E);
            }
            if (c == 0) {
              pg8::Gemm g{WSP(bf16, WS_PB), WSP(bf16, WS_WLAY + L * W_LAYER + WO_PU), T, DM, PLE + ZERO()}; pg8::StaticOrder S; S.init(T, DM, G, bx + ZERO());
              pg8::EpiBf16<0, 0, true> E{WSP(bf16, WS_E), DM, nullptr, 0.f, WSP(float, PS_E), 0};
              pg8::gemm_phase<pg8::EpiBf16<0, 0, true>, pg8::StaticOrder, true, true>(lds + RING_OFF, g, S, E);
            }
#endif
            GRID_BAR();
        }
        { LANE_DECL(); const float* g3 = INP(4) + (size_t)(L * 4 + 3) * DM; bf16* XB = WSP(bf16, WS_XB); const bf16* H = WSP(bf16, WS_H); const float* psh = WSP(float, PS_H); const float* pse = WSP(float, PS_E); float* sse = WSP(float, SS_E); const float* ssx2 = WSP(float, SS_X2);
          constexpr int RD = 4; int m0 = gwl;
          for (; m0 + (RD - 1) * NGW < T; m0 += RD * NGW) thin_d_rows<RD>(m0, NGW, lane, g3, XB, H, psh, pse, sse, ssx2);
          for (; m0 < T; m0 += NGW) thin_d_rows<1>(m0, NGW, lane, g3, XB, H, psh, pse, sse, ssx2);
        }
        GRID_BAR();
#ifndef DBG_NO_GEMM
        { pg8::Gemm g{WSP(bf16, WS_XB), WSP(bf16, WS_WLAY + L * W_LAYER + WO_G), T, DM, DM}; pg8::StaticOrder S; S.init(T, DM, G, bx + ZERO());
          pg8::EpiGate E{WSP(bf16, WS_XB), WSP(bf16, WS_E), (L + 1 < DEPTH) ? (bf16*)(args.out + ZERO()) : (bf16*)nullptr, args.out + ZERO(), DM, WSP(float, SS_E), INP(19) + (size_t)L * DM, WSP(float, PS_X)};
          pg8::gemm_phase<pg8::EpiGate, pg8::StaticOrder, true, true>(lds + RING_OFF, g, S, E);
        }
#endif
        if (L + 1 < DEPTH) {
            GRID_BAR();
            { LANE_DECL(); const float* psx = WSP(float, PS_X); float* ssx = WSP(float, SS_XIN);
              for (int m = gwl; m < T; m += NGW) { const float s = wave_sum(lane < 32 ? psx[(size_t)m * 32 + lane] : 0.f); if (lane == 0) ssx[m] = s; } }
            GRID_BAR();
        }
    }
#undef GRID_BAR
}

extern "C" void kernel_launch(void* const* d_in, const int* in_sizes, int n_in, void* d_out, int out_size, void* d_ws, size_t ws_size, hipStream_t stream) {
    static int grid = 0;
    if (grid == 0) {
        if (n_in != 20 || out_size != T * DM || ws_size < WS_END) { fprintf(stderr, "kernel_launch: unexpected shapes: n_in %d out %d ws %zu (need %zu)\n", n_in, out_size, ws_size, (size_t)WS_END); grid = -1; return; }
        int dev = 0, cus = 0, per_cu = 0;
        if (hipGetDevice(&dev) != hipSuccess || hipDeviceGetAttribute(&cus, hipDeviceAttributeMultiprocessorCount, dev) != hipSuccess) { grid = -1; return; }
        if (hipFuncSetAttribute((const void*)trunk_fwd, hipFuncAttributeMaxDynamicSharedMemorySize, LDS_BYTES) != hipSuccess) { fprintf(stderr, "kernel_launch: hipFuncSetAttribute failed\n"); grid = -1; return; }
        if (hipOccupancyMaxActiveBlocksPerMultiprocessor(&per_cu, (const void*)trunk_fwd, NWAVES * 64, LDS_BYTES) != hipSuccess || per_cu < 1) fprintf(stderr, "kernel_launch: occupancy query reports %d\n", per_cu);
        (void)hipGetLastError();
        grid = cus;
    }
    if (grid < 0) return;
    if (hipMemsetAsync((char*)d_ws + WS_CTL, 0, CTL_ZERO_BYTES, stream) != hipSuccess) return;
    Args a{};
    for (int i = 0; i < 20; ++i) a.in[i] = (const float*)d_in[i];
    a.out = (float*)d_out; a.ws = (unsigned char*)d_ws;
    hipLaunchKernelGGL(trunk_fwd, dim3(grid), dim3(NWAVES * 64), LDS_BYTES, stream, a);
    const hipError_t le = hipPeekAtLastError();
    if (le != hipSuccess) fprintf(stderr, "kernel_launch: launch failed: %s\n", hipGetErrorName(le));
}
```
